# Optimizing an MI355X kernel written in HIP

```python
import jax
import jax.numpy as jnp
from jax import lax
import numpy as np

D_MODEL = 1024
BATCH = 1
SEQ = 16384
DEPTH = 4

N_MIXERS = 4
NORM_EPS = 1e-6
GLA_HEADS = 4
GLA_DK = D_MODEL // 2
GLA_DV = D_MODEL
GLA_RANK = 16
GLA_TAU = 16.0
GLA_CHUNK = 64
GLA_IN = 2 * GLA_DK + 2 * GLA_DV + GLA_RANK
RWKV_HEAD = 64
RWKV_HEADS = D_MODEL // RWKV_HEAD
RWKV_DECAY_RANK = 64
RWKV_A_RANK = 64
RWKV_GATE_RANK = 128
RWKV_GN_EPS = 64e-5
RWKV_SHIFT_MIXES = 6
SB_HEADS = 16
SB_HEAD_DIM = D_MODEL // SB_HEADS
SB_BLOCK = 128
ML_HEADS = 4
ML_DK = D_MODEL // 2
ML_DV = D_MODEL
ML_CHUNK = 64
ML_IN = 2 * ML_DK + 2 * ML_DV + 2 * ML_HEADS
FFN_DIM = 2816
CONV_WIDTH = 3

kernel_name = "hybrid_gla_rwkv7_stickbreak_mlstm_trunk"


def rms_norm(x, g, eps=NORM_EPS):
    xf = x.astype(jnp.float32)
    y = xf * lax.rsqrt(jnp.mean(xf * xf, axis=-1, keepdims=True) + eps)
    return (y * g.astype(jnp.float32)).astype(x.dtype)


def _to_chunks(t, chunk):
    b, s, h, d = t.shape
    return t.reshape(b, s // chunk, chunk, h, d).transpose(1, 0, 3, 2, 4)


def _from_chunks(t):
    n, b, h, c, d = t.shape
    return t.transpose(1, 0, 3, 2, 4).reshape(b, n * c, h, d)


def _gates_to_chunks(t, chunk):
    b, s, h = t.shape
    return t.reshape(b, s // chunk, chunk, h).transpose(1, 0, 3, 2)


def gla_mixer(x, w_in, w_alpha_up, b_alpha, out_norm, w_out):
    f32 = jnp.float32
    b, s, _ = x.shape
    h, dk, dv, c = GLA_HEADS, GLA_DK // GLA_HEADS, GLA_DV // GLA_HEADS, GLA_CHUNK
    proj = x @ w_in
    q, k, v, r, a_low = jnp.split(
        proj, [GLA_DK, 2 * GLA_DK, 2 * GLA_DK + GLA_DV, 2 * GLA_DK + 2 * GLA_DV], axis=-1)
    log_alpha = jax.nn.log_sigmoid((a_low @ w_alpha_up + b_alpha).astype(f32)) / GLA_TAU
    q = q.astype(f32).reshape(b, s, h, dk) * dk ** -0.5
    k = k.astype(f32).reshape(b, s, h, dk)
    v = v.astype(f32).reshape(b, s, h, dv)
    qc, kc, vc = _to_chunks(q, c), _to_chunks(k, c), _to_chunks(v, c)
    cum = jnp.cumsum(_to_chunks(log_alpha.reshape(b, s, h, dk), c), axis=3)
    causal = jnp.tril(jnp.ones((c, c), dtype=bool))

    def step(state, inp):
        qi, ki, vi, bi = inp
        q_dec = qi * jnp.exp(bi)
        k_inv = ki * jnp.exp(-bi)
        scores = jnp.where(causal, jnp.einsum('bhtd,bhsd->bhts', q_dec, k_inv), 0.0)
        o = (jnp.einsum('bhts,bhsv->bhtv', scores, vi)
             + jnp.einsum('bhtd,bhdv->bhtv', q_dec, state))
        b_last = bi[:, :, -1:, :]
        k_end = ki * jnp.exp(b_last - bi)
        state = (state * jnp.exp(b_last)[:, :, 0, :, None]
                 + jnp.einsum('bhsd,bhsv->bhdv', k_end, vi))
        return state, o

    state0 = jnp.zeros((b, h, dk, dv), f32)
    _, o = lax.scan(step, state0, (qc, kc, vc, cum))
    o = _from_chunks(o)
    o = rms_norm(o, out_norm.reshape(h, dv)).reshape(b, s, GLA_DV)
    return (o.astype(x.dtype) * jax.nn.silu(r)) @ w_out


def rwkv7_mixer(x, mu, w_rkv, w0, w1, w2, a0, a1, a2, g1, g2, k_k, k_a, r_k, gn_g, gn_b, w_out):
    f32 = jnp.float32
    b, s, d = x.shape
    h, n = RWKV_HEADS, RWKV_HEAD
    x_prev = jnp.pad(x, ((0, 0), (1, 0), (0, 0)))[:, :-1]
    xx = x_prev - x
    xr, xw, xk, xv, xa, xg = (x + xx * mu[j] for j in range(RWKV_SHIFT_MIXES))
    r = xr @ w_rkv[0]
    k = xk @ w_rkv[1]
    v = xv @ w_rkv[2]
    w_log = -jax.nn.softplus(-(w0 + jnp.tanh(xw @ w1) @ w2).astype(f32)) - 0.5
    decay = jnp.exp(-jnp.exp(w_log))
    a = jax.nn.sigmoid((a0 + (xa @ a1) @ a2).astype(f32))
    g = jax.nn.sigmoid(xg @ g1) @ g2
    kk = (k * k_k).astype(f32).reshape(b, s, h, n)
    kk = kk / jnp.maximum(jnp.sqrt(jnp.sum(kk * kk, axis=-1, keepdims=True)), 1e-12)
    k = k.astype(f32) * (1.0 + (a - 1.0) * k_a.astype(f32))
    r = r.astype(f32).reshape(b, s, h, n)
    k = k.reshape(b, s, h, n)
    v = v.astype(f32).reshape(b, s, h, n)
    a = a.reshape(b, s, h, n)
    decay = decay.reshape(b, s, h, n)

    def step(state, inp):
        r_t, w_t, k_t, v_t, kk_t, a_t = inp
        sa = jnp.einsum('bhvk,bhk->bhv', state, -kk_t)
        state = (state * w_t[:, :, None, :]
                 + sa[..., None] * (kk_t * a_t)[:, :, None, :]
                 + v_t[..., None] * k_t[:, :, None, :])
        return state, jnp.einsum('bhvk,bhk->bhv', state, r_t)

    tm = lambda t: jnp.moveaxis(t, 1, 0)
    state0 = jnp.zeros((b, h, n, n), f32)
    _, y = lax.scan(step, state0, (tm(r), tm(decay), tm(k), tm(v), tm(kk), tm(a)))
    y = jnp.moveaxis(y, 0, 1)
    mean = jnp.mean(y, axis=-1, keepdims=True)
    var = jnp.mean(jnp.square(y - mean), axis=-1, keepdims=True)
    yn = ((y - mean) * lax.rsqrt(var + RWKV_GN_EPS)).reshape(b, s, d) * gn_g.astype(f32) + gn_b.astype(f32)
    bonus = jnp.sum(r * k * r_k.astype(f32).reshape(h, n), axis=-1, keepdims=True) * v
    out = (yn + bonus.reshape(b, s, d)).astype(x.dtype) * g
    return out @ w_out


def stick_breaking_mixer(x, w_qkv, w_out):
    f32 = jnp.float32
    b, s, d = x.shape
    h, dh, qb_len = SB_HEADS, SB_HEAD_DIM, SB_BLOCK
    q, k, v = jnp.split(x @ w_qkv, 3, axis=-1)
    q = q.reshape(b, s, h, dh) * dh ** -0.5
    k = k.reshape(b, s, h, dh)
    v = v.reshape(b, s, h, dh)
    n_blocks = s // qb_len
    q_blocks = q.reshape(b, n_blocks, qb_len, h, dh).transpose(1, 0, 3, 2, 4)
    starts = jnp.arange(n_blocks, dtype=jnp.int32) * qb_len
    key_pos = jnp.arange(s, dtype=jnp.int32)

    def block(args):
        q_blk, start = args
        z = jnp.einsum('bhqd,bkhd->bhqk', q_blk, k).astype(f32)
        q_pos = start + jnp.arange(qb_len, dtype=jnp.int32)
        before = key_pos[None, :] < q_pos[:, None]
        log_keep = jnp.where(before, jax.nn.log_sigmoid(-z), 0.0)
        suffix = lax.cumsum(log_keep, axis=3, reverse=True)
        log_w = jax.nn.log_sigmoid(z) + suffix - log_keep
        w = jnp.where(before, jnp.exp(log_w), 0.0)
        return jnp.einsum('bhqk,bkhd->bhqd', w.astype(v.dtype), v)

    o = lax.map(block, (q_blocks, starts))
    o = o.transpose(1, 0, 3, 2, 4).reshape(b, s, d)
    return o @ w_out


def mlstm_mixer(x, w_in, b_if, out_norm, w_out):
    f32 = jnp.float32
    b, s, _ = x.shape
    h, dk, dv, c = ML_HEADS, ML_DK // ML_HEADS, ML_DV // ML_HEADS, ML_CHUNK
    proj = x @ w_in
    q, k, v, o_pre, if_pre = jnp.split(
        proj, [ML_DK, 2 * ML_DK, 2 * ML_DK + ML_DV, 2 * ML_DK + 2 * ML_DV], axis=-1)
    if_pre = (if_pre + b_if).astype(f32)
    i_pre = if_pre[..., :h]
    log_f = jax.nn.log_sigmoid(if_pre[..., h:])
    qc = _to_chunks(q.astype(f32).reshape(b, s, h, dk), c)
    kc = _to_chunks(k.astype(f32).reshape(b, s, h, dk) * dk ** -0.5, c)
    vc = _to_chunks(v.astype(f32).reshape(b, s, h, dv), c)
    ic = _gates_to_chunks(i_pre, c)
    cum_f = jnp.cumsum(_gates_to_chunks(log_f, c), axis=-1)
    causal = jnp.tril(jnp.ones((c, c), dtype=bool))

    def step(carry, inp):
        c_st, n_st, m_prev = carry
        qi, ki, vi, ii, bi = inp
        d_log = jnp.where(causal, bi[..., :, None] - bi[..., None, :] + ii[..., None, :], -jnp.inf)
        inter = bi + m_prev[..., None]
        m_t = jnp.maximum(inter, jnp.max(d_log, axis=-1))
        w_intra = jnp.exp(d_log - m_t[..., None])
        scale = jnp.exp(inter - m_t)
        qk = jnp.einsum('bhtd,bhsd->bhts', qi, ki) * w_intra
        num = (jnp.einsum('bhts,bhsv->bhtv', qk, vi)
               + scale[..., None] * jnp.einsum('bhtd,bhdv->bhtv', qi, c_st))
        den = jnp.sum(qk, axis=-1) + scale * jnp.einsum('bhtd,bhd->bht', qi, n_st)
        h_out = num / jnp.maximum(jnp.abs(den), jnp.exp(-m_t))[..., None]
        b_last = bi[..., -1]
        g_end = b_last[..., None] - bi + ii
        m_new = jnp.maximum(b_last + m_prev, jnp.max(g_end, axis=-1))
        w_end = jnp.exp(g_end - m_new[..., None])
        carry_scale = jnp.exp(b_last + m_prev - m_new)
        c_st = carry_scale[..., None, None] * c_st + jnp.einsum('bhs,bhsd,bhsv->bhdv', w_end, ki, vi)
        n_st = carry_scale[..., None] * n_st + jnp.einsum('bhs,bhsd->bhd', w_end, ki)
        return (c_st, n_st, m_new), h_out

    carry0 = (jnp.zeros((b, h, dk, dv), f32), jnp.zeros((b, h, dk), f32), jnp.zeros((b, h), f32))
    _, hs = lax.scan(step, carry0, (qc, kc, vc, ic, cum_f))
    hs = _from_chunks(hs)
    hs = rms_norm(hs, out_norm.reshape(h, dv)).reshape(b, s, ML_DV)
    return (hs.astype(x.dtype) * jax.nn.sigmoid(o_pre)) @ w_out


def conv_ffn(x, w_up, conv_w, conv_b, w_down):
    s = x.shape[1]
    u = x @ w_up
    u_pad = jnp.pad(u, ((0, 0), (CONV_WIDTH - 1, 0), (0, 0)))
    u = sum(u_pad[:, j:j + s] * conv_w[j] for j in range(CONV_WIDTH)) + conv_b
    gate, up = jnp.split(u, 2, axis=-1)
    return (jax.nn.silu(gate) * up) @ w_down


def setup_inputs(seed: int = 0) -> dict:
    key = jax.random.key(seed)
    ks = iter(jax.random.split(key, 96))
    f32 = jnp.float32
    D, F2 = D_MODEL, 2 * FFN_DIM

    def nrm(shape, scale):
        return scale * jax.random.normal(next(ks), shape, f32)

    def dense(fan_in, shape):
        return nrm(shape, fan_in ** -0.5)

    def gain(n):
        return 1.0 + nrm((n,), 0.02)

    def unif(shape, lo, hi):
        return jax.random.uniform(next(ks), shape, f32, lo, hi)

    p = {}

    def ffn_params(i):
        p[f"l{i}_norm2"] = gain(D)
        p[f"l{i}_ffn_w_up"] = dense(D, (D, F2))
        p[f"l{i}_ffn_conv_w"] = dense(CONV_WIDTH, (CONV_WIDTH, F2))
        p[f"l{i}_ffn_conv_b"] = nrm((F2,), 0.02)
        p[f"l{i}_ffn_w_down"] = dense(FFN_DIM, (FFN_DIM, D))

    p["x"] = nrm((BATCH, SEQ, D), 1.0)
    p["l0_norm1"] = gain(D)
    p["l0_gla_w_in"] = dense(D, (D, GLA_IN))
    p["l0_gla_w_alpha_up"] = dense(GLA_RANK, (GLA_RANK, GLA_DK))
    p["l0_gla_b_alpha"] = nrm((GLA_DK,), 0.1)
    p["l0_gla_out_norm"] = gain(GLA_DV)
    p["l0_gla_w_out"] = dense(GLA_DV, (GLA_DV, D))
    ffn_params(0)
    p["l1_norm1"] = gain(D)
    p["l1_rwkv_mu"] = unif((RWKV_SHIFT_MIXES, D), 0.0, 1.0)
    p["l1_rwkv_w_rkv"] = dense(D, (3, D, D))
    p["l1_rwkv_w0"] = unif((D,), -6.0, -1.0)
    p["l1_rwkv_w1"] = dense(D, (D, RWKV_DECAY_RANK))
    p["l1_rwkv_w2"] = nrm((RWKV_DECAY_RANK, D), 0.1 * RWKV_DECAY_RANK ** -0.5)
    p["l1_rwkv_a0"] = nrm((D,), 0.1)
    p["l1_rwkv_a1"] = dense(D, (D, RWKV_A_RANK))
    p["l1_rwkv_a2"] = dense(RWKV_A_RANK, (RWKV_A_RANK, D))
    p["l1_rwkv_g1"] = dense(D, (D, RWKV_GATE_RANK))
    p["l1_rwkv_g2"] = dense(RWKV_GATE_RANK, (RWKV_GATE_RANK, D))
    p["l1_rwkv_k_k"] = 0.85 + nrm((D,), 0.05)
    p["l1_rwkv_k_a"] = 1.0 + nrm((D,), 0.05)
    p["l1_rwkv_r_k"] = nrm((D,), 0.1)
    p["l1_rwkv_gn_g"] = gain(D)
    p["l1_rwkv_gn_b"] = nrm((D,), 0.02)
    p["l1_rwkv_w_out"] = dense(D, (D, D))
    ffn_params(1)
    p["l2_norm1"] = gain(D)
    p["l2_sb_w_qkv"] = dense(D, (D, 3 * D))
    p["l2_sb_w_out"] = dense(D, (D, D))
    ffn_params(2)
    p["l3_norm1"] = gain(D)
    p["l3_ml_w_in"] = dense(D, (D, ML_IN))
    p["l3_ml_b_if"] = jnp.concatenate([nrm((ML_HEADS,), 0.1), unif((ML_HEADS,), 3.0, 6.0)])
    p["l3_ml_out_norm"] = gain(ML_DV)
    p["l3_ml_w_out"] = dense(ML_DV, (ML_DV, D))
    ffn_params(3)
    p["final_norm"] = gain(D)
    return p


def reference(x,
              l0_norm1, l0_gla_w_in, l0_gla_w_alpha_up, l0_gla_b_alpha, l0_gla_out_norm, l0_gla_w_out,
              l0_norm2, l0_ffn_w_up, l0_ffn_conv_w, l0_ffn_conv_b, l0_ffn_w_down,
              l1_norm1, l1_rwkv_mu, l1_rwkv_w_rkv, l1_rwkv_w0, l1_rwkv_w1, l1_rwkv_w2,
              l1_rwkv_a0, l1_rwkv_a1, l1_rwkv_a2, l1_rwkv_g1, l1_rwkv_g2,
              l1_rwkv_k_k, l1_rwkv_k_a, l1_rwkv_r_k, l1_rwkv_gn_g, l1_rwkv_gn_b, l1_rwkv_w_out,
              l1_norm2, l1_ffn_w_up, l1_ffn_conv_w, l1_ffn_conv_b, l1_ffn_w_down,
              l2_norm1, l2_sb_w_qkv, l2_sb_w_out,
              l2_norm2, l2_ffn_w_up, l2_ffn_conv_w, l2_ffn_conv_b, l2_ffn_w_down,
              l3_norm1, l3_ml_w_in, l3_ml_b_if, l3_ml_out_norm, l3_ml_w_out,
              l3_norm2, l3_ffn_w_up, l3_ffn_conv_w, l3_ffn_conv_b, l3_ffn_w_down,
              final_norm):
    mixers = (
        lambda h: gla_mixer(h, l0_gla_w_in, l0_gla_w_alpha_up, l0_gla_b_alpha, l0_gla_out_norm, l0_gla_w_out),
        lambda h: rwkv7_mixer(h, l1_rwkv_mu, l1_rwkv_w_rkv, l1_rwkv_w0, l1_rwkv_w1, l1_rwkv_w2,
                              l1_rwkv_a0, l1_rwkv_a1, l1_rwkv_a2, l1_rwkv_g1, l1_rwkv_g2,
                              l1_rwkv_k_k, l1_rwkv_k_a, l1_rwkv_r_k, l1_rwkv_gn_g, l1_rwkv_gn_b,
                              l1_rwkv_w_out),
        lambda h: stick_breaking_mixer(h, l2_sb_w_qkv, l2_sb_w_out),
        lambda h: mlstm_mixer(h, l3_ml_w_in, l3_ml_b_if, l3_ml_out_norm, l3_ml_w_out),
    )
    norm1 = (l0_norm1, l1_norm1, l2_norm1, l3_norm1)
    norm2 = (l0_norm2, l1_norm2, l2_norm2, l3_norm2)
    ffns = (
        (l0_ffn_w_up, l0_ffn_conv_w, l0_ffn_conv_b, l0_ffn_w_down),
        (l1_ffn_w_up, l1_ffn_conv_w, l1_ffn_conv_b, l1_ffn_w_down),
        (l2_ffn_w_up, l2_ffn_conv_w, l2_ffn_conv_b, l2_ffn_w_down),
        (l3_ffn_w_up, l3_ffn_conv_w, l3_ffn_conv_b, l3_ffn_w_down),
    )
    for layer in range(DEPTH):
        x = x + mixers[layer % N_MIXERS](rms_norm(x, norm1[layer]))
        x = x + conv_ffn(rms_norm(x, norm2[layer]), *ffns[layer])
    return rms_norm(x, final_norm)
```

```cpp
#include <hip/hip_runtime.h>
#include <hip/hip_cooperative_groups.h>
#include <cstdio>
#include <cstdint>
namespace cg = cooperative_groups;

#define LAS __attribute__((address_space(3)))
typedef unsigned short bf16_t;
typedef short bf16x8 __attribute__((ext_vector_type(8)));
typedef float f32x4 __attribute__((ext_vector_type(4)));
typedef unsigned u32x4 __attribute__((ext_vector_type(4)));
typedef unsigned u32x2 __attribute__((ext_vector_type(2)));
typedef unsigned long long ull;

#ifndef EN_GLA
#define EN_GLA 1
#endif
#ifndef EN_RWKV
#define EN_RWKV 1
#endif
#ifndef EN_SB
#define EN_SB 1
#endif
#ifndef EN_ML
#define EN_ML 1
#endif
#ifndef EN_FFN
#define EN_FFN 1
#endif
#define REPMASK 0
#define XSYNC 0

constexpr int M = 16384, D = 1024, FF = 2816, FF2 = 5632;
constexpr unsigned MiB = 1u << 20;
constexpr unsigned WS_SMALL = 0;
constexpr unsigned SM_DTOT = 0;
constexpr unsigned SM_NST = 512 * 1024;
constexpr unsigned SM_BL = 1024 * 1024;
constexpr unsigned SM_ML = SM_BL + 4096;
constexpr unsigned SM_MST = SM_ML + 4096;
constexpr unsigned SM_UH = SM_MST + 4096;
constexpr unsigned SM_SC = 2 * MiB;
constexpr unsigned SM_BAR = 3 * MiB;
constexpr unsigned WS_W = 4 * MiB;
constexpr unsigned WS_ACT = 22 * MiB;
constexpr unsigned A0 = WS_ACT;
constexpr unsigned A_U = WS_ACT + 32 * MiB;
constexpr unsigned A_H = WS_ACT + 120 * MiB;
constexpr unsigned A_P = WS_ACT + 32 * MiB;
constexpr unsigned A_BS = WS_ACT + 136 * MiB;
constexpr unsigned A_P1 = WS_ACT + 64 * MiB;
constexpr unsigned A_Y = WS_ACT + 168 * MiB;
constexpr unsigned A_RA = WS_ACT + 32 * MiB;
constexpr size_t WS_NEED = 256ull * MiB;
constexpr unsigned W_GLA_IN = WS_W, W_GLA_OUT = WS_W + 3328u * 1024 * 2;
constexpr unsigned W_UP = WS_W, W_DOWN = WS_W + 5632u * 1024 * 2;
constexpr unsigned W_R1 = WS_W, W_R2A = W_R1 + 3328u * 2048 * 2, W_R2G = W_R2A + 2048u * 256 * 2, W_ROUT = W_R2G + 1024u * 256 * 2;
constexpr unsigned W_QKV = WS_ACT + 208 * MiB, W_SBOUT = W_QKV + 3072u * 1024 * 2;
constexpr unsigned WF_A = WS_ACT + 208 * MiB, WF_B = WS_ACT + 216 * MiB + 512 * 1024;
constexpr unsigned DOWN_OFF = 5632u * 1024 * 2;
static_assert(W_ROUT + 2u * MiB <= WS_ACT && W_DOWN + 1024u * 2816 * 2 <= WS_ACT, "weights region");
constexpr int RING_BYTES = 131072, PT_OFF = RING_BYTES, LDS_BYTES = 147456;

struct ConvJob { int in_idx, in_off, K, N, NP, KP, k_off, col_base, ldo, row_off, sc_off, sc_mode; unsigned out_off; int perm; };
#define MU(j) ((j) * 1024)
__constant__ ConvJob JOBS[] = {
    {2, 0, 1024, 3088, 3328, 1024, 0, 0, 1024, 0, 0, 0, W_GLA_IN},
    {6, 0, 1024, 1024, 1024, 1024, 0, 0, 1024, 0, 0, 0, W_GLA_OUT},
    {14, 0,       1024, 1024, 1024, 1024, 0, 0,    2048, 0,    MU(0), 2, W_R1},
    {14, 0,       1024, 1024, 1024, 1024, 0, 1024, 2048, 0,    MU(0), 1, W_R1},
    {14, 1048576, 1024, 1024, 1024, 1024, 0, 0,    2048, 1024, MU(2), 2, W_R1},
    {14, 1048576, 1024, 1024, 1024, 1024, 0, 1024, 2048, 1024, MU(2), 1, W_R1},
    {14, 2097152, 1024, 1024, 1024, 1024, 0, 0,    2048, 2048, MU(3), 2, W_R1},
    {14, 2097152, 1024, 1024, 1024, 1024, 0, 1024, 2048, 2048, MU(3), 1, W_R1},
    {16, 0, 1024, 64, 64, 1024, 0, 0,    2048, 3072, MU(1), 2, W_R1},
    {16, 0, 1024, 64, 64, 1024, 0, 1024, 2048, 3072, MU(1), 1, W_R1},
    {19, 0, 1024, 64, 64, 1024, 0, 0,    2048, 3136, MU(4), 2, W_R1},
    {19, 0, 1024, 64, 64, 1024, 0, 1024, 2048, 3136, MU(4), 1, W_R1},
    {21, 0, 1024, 128, 128, 1024, 0, 0,    2048, 3200, MU(5), 2, W_R1},
    {21, 0, 1024, 128, 128, 1024, 0, 1024, 2048, 3200, MU(5), 1, W_R1},
    {17, 0, 64, 1024, 1024, 256, 0, 0, 256, 0, 0, 0, W_R2A},
    {20, 0, 64, 1024, 1024, 256, 64, 0, 256, 1024, 0, 0, W_R2A},
    {22, 0, 128, 1024, 1024, 256, 128, 0, 256, 0, 0, 0, W_R2G},
    {28, 0, 1024, 1024, 1024, 1024, 0, 0, 1024, 0, 0, 0, W_ROUT},
    {35, 0, 1024, 3072, 3072, 1024, 0, 0, 1024, 0, 0, 0, W_QKV},
    {36, 0, 1024, 1024, 1024, 1024, 0, 0, 1024, 0, 0, 0, W_SBOUT},
    {43, 0, 1024, 3080, 3328, 1024, 0, 0, 1024, 0, 0, 0, W_GLA_IN},
    {46, 0, 1024, 1024, 1024, 1024, 0, 0, 1024, 0, 0, 0, W_GLA_OUT},
    {8, 0, 1024, 5632, 5632, 1024, 0, 0, 1024, 0, 0, 0, WF_A, 1},   {11, 0, 2816, 1024, 1024, 2816, 0, 0, 2816, 0, 0, 0, WF_A + DOWN_OFF},
    {30, 0, 1024, 5632, 5632, 1024, 0, 0, 1024, 0, 0, 0, W_UP, 1},  {33, 0, 2816, 1024, 1024, 2816, 0, 0, 2816, 0, 0, 0, W_DOWN},
    {38, 0, 1024, 5632, 5632, 1024, 0, 0, 1024, 0, 0, 0, WF_B, 1},  {41, 0, 2816, 1024, 1024, 2816, 0, 0, 2816, 0, 0, 0, WF_B + DOWN_OFF},
    {48, 0, 1024, 5632, 5632, 1024, 0, 0, 1024, 0, 0, 0, WF_A, 1},  {51, 0, 2816, 1024, 1024, 2816, 0, 0, 2816, 0, 0, 0, WF_A + DOWN_OFF},
};

enum { K_PREP = 0, K_GEMM, K_GEMMR, K_CLOCAL, K_CSCAN, K_COUT, K_CONV, K_RREC, K_RPOST, K_SB, K_FINAL, K_RP1, K_RSCAN, K_NOP };
struct PhaseDesc { int kind; unsigned a, b, c; int lda, K, Mr, N, ldc, act, x0, x1, sj0, sj1; };
#define FFN_PHASES(fb, wf, pj0, pj1, sj0_, sj1_) \
  {K_PREP, A0 + 4096u, 0, 0, 4, fb, 0, 0, 0, 0, pj0, pj1, 0, 0}, \
  {EN_FFN ? K_GEMM : K_NOP, A0, wf, 0, 1024, 1024, 16640, 5632, 0, 2, 0, fb, sj0_, sj1_}, \
  {EN_FFN ? K_GEMMR : K_NOP, A_H, (wf) + DOWN_OFF, 0, 2816, 2816, 16384, 1024, 0, 0, 0, 0, 0, 0}
__constant__ PhaseDesc PROG[] = {
  {K_PREP, A0, 0, 0, 1, 1, 0, 0, 0, 0, 0, 2},
  {EN_GLA ? K_GEMM : K_NOP, A0, W_GLA_IN, A_P, 1024, 1024, 16384, 3328, 3328, 0, 0, 0},
  {EN_GLA ? K_CLOCAL : K_NOP, 0, 0, 0, 0, 0, 0, 0, 0, 0, 0, 0},
  {EN_GLA ? K_CSCAN : K_NOP, 0, 0, 0, 0, 0, 0, 0, 0, 0, 0, 0},
  {EN_GLA ? K_COUT : K_NOP, 0, 0, 0, 0, 0, 0, 0, 0, 0, 0, 0, 22, 24},
  {EN_GLA ? K_GEMMR : K_NOP, A0, W_GLA_OUT, 0, 1024, 1024, 16384, 1024, 0, 0, 0, 0},
  FFN_PHASES(7, WF_A, 0, 0, 2, 18),
  {K_PREP, A0, 0, 0, 2, 12, 0, 0, 0, 0, 0, 0, 0, 0},
  {EN_RWKV ? K_GEMM : K_NOP, A0, W_R1, A_P1, 2048, 2048, 16384, 3328, 3328, 1, 0, 0},
  {EN_RWKV ? K_GEMM : K_NOP, A_P1 + 3072u * 2, W_R2A, A0, 3328, 256, 16384, 2048, 2048, 0, 0, 0},
  {EN_RWKV ? K_RP1 : K_NOP, 0, 0, 0, 0, 0, 0, 0, 0, 0, 0, 0},
  {EN_RWKV ? K_RSCAN : K_NOP, 0, 0, 0, 0, 0, 0, 0, 0, 0, 0, 0},
  {EN_RWKV ? K_RREC : K_NOP, 0, 0, 0, 0, 0, 0, 0, 0, 0, 0, 0},
  {EN_RWKV ? K_GEMM : K_NOP, A_P1 + 3072u * 2, W_R2G, A0, 3328, 256, 16384, 1024, 1024, 0, 0, 0},
  {EN_RWKV ? K_RPOST : K_NOP, 0, 0, 0, 0, 0, 0, 0, 0, 0, 0, 0},
  {EN_RWKV ? K_GEMMR : K_NOP, A_RA, W_ROUT, 0, 1024, 1024, 16384, 1024, 0, 0, 0, 0},
  FFN_PHASES(29, W_UP, 24, 26, 18, 20),
  {K_PREP, A0, 0, 0, 0, 34, 0, 0, 0, 0, 0, 0, 0, 0},
  {EN_SB ? K_GEMM : K_NOP, A0, W_QKV, A_P, 1024, 1024, 16384, 3072, 3072, 0, 0, 0},
  {EN_SB ? K_SB : K_NOP, 0, 0, 0, 0, 0, 0, 0, 0, 0, 0, 0, 26, 28},
  {EN_SB ? K_GEMMR : K_NOP, A0, W_SBOUT, 0, 1024, 1024, 16384, 1024, 0, 0, 0, 0},
  FFN_PHASES(37, WF_B, 0, 0, 20, 22),
  {K_PREP, A0, 0, 0, 0, 42, 0, 0, 0, 0, 0, 0, 0, 0},
  {EN_ML ? K_GEMM : K_NOP, A0, W_GLA_IN, A_P, 1024, 1024, 16384, 3328, 3328, 0, 0, 0},
  {EN_ML ? K_CLOCAL : K_NOP, 0, 0, 0, 0, 0, 0, 0, 0, 0, 1, 0},
  {EN_ML ? K_CSCAN : K_NOP, 0, 0, 0, 0, 0, 0, 0, 0, 0, 1, 0},
  {EN_ML ? K_COUT : K_NOP, 0, 0, 0, 0, 0, 0, 0, 0, 0, 1, 0, 28, 30},
  {EN_ML ? K_GEMMR : K_NOP, A0, W_GLA_OUT, 0, 1024, 1024, 16384, 1024, 0, 0, 0, 0},
  FFN_PHASES(47, WF_A, 0, 0, 0, 0),
  {K_FINAL, 0, 0, 0, 0, 52, 0, 0, 0, 0, 0, 0},
};
constexpr int NPH = sizeof(PROG) / sizeof(PhaseDesc);

__device__ __forceinline__ int opaque_tid_w(int wid_s) { unsigned z = 0u; asm volatile("" : "+v"(z)); int t = (wid_s << 6) | (int)__builtin_amdgcn_mbcnt_hi(~0u, __builtin_amdgcn_mbcnt_lo(~0u, z)); return t; }
__device__ __forceinline__ unsigned f2bf(float f) { unsigned u = __builtin_bit_cast(unsigned, f); return (u + 0x7fffu + ((u >> 16) & 1u)) >> 16; }
__device__ __forceinline__ float bf2f(unsigned b) { return __builtin_bit_cast(float, b << 16); }
__device__ __forceinline__ unsigned pk2(float lo, float hi) { return f2bf(lo) | (f2bf(hi) << 16); }
__device__ __forceinline__ float bflo(unsigned w) { return __builtin_bit_cast(float, w << 16); }
__device__ __forceinline__ float bfhi(unsigned w) { return __builtin_bit_cast(float, w & 0xffff0000u); }
template <int MASK> __device__ __forceinline__ float sx(float v) { return __builtin_bit_cast(float, __builtin_amdgcn_ds_swizzle(__builtin_bit_cast(int, v), (MASK << 10) | 0x1f)); }
template <int Q> __device__ __forceinline__ float quad_bcast(float v) { return __builtin_bit_cast(float, __builtin_amdgcn_update_dpp(0, __builtin_bit_cast(int, v), Q * 0x55, 0xf, 0xf, false)); }
__device__ __forceinline__ float wave_sum(float v) {
#pragma unroll
  for (int o = 1; o < 64; o <<= 1) v += __shfl_xor(v, o);
  return v;
}
__device__ __forceinline__ float logsig(float z) { return fminf(z, 0.f) - __logf(1.f + __expf(-fabsf(z))); }
__device__ __forceinline__ float sigm(float z) { return 1.f / (1.f + __expf(-z)); }
__device__ __forceinline__ float dpp_row_shr(float v, int n) {
  const int iv = __builtin_bit_cast(int, v); int r;
  switch (n) { case 1: r = __builtin_amdgcn_update_dpp(0, iv, 0x111, 0xf, 0xf, true); break; case 2: r = __builtin_amdgcn_update_dpp(0, iv, 0x112, 0xf, 0xf, true); break;
               case 4: r = __builtin_amdgcn_update_dpp(0, iv, 0x114, 0xf, 0xf, true); break; default: r = __builtin_amdgcn_update_dpp(0, iv, 0x118, 0xf, 0xf, true); break; }
  return __builtin_bit_cast(float, r);
}
__device__ __forceinline__ float wave_scan63(float v) {
  v += dpp_row_shr(v, 1); v += dpp_row_shr(v, 2); v += dpp_row_shr(v, 4); v += dpp_row_shr(v, 8);
  v += __builtin_bit_cast(float, __builtin_amdgcn_update_dpp(0, __builtin_bit_cast(int, v), 0x142, 0xa, 0xf, false));
  v += __builtin_bit_cast(float, __builtin_amdgcn_update_dpp(0, __builtin_bit_cast(int, v), 0x143, 0xc, 0xf, false));
  return v;
}
__device__ __forceinline__ f32x4 mfma16(bf16x8 a, bf16x8 b, f32x4 c) { return __builtin_amdgcn_mfma_f32_16x16x32_bf16(a, b, c, 0, 0, 0); }
#define LDSV8(off) (*(const LAS bf16x8*)(lds + (off)))

namespace pg8 {
constexpr int BM = 256, BK = 64, HALF = 128, HTB = HALF * BK * 2, NXCD = 8, WGM = 8;
__device__ __forceinline__ int lds_byte(int r, int c) { const int st = (r >> 4) * 2 + (c >> 5), rr = r & 15, cc = c & 31, ob = rr * 64 + cc * 2; return st * 1024 + (ob ^ (((ob >> 9) & 1) << 5)); }
__device__ __forceinline__ void stage_rc(int b, int& R, int& C) { const int st = b / 1024, sb = b % 1024, swz = sb ^ (((sb >> 9) & 1) << 5); R = (st >> 1) * 16 + swz / 64; C = (st & 1) * 32 + (swz % 64) / 2; }
__device__ __forceinline__ int perm32(int rho) { const int n = rho >> 4, i = rho & 15; return 8 * (i >> 2) + 4 * n + (i & 3); }
struct Unit { int pm, pn; };
struct Gemm { const bf16_t* A; const bf16_t* Bt; int M, N, K, lda, mrows; };
struct StaticOrder {
  int nM, nN, nwg, G, c;
  __device__ void init(int M_, int N_, int G_, int c_) { nM = M_ / BM; nN = N_ / BM; nwg = nM * nN; G = G_; c = c_; }
  __device__ bool next(int i, Unit& u) const {
    const long L = (long)i * G + c; if (L >= nwg) return false;
    int wgid = (int)L; { const int q = nwg / NXCD, r = nwg % NXCD, xcd = wgid % NXCD, off = wgid / NXCD; wgid = (xcd < r ? xcd * (q + 1) : r * (q + 1) + (xcd - r) * q) + off; }
    const int nig = WGM * nN, gid = wgid / nig, fm = gid * WGM, gsz = (nM - fm) < WGM ? (nM - fm) : WGM;
    u.pm = fm + ((wgid % nig) % gsz); u.pn = (wgid % nig) / gsz; return true;
  }
};
__device__ __forceinline__ unsigned cvt_pk_bf16(float lo, float hi) { unsigned r; asm volatile("v_cvt_pk_bf16_f32 %0, %1, %2" : "=v"(r) : "v"(lo), "v"(hi)); return r; }

struct EpiBf16 {
  static constexpr bool PERM = true;
  bf16_t* O; int ldc; int act;
  __device__ __forceinline__ void operator()(const f32x4 (&acc)[2][2][4][2], const Unit& u, int wr, int wc, int fr, int fq) const {
    const int row0 = u.pm * BM + wr * 64 + fr; const int col0 = u.pn * BM + wc * 32 + 8 * fq;
    const bool sp = (act == 1) && (u.pn == 12);
#pragma unroll
    for (int ai = 0; ai < 2; ++ai)
#pragma unroll
      for (int m = 0; m < 4; ++m) { bf16_t* rowp = O + (size_t)(row0 + ai * HALF + m * 16) * ldc + col0;
#pragma unroll
        for (int bj = 0; bj < 2; ++bj) { f32x4 v0 = acc[ai][bj][m][0], v1 = acc[ai][bj][m][1];
          if (sp) {
            if (bj == 1) { for (int e = 0; e < 4; ++e) { v0[e] = sigm(v0[e]); v1[e] = sigm(v1[e]); } }
            else if (wc < 2) { for (int e = 0; e < 4; ++e) { v0[e] = tanhf(v0[e]); v1[e] = tanhf(v1[e]); } }
          }
          u32x4 w; w.x = cvt_pk_bf16(v0[0], v0[1]); w.y = cvt_pk_bf16(v0[2], v0[3]); w.z = cvt_pk_bf16(v1[0], v1[1]); w.w = cvt_pk_bf16(v1[2], v1[3]);
          *(u32x4*)(rowp + bj * HALF) = w; } }
  }
};
struct EpiResid {
  static constexpr bool PERM = false;
  float* X;
  __device__ __forceinline__ void operator()(const f32x4 (&acc)[2][2][4][2], const Unit& u, int wr, int wc, int fr, int fq) const {
#pragma unroll
    for (int ai = 0; ai < 2; ++ai)
#pragma unroll
      for (int m = 0; m < 4; ++m) { const int row = u.pm * BM + ai * HALF + wr * 64 + m * 16 + fr;
#pragma unroll
        for (int bj = 0; bj < 2; ++bj)
#pragma unroll
          for (int n = 0; n < 2; ++n) { f32x4* p = (f32x4*)(X + (size_t)row * 1024 + u.pn * BM + bj * HALF + wc * 32 + n * 16 + 4 * fq); *p = *p + acc[ai][bj][m][n]; } }
  }
};

__device__ __forceinline__ float dpp_ror1(float v) { return __builtin_bit_cast(float, __builtin_amdgcn_update_dpp(0, __builtin_bit_cast(int, v), 0x121, 0xf, 0xf, false)); }
__device__ __forceinline__ float dpp_ror2(float v) { return __builtin_bit_cast(float, __builtin_amdgcn_update_dpp(0, __builtin_bit_cast(int, v), 0x122, 0xf, 0xf, false)); }
struct EpiFfn {
  bf16_t* H; int fb; LAS unsigned char* ldsb;
  __device__ __forceinline__ void operator()(const f32x4 (&acc)[2][2][4][2], const Unit& u, int wr, int wc, int fr, int fq) const {
    LAS float* HB = (LAS float*)(ldsb + PT_OFF + 2048); const LAS ull* PTt = (const LAS ull*)(ldsb + PT_OFF);
    const float* cw = (const float*)(const __attribute__((address_space(1))) float*)PTt[fb + 2]; const float* cb = (const float*)(const __attribute__((address_space(1))) float*)PTt[fb + 3];
    if (fr >= 14) {
#pragma unroll
      for (int ai = 0; ai < 2; ++ai)
#pragma unroll
        for (int bj = 0; bj < 2; ++bj)
#pragma unroll
          for (int n = 0; n < 2; ++n) *(LAS f32x4*)(HB + ((ai * 2 + wr) * 2 + (fr - 14)) * 256 + bj * 128 + wc * 32 + 8 * fq + 4 * n) = acc[ai][bj][3][n];
    }
    asm volatile("s_waitcnt lgkmcnt(0)" ::: "memory"); __builtin_amdgcn_s_barrier(); asm volatile("" ::: "memory");
    const int c0 = u.pn * 128 + wc * 32 + 8 * fq;
#pragma unroll
    for (int n = 0; n < 2; ++n) {
      asm volatile("" ::: "memory");
      const int c = c0 + 4 * n;
      const f32x4 wg0 = *(const f32x4*)(cw + c), wg1 = *(const f32x4*)(cw + FF2 + c), wg2 = *(const f32x4*)(cw + 2 * FF2 + c), bg = *(const f32x4*)(cb + c);
      const f32x4 wu0 = *(const f32x4*)(cw + FF + c), wu1 = *(const f32x4*)(cw + FF2 + FF + c), wu2 = *(const f32x4*)(cw + 2 * FF2 + FF + c), bu = *(const f32x4*)(cb + FF + c);
#pragma unroll
      for (int ai = 0; ai < 2; ++ai) {
        asm volatile("" ::: "memory");
        f32x4 hg1 = (f32x4){0.f, 0.f, 0.f, 0.f}, hg2 = hg1, hu1 = hg1, hu2 = hg1;
        const int ps = (wr == 1) ? ai * 2 : (ai == 1 ? 1 : -1);
        if (ps >= 0 && fr < 2) { const LAS float* hb = HB + ps * 512 + wc * 32 + 8 * fq + 4 * n;
          const f32x4 g62 = *(const LAS f32x4*)(hb), g63 = *(const LAS f32x4*)(hb + 256), u62 = *(const LAS f32x4*)(hb + 128), u63 = *(const LAS f32x4*)(hb + 256 + 128);
          hg1 = g63; hu1 = u63; hg2 = (fr == 0) ? g62 : g63; hu2 = (fr == 0) ? u62 : u63; }
#pragma unroll
        for (int m = 0; m < 4; ++m) {
          const f32x4 xg = acc[ai][0][m][n], xu = acc[ai][1][m][n];
          float hh[4];
#pragma unroll
          for (int e = 0; e < 4; ++e) {
            const float tg1 = dpp_ror1(xg[e]), tg2 = dpp_ror2(xg[e]), tu1 = dpp_ror1(xu[e]), tu2 = dpp_ror2(xu[e]);
            float qg1, qg2, qu1, qu2;
            if (m > 0) { qg1 = dpp_ror1(acc[ai][0][m - 1][n][e]); qg2 = dpp_ror2(acc[ai][0][m - 1][n][e]); qu1 = dpp_ror1(acc[ai][1][m - 1][n][e]); qu2 = dpp_ror2(acc[ai][1][m - 1][n][e]); }
            else { qg1 = hg1[e]; qg2 = hg2[e]; qu1 = hu1[e]; qu2 = hu2[e]; }
            const float pg1 = (fr == 0) ? qg1 : tg1, pg2 = (fr < 2) ? qg2 : tg2, pu1 = (fr == 0) ? qu1 : tu1, pu2 = (fr < 2) ? qu2 : tu2;
            const float gv = wg0[e] * pg2 + wg1[e] * pg1 + wg2[e] * xg[e] + bg[e];
            const float uv = wu0[e] * pu2 + wu1[e] * pu1 + wu2[e] * xu[e] + bu[e];
            hh[e] = gv * __builtin_amdgcn_rcpf(1.f + __expf(-gv)) * uv;
          }
          const int rl = ai * HALF + wr * 64 + m * 16 + fr; const int gr = 254 * u.pm - 2 + rl;
          if (rl >= 2 && gr < 16384) { u32x2 w; w.x = cvt_pk_bf16(hh[0], hh[1]); w.y = cvt_pk_bf16(hh[2], hh[3]); *(u32x2*)(H + (size_t)gr * 2816 + c) = w; }
          asm volatile("" ::: "memory"); __builtin_amdgcn_sched_barrier(0);
        }
      }
    }
  }
};
struct EpiAny {
  int mode; void* P; int ldc, act, fb; LAS unsigned char* ldsb;
  bool perm_() const { return mode != 0; }
  __device__ __forceinline__ void operator()(const f32x4 (&acc)[2][2][4][2], const Unit& u, int wr, int wc, int fr, int fq) const {
    if (mode == 2) { EpiFfn ef{(bf16_t*)P, fb, ldsb}; ef(acc, u, wr, wc, fr, fq); }
    else if (mode == 1) { EpiBf16 eb{(bf16_t*)P, ldc, act}; eb(acc, u, wr, wc, fr, fq); }
    else { EpiResid er{(float*)P}; er(acc, u, wr, wc, fr, fq); }
  }
};
template <class Epi>
__device__ __forceinline__ void gemm_phase(LAS unsigned char* lds, const Gemm g, const StaticOrder& S, const Epi& E, int wid_s) {
  const int tid = opaque_tid_w(wid_s), wid = __builtin_amdgcn_readfirstlane(tid >> 6), lane = tid & 63, wr = wid >> 2, wc = wid & 3, fr = lane & 15, fq = lane >> 4;
  const int K = g.K, nt = K / BK, lda = g.lda;
  unsigned voffA[2], voffB[2];
#pragma unroll
  for (int i = 0; i < 2; ++i) { int R, C; stage_rc(tid * 16 + i * 8192, R, C); const int Rb = (E.mode != 0) ? ((R & ~31) + perm32(R & 31)) : R;
    voffA[i] = (unsigned)(R * lda + C) * 2u; voffB[i] = (unsigned)(Rb * K + C) * 2u; }
  const size_t kstep = (size_t)(BK * 2);
  const size_t hA = (size_t)HALF * lda * 2, tA = (size_t)g.mrows * lda * 2, hB = (size_t)HALF * K * 2, tB = 2 * hB;
  const unsigned ldsw = (unsigned)wid * 1024u;
  const int aoff = lds_byte(wr * 64 + fr, fq * 8), boff = lds_byte(wc * 32 + fr, fq * 8);
#define PG8_SA(b, h) (((b) * 2 + (h)) * HTB)
#define PG8_SB(b, h) ((4 + (b) * 2 + (h)) * HTB)
#define PG8_STAGE(bufoff, gbase, voff) do { _Pragma("unroll") for (int _i = 0; _i < 2; ++_i) \
    __builtin_amdgcn_global_load_lds((const unsigned*)((const char*)(gbase) + (voff)[_i]), (LAS unsigned*)(lds + (bufoff) + ldsw + _i * 8192), 16, 0, 0); } while (0)
#define PG8_LDA(dst, b, h) do { _Pragma("unroll") for (int m = 0; m < 4; ++m) _Pragma("unroll") for (int k = 0; k < 2; ++k) dst[m][k] = *(const LAS bf16x8*)(lds + PG8_SA(b, h) + aoff + m * 2048 + k * 1024); } while (0)
#define PG8_LDB(dst, b, h) do { _Pragma("unroll") for (int n = 0; n < 2; ++n) _Pragma("unroll") for (int k = 0; k < 2; ++k) dst[n][k] = *(const LAS bf16x8*)(lds + PG8_SB(b, h) + boff + n * 2048 + k * 1024); } while (0)
#define PG8_MMA(ai, bj, At, Bt) do { __builtin_amdgcn_s_setprio(1); _Pragma("unroll") for (int m = 0; m < 4; ++m) _Pragma("unroll") for (int n = 0; n < 2; ++n) _Pragma("unroll") for (int k = 0; k < 2; ++k) \
    acc[ai][bj][m][n] = __builtin_amdgcn_mfma_f32_16x16x32_bf16(Bt[n][k], At[m][k], acc[ai][bj][m][n], 0, 0, 0); __builtin_amdgcn_s_setprio(0); } while (0)
#define PG8_WAIT_V(n) asm volatile("s_waitcnt vmcnt(" #n ")" ::: "memory")
#define PG8_WAIT_L(n) asm volatile("s_waitcnt lgkmcnt(" #n ")" ::: "memory")
#define PG8_BAR __builtin_amdgcn_s_barrier()
#define PG8_SCHED __builtin_amdgcn_sched_barrier(0)
  Unit cur, nxt; int ui = 0;
  if (!S.next(0, cur)) return;
  f32x4 acc[2][2][4][2];
#pragma unroll
  for (int a = 0; a < 2; ++a)
#pragma unroll
    for (int b = 0; b < 2; ++b)
#pragma unroll
      for (int m = 0; m < 4; ++m)
#pragma unroll
        for (int n = 0; n < 2; ++n) acc[a][b][m][n] = (f32x4){0.f, 0.f, 0.f, 0.f};
  bf16x8 At[4][2], B0[2][2], B1[2][2];
  const char* cA = (const char*)g.A + (size_t)cur.pm * tA; const char* cB = (const char*)g.Bt + (size_t)cur.pn * tB;
  PG8_STAGE(PG8_SB(0, 0), cB, voffB); PG8_STAGE(PG8_SB(0, 1), cB + hB, voffB); PG8_STAGE(PG8_SA(0, 0), cA, voffA); PG8_STAGE(PG8_SA(0, 1), cA + hA, voffA);
  if (wr == 1) PG8_BAR;
  PG8_WAIT_V(2); PG8_BAR;
  PG8_STAGE(PG8_SB(1, 0), cB + kstep, voffB); PG8_STAGE(PG8_SA(1, 0), cA + kstep, voffA); PG8_STAGE(PG8_SB(1, 1), cB + hB + kstep, voffB);
  PG8_WAIT_V(6); PG8_BAR;
  for (;;) {
    const bool has_next = S.next(ui + 1, nxt);
    const char* nA = has_next ? (const char*)g.A + (size_t)nxt.pm * tA : cA; const char* nB = has_next ? (const char*)g.Bt + (size_t)nxt.pn * tB : cB;
    for (int t = 0; t < nt; t += 2) {
      const bool last = (t == nt - 2);
      const char* a1 = cA + (size_t)(t + 1) * kstep;
      const char* a2 = last ? nA : cA + (size_t)(t + 2) * kstep; const char* b2 = last ? nB : cB + (size_t)(t + 2) * kstep;
      const char* a3 = a2 + kstep; const char* b3 = b2 + kstep;
      PG8_LDB(B0, 0, 0); PG8_LDB(B1, 0, 1); PG8_SCHED; PG8_LDA(At, 0, 0); PG8_STAGE(PG8_SA(1, 1), a1 + hA, voffA);
      PG8_WAIT_V(8); PG8_WAIT_L(0); PG8_BAR; PG8_MMA(0, 0, At, B0); PG8_MMA(0, 1, At, B1); PG8_BAR; PG8_SCHED;
      PG8_LDA(At, 0, 1); PG8_STAGE(PG8_SB(0, 0), b2, voffB); PG8_STAGE(PG8_SB(0, 1), b2 + hB, voffB); PG8_STAGE(PG8_SA(0, 0), a2, voffA);
      PG8_WAIT_V(8); PG8_WAIT_L(0); PG8_BAR; PG8_MMA(1, 0, At, B0); PG8_MMA(1, 1, At, B1); PG8_BAR; PG8_SCHED;
      PG8_LDB(B0, 1, 0); PG8_LDB(B1, 1, 1); PG8_SCHED; PG8_LDA(At, 1, 0); PG8_STAGE(PG8_SA(0, 1), a2 + hA, voffA);
      PG8_WAIT_V(8); PG8_WAIT_L(0); PG8_BAR; PG8_MMA(0, 0, At, B0); PG8_MMA(0, 1, At, B1); PG8_BAR; PG8_SCHED;
      PG8_LDA(At, 1, 1); PG8_STAGE(PG8_SB(1, 0), b3, voffB); PG8_STAGE(PG8_SB(1, 1), b3 + hB, voffB); PG8_STAGE(PG8_SA(1, 0), a3, voffA);
      PG8_WAIT_V(8); PG8_WAIT_L(0); PG8_BAR; PG8_MMA(1, 0, At, B0); PG8_MMA(1, 1, At, B1); PG8_BAR; PG8_SCHED;
    }
    if (wr == 0) PG8_BAR;
    { const int l2 = opaque_tid_w(wid_s) & 63; E(acc, cur, wr, wc, l2 & 15, l2 >> 4); }
    if (!has_next) break;
#pragma unroll
    for (int a = 0; a < 2; ++a)
#pragma unroll
      for (int b = 0; b < 2; ++b)
#pragma unroll
        for (int m = 0; m < 4; ++m)
#pragma unroll
          for (int n = 0; n < 2; ++n) acc[a][b][m][n] = (f32x4){0.f, 0.f, 0.f, 0.f};
    cur = nxt; cA = nA; cB = nB; ++ui;
    if (wr == 1) PG8_BAR;
  }
  PG8_WAIT_V(0);
  PG8_BAR;
#undef PG8_SA
#undef PG8_SB
#undef PG8_STAGE
#undef PG8_LDA
#undef PG8_LDB
#undef PG8_MMA
#undef PG8_WAIT_V
#undef PG8_WAIT_L
#undef PG8_BAR
#undef PG8_SCHED
}
}

__device__ __forceinline__ void conv_item(const ConvJob& J, const float* W, const float* sc, bf16_t* out, LAS float* scr, int item, int lane) {
  const int nblk = J.NP / 32, cb = item / nblk, nb = item % nblk, c0 = 64 * cb, n0 = 32 * nb;
#pragma unroll 8
  for (int i = 0; i < 32; ++i) { const int cc = 2 * i + (lane >> 5); const int k = c0 + cc - J.k_off; const int n = n0 + (lane & 31);
    float v = 0.f;
    if (k >= 0 && k < J.K && n < J.N) { v = W[(size_t)k * J.N + n]; if (J.sc_mode == 1) v *= sc[k]; else if (J.sc_mode == 2) v *= (1.f - sc[k]); }
    scr[cc * 33 + (lane & 31)] = v; }
  asm volatile("s_waitcnt lgkmcnt(0)" ::: "memory");
  const int c = lane & 7;
#pragma unroll
  for (int j = 0; j < 4; ++j) { const int n = (lane >> 3) + 8 * j; const LAS float* s = scr + (8 * c) * 33 + n;
    u32x4 o; o.x = pk2(s[0 * 33], s[1 * 33]); o.y = pk2(s[2 * 33], s[3 * 33]); o.z = pk2(s[4 * 33], s[5 * 33]); o.w = pk2(s[6 * 33], s[7 * 33]);
    int nr = n0 + n; if (J.perm) { const int half = nr >= FF ? 1 : 0; const int cc = nr - half * FF; nr = (cc >> 7) * 256 + half * 128 + (cc & 127); }
    *(u32x4*)(out + (size_t)(J.row_off + nr) * J.ldo + J.col_base + c0 + 8 * c) = o; }
  asm volatile("s_waitcnt lgkmcnt(0)" ::: "memory");
}

__device__ __forceinline__ float wave_total_n(float v) {
  v += dpp_row_shr(v, 1); v += dpp_row_shr(v, 2); v += dpp_row_shr(v, 4); v += dpp_row_shr(v, 8);
  v += __builtin_bit_cast(float, __builtin_amdgcn_update_dpp(0, __builtin_bit_cast(int, v), 0x142, 0xa, 0xf, false));
  v += __builtin_bit_cast(float, __builtin_amdgcn_update_dpp(0, __builtin_bit_cast(int, v), 0x143, 0xc, 0xf, false));
  return __builtin_bit_cast(float, __builtin_amdgcn_readlane(__builtin_bit_cast(int, v), 63));
}
__device__ __forceinline__ void norm_rows(const float* src, float* cpy, const float* g, bf16_t* out, int mode, int gw, int ngw, int lane) {
  f32x4 gg[4];
#pragma unroll
  for (int j = 0; j < 4; ++j) gg[j] = ((const f32x4*)g)[lane + 64 * j];
  if (mode == 4) { if (gw == 0) { unsigned zz = 0u; asm volatile("" : "+v"(zz)); for (int j = 0; j < 4; ++j) ((u32x4*)(out - 2048))[lane + 64 * j] = (u32x4){zz, zz, zz, zz}; } mode = 0; }
  for (int m0 = gw; m0 < M; m0 += 2 * ngw) {
    const int m1 = m0 + ngw;
    const bool has1 = m1 < M;
    f32x4 v[2][4]; float ss0 = 0.f, ss1 = 0.f;
#pragma unroll
    for (int j = 0; j < 4; ++j) { v[0][j] = ((const f32x4*)(src + (size_t)m0 * D))[lane + 64 * j]; v[1][j] = has1 ? ((const f32x4*)(src + (size_t)m1 * D))[lane + 64 * j] : (f32x4){0.f, 0.f, 0.f, 0.f}; }
#pragma unroll
    for (int j = 0; j < 4; ++j) { ss0 += (v[0][j].x * v[0][j].x + v[0][j].y * v[0][j].y) + (v[0][j].z * v[0][j].z + v[0][j].w * v[0][j].w);
      ss1 += (v[1][j].x * v[1][j].x + v[1][j].y * v[1][j].y) + (v[1][j].z * v[1][j].z + v[1][j].w * v[1][j].w); }
    ss0 = wave_total_n(ss0); ss1 = wave_total_n(ss1);
#pragma unroll
    for (int rr = 0; rr < 2; ++rr) {
      if (rr == 1 && !has1) break;
      const int m = rr ? m1 : m0; const float rs = 1.0f / sqrtf((rr ? ss1 : ss0) * (1.f / D) + 1e-6f);
#pragma unroll
      for (int j = 0; j < 4; ++j) {
        const f32x4 y = v[rr][j] * rs * gg[j];
        if (mode == 3) { ((f32x4*)(cpy + (size_t)m * D))[lane + 64 * j] = y; }
        else {
          if (mode == 1) ((f32x4*)(cpy + (size_t)m * D))[lane + 64 * j] = v[rr][j];
          u32x2 w; w.x = pk2(y.x, y.y); w.y = pk2(y.z, y.w);
          if (mode == 2) {
            *(u32x2*)(out + (size_t)m * 2048 + 4 * (lane + 64 * j)) = w;
            if (m + 1 < M) *(u32x2*)(out + (size_t)(m + 1) * 2048 + 1024 + 4 * (lane + 64 * j)) = w;
            if (m == 0) { unsigned zz = 0u; asm volatile("" : "+v"(zz)); *(u32x2*)(out + 1024 + 4 * (lane + 64 * j)) = (u32x2){zz, zz}; }
          } else *(u32x2*)(out + (size_t)m * 1024 + 4 * (lane + 64 * j)) = w;
        }
      }
    }
  }
}

__device__ __forceinline__ void conv_load8(const bf16_t* U, const bf16_t* UH, int t, int half, int col, float (&o)[8]) {
  if (t < 0) { for (int e = 0; e < 8; ++e) o[e] = 0.f; return; }
  const bf16_t* p = (t >= half * 8192) ? U + (size_t)(t - half * 8192) * FF2 + col : UH + (size_t)(t - 8190) * FF2 + col;
  const u32x4 w = *(const u32x4*)p;
  o[0] = bflo(w.x); o[1] = bfhi(w.x); o[2] = bflo(w.y); o[3] = bfhi(w.y); o[4] = bflo(w.z); o[5] = bfhi(w.z); o[6] = bflo(w.w); o[7] = bfhi(w.w);
}
__device__ __forceinline__ void ffn_conv(unsigned char* ws, const float* cw, const float* cb, int half, int gtid, int ngt) {
  const bf16_t* U = (const bf16_t*)(ws + A_U); bf16_t* UH = (bf16_t*)(ws + WS_SMALL + SM_UH); bf16_t* H = (bf16_t*)(ws + A_H);
  constexpr int RUN = 16, NCG = FF / 8, NP = (8192 / RUN) * NCG;
  for (int p = gtid; p < NP; p += ngt) {
    const int run = p / NCG, cg8 = p % NCG, c = cg8 * 8; const int t0 = half * 8192 + run * RUN;
    float wg[3][8], wu[3][8], bg[8], bu[8];
#pragma unroll
    for (int j = 0; j < 3; ++j)
#pragma unroll
      for (int e = 0; e < 8; ++e) { wg[j][e] = cw[j * FF2 + c + e]; wu[j][e] = cw[j * FF2 + FF + c + e]; }
#pragma unroll
    for (int e = 0; e < 8; ++e) { bg[e] = cb[c + e]; bu[e] = cb[FF + c + e]; }
    float g2[8], g1[8], u2[8], u1[8], g0[8], u0[8];
    conv_load8(U, UH, t0 - 2, half, c, g2); conv_load8(U, UH, t0 - 1, half, c, g1);
    conv_load8(U, UH, t0 - 2, half, FF + c, u2); conv_load8(U, UH, t0 - 1, half, FF + c, u1);
    for (int i = 0; i < RUN; ++i) {
      const int t = t0 + i;
      conv_load8(U, UH, t, half, c, g0); conv_load8(U, UH, t, half, FF + c, u0);
      float o[8];
#pragma unroll
      for (int e = 0; e < 8; ++e) {
        const float gv = wg[0][e] * g2[e] + wg[1][e] * g1[e] + wg[2][e] * g0[e] + bg[e];
        const float uv = wu[0][e] * u2[e] + wu[1][e] * u1[e] + wu[2][e] * u0[e] + bu[e];
        o[e] = gv * sigm(gv) * uv; g2[e] = g1[e]; g1[e] = g0[e]; u2[e] = u1[e]; u1[e] = u0[e];
      }
      u32x4 w; w.x = pk2(o[0], o[1]); w.y = pk2(o[2], o[3]); w.z = pk2(o[4], o[5]); w.w = pk2(o[6], o[7]);
      *(u32x4*)(H + (size_t)t * FF + c) = w;
    }
  }
  if (half == 0) {
    for (int p = gtid; p < 2 * FF2 / 8; p += ngt) { const int r = p / (FF2 / 8), cc = (p % (FF2 / 8)) * 8;
      *(u32x4*)(UH + (size_t)r * FF2 + cc) = *(const u32x4*)(U + (size_t)(8190 + r) * FF2 + cc); }
  }
}

constexpr int CS = 132;
constexpr int C_CUM = 0, C_QD = 33792, C_KI = 51200, C_VT = 68608, C_PP = 105472, C_GATE = 114688;
constexpr int G_AL = C_GATE, G_SEG = C_GATE + 4096, G_MISC = C_GATE + 6144;
constexpr float QSCALE = 0.08838834764831845f;
#define GM(i) ((LAS float*)(lds + G_MISC + (i) * 256))
__device__ __forceinline__ void unpack8(const u32x4 w, float (&o)[8]) { o[0] = bflo(w.x); o[1] = bfhi(w.x); o[2] = bflo(w.y); o[3] = bfhi(w.y); o[4] = bflo(w.z); o[5] = bfhi(w.z); o[6] = bflo(w.w); o[7] = bfhi(w.w); }
__device__ __forceinline__ u32x4 pack8(const float (&o)[8]) { return (u32x4){pk2(o[0], o[1]), pk2(o[2], o[3]), pk2(o[4], o[5]), pk2(o[6], o[7])}; }

__device__ __forceinline__ void gla_cum(LAS unsigned char* lds, const bf16_t* P, int c, int h, const float* wau, const float* balpha, int tid) {
  LAS float* AL = (LAS float*)(lds + G_AL); LAS float* SEG = (LAS float*)(lds + G_SEG); LAS float* CUM = (LAS float*)(lds + C_CUM);
  if (tid < 128) { const int t = tid >> 1, hf = tid & 1; float o[8]; unpack8(*(const u32x4*)(P + (size_t)(c * 64 + t) * 3328 + 3072 + hf * 8), o);
#pragma unroll
    for (int e = 0; e < 8; ++e) AL[t * 16 + hf * 8 + e] = o[e]; }
  __syncthreads();
  const int d = tid & 127, tq = tid >> 7;
  float wa[16];
#pragma unroll
  for (int j = 0; j < 16; ++j) wa[j] = wau[j * 512 + h * 128 + d];
  const float b = balpha[h * 128 + d];
  float run = 0.f;
#pragma unroll 2
  for (int i = 0; i < 16; ++i) { const int t = tq * 16 + i; float z = b;
#pragma unroll
    for (int j = 0; j < 16; ++j) z += AL[t * 16 + j] * wa[j];
    run += logsig(z) * (1.f / 16.f); CUM[t * CS + d] = run; }
  SEG[tq * 128 + d] = run;
  __syncthreads();
  float off = 0.f;
  for (int q = 0; q < tq; ++q) off += SEG[q * 128 + d];
  for (int i = 0; i < 16; ++i) CUM[(tq * 16 + i) * CS + d] += off;
  __syncthreads();
}
__device__ __forceinline__ void ml_gates(LAS unsigned char* lds, const bf16_t* P, int c, int h, const float* bif, int tid) {
  if (tid < 64) { const size_t r = (size_t)(c * 64 + tid) * 3328;
    GM(1)[tid] = bf2f(P[r + 3072 + h]) + bif[h];
    GM(0)[tid] = logsig(bf2f(P[r + 3076 + h]) + bif[4 + h]); }
  __syncthreads();
  if (tid == 0) { float run = 0.f; for (int t = 0; t < 64; ++t) { run += GM(0)[t]; GM(0)[t] = run; } }
  __syncthreads();
}
__device__ __forceinline__ void stage_vt(LAS unsigned char* lds, const bf16_t* P, int c, int h, int wid, int lane) {
  LAS bf16_t* VT = (LAS bf16_t*)(lds + C_VT);
  u32x4 vv[4];
#pragma unroll
  for (int g = 0; g < 4; ++g) vv[g] = *(const u32x4*)(P + (size_t)(c * 64 + lane) * 3328 + 1024 + h * 256 + 8 * (4 * wid + g));
#pragma unroll
  for (int g = 0; g < 4; ++g) { const unsigned w[4] = {vv[g].x, vv[g].y, vv[g].z, vv[g].w}; const int v0 = 8 * (4 * wid + g);
#pragma unroll
    for (int e = 0; e < 4; ++e) { VT[(v0 + 2 * e) * 72 + lane] = (bf16_t)(w[e] & 0xffffu); VT[(v0 + 2 * e + 1) * 72 + lane] = (bf16_t)(w[e] >> 16); } }
}

template <bool IS_ML>
__device__ __forceinline__ void chunk_local(LAS unsigned char* lds, unsigned char* ws, const float* w1, const float* w2, int bid, int nb, int wid_s) {
  const int tid = opaque_tid_w(wid_s), wid = wid_s, lane = tid & 63;
  const bf16_t* P = (const bf16_t*)(ws + A_P); bf16_t* BS = (bf16_t*)(ws + A_BS);
  float* DT = (float*)(ws + WS_SMALL + SM_DTOT);
  LAS bf16_t* KT = (LAS bf16_t*)(lds + C_QD); LAS float* CUM = (LAS float*)(lds + C_CUM);
  LAS float* SCL = (LAS float*)(lds + G_MISC + 1280);
  for (int it = bid; it < 1024; it += nb) {
    const int c = it >> 2, h = it & 3;
    if (IS_ML) {
      ml_gates(lds, P, c, h, w1, tid);
      if (tid == 0) { const float bl = GM(0)[63]; float mx = -1e30f; for (int s = 0; s < 64; ++s) mx = fmaxf(mx, bl - GM(0)[s] + GM(1)[s]); SCL[0] = bl; SCL[1] = mx;
        ((float*)(ws + WS_SMALL + SM_BL))[c * 4 + h] = bl; ((float*)(ws + WS_SMALL + SM_ML))[c * 4 + h] = mx; }
      __syncthreads();
    } else gla_cum(lds, P, c, h, w1, w2, tid);
    {
      u32x4 kv[2];
#pragma unroll
      for (int g = 0; g < 2; ++g) kv[g] = *(const u32x4*)(P + (size_t)(c * 64 + lane) * 3328 + 512 + h * 128 + 8 * (2 * wid + g));
      stage_vt(lds, P, c, h, wid, lane);
      const float fml = IS_ML ? __expf(SCL[0] - GM(0)[lane] + GM(1)[lane] - SCL[1]) * QSCALE : 0.f;
#pragma unroll
      for (int g = 0; g < 2; ++g) { const int d0 = 8 * (2 * wid + g); float k8[8]; unpack8(kv[g], k8);
        float f8[8];
        if (IS_ML) { for (int e = 0; e < 8; ++e) f8[e] = fml; }
        else { const f32x4 ca = *(const LAS f32x4*)(CUM + lane * CS + d0), cb = *(const LAS f32x4*)(CUM + lane * CS + d0 + 4), la = *(const LAS f32x4*)(CUM + 63 * CS + d0), lb = *(const LAS f32x4*)(CUM + 63 * CS + d0 + 4);
          f8[0] = __expf(la.x - ca.x); f8[1] = __expf(la.y - ca.y); f8[2] = __expf(la.z - ca.z); f8[3] = __expf(la.w - ca.w);
          f8[4] = __expf(lb.x - cb.x); f8[5] = __expf(lb.y - cb.y); f8[6] = __expf(lb.z - cb.z); f8[7] = __expf(lb.w - cb.w);
          if (lane == 63) { *(f32x4*)(DT + (c * 4 + h) * 128 + d0) = la; *(f32x4*)(DT + (c * 4 + h) * 128 + d0 + 4) = lb; } }
#pragma unroll
        for (int e = 0; e < 8; ++e) { const float kw = k8[e] * f8[e]; KT[(d0 + e) * 72 + lane] = (bf16_t)f2bf(kw);
          if (IS_ML) { const float ns = wave_total_n(kw); if (lane == 0) DT[(c * 4 + h) * 128 + d0 + e] = ns; } }
      }
    }
    __syncthreads();
    f32x4 acc[2][8];
#pragma unroll
    for (int a = 0; a < 2; ++a)
#pragma unroll
      for (int b = 0; b < 8; ++b) acc[a][b] = (f32x4){0.f, 0.f, 0.f, 0.f};
    const int fr = lane & 15, kg = lane >> 4;
#pragma unroll
    for (int ks = 0; ks < 2; ++ks) {
      bf16x8 av[2];
#pragma unroll
      for (int a = 0; a < 2; ++a) av[a] = LDSV8(C_VT + (((wid * 2 + a) * 16 + fr) * 72 + ks * 32 + kg * 8) * 2);
#pragma unroll
      for (int b = 0; b < 8; ++b) { const bf16x8 bv = LDSV8(C_QD + ((b * 16 + fr) * 72 + ks * 32 + kg * 8) * 2);
#pragma unroll
        for (int a = 0; a < 2; ++a) acc[a][b] = mfma16(av[a], bv, acc[a][b]); }
    }
#pragma unroll
    for (int a = 0; a < 2; ++a)
#pragma unroll
      for (int b = 0; b < 8; ++b)
#pragma unroll
        for (int r = 0; r < 4; ++r) { const int v = (wid * 2 + a) * 16 + 4 * kg + r, d = b * 16 + fr;
          BS[((size_t)(c * 4 + h) * 256 + v) * 128 + d] = (bf16_t)f2bf(acc[a][b][r]); }
    __syncthreads();
  }
}

template <bool IS_ML>
__device__ __forceinline__ void chunk_scan(unsigned char* ws, int gtid, int ngt) {
  bf16_t* BS = (bf16_t*)(ws + A_BS);
  const float* DT = (const float*)(ws + WS_SMALL + SM_DTOT); float* NST = (float*)(ws + WS_SMALL + SM_NST);
  const float* BL = (const float*)(ws + WS_SMALL + SM_BL); const float* MLc = (const float*)(ws + WS_SMALL + SM_ML); float* MST = (float*)(ws + WS_SMALL + SM_MST);
  for (int e = gtid; e < 131072; e += ngt) {
    const int h = e >> 15, v = (e >> 7) & 255, d = e & 127;
    float st = 0.f, m = 0.f, n = 0.f;
#pragma unroll 16
    for (int c = 0; c < 256; ++c) {
      const size_t idx = ((size_t)(c * 4 + h) * 256 + v) * 128 + d;
      const float b = bf2f(BS[idx]); BS[idx] = (bf16_t)f2bf(st);
      if (IS_ML) {
        const float bl = BL[c * 4 + h], ml = MLc[c * 4 + h]; const float mn = fmaxf(bl + m, ml);
        const float cs = __expf(bl + m - mn), wsc = __expf(ml - mn);
        st = cs * st + wsc * b;
        if (v == 0) { NST[(c * 4 + h) * 128 + d] = n; n = cs * n + wsc * DT[(c * 4 + h) * 128 + d]; if (d == 0) MST[c * 4 + h] = m; }
        m = mn;
      } else st = st * __expf(DT[(c * 4 + h) * 128 + d]) + b;
    }
  }
}

template <bool IS_ML>
__device__ __forceinline__ void chunk_out(LAS unsigned char* lds, unsigned char* ws, const float* w1, const float* w2, const float* onorm, int bid, int nb, int wid_s) {
  const int tid = opaque_tid_w(wid_s), wid = tid >> 6, lane = tid & 63, fr = lane & 15, kg = lane >> 4;
  const bf16_t* P = (const bf16_t*)(ws + A_P); const bf16_t* BS = (const bf16_t*)(ws + A_BS); bf16_t* AO = (bf16_t*)(ws + A0);
  LAS bf16_t* QD = (LAS bf16_t*)(lds + C_QD); LAS bf16_t* KI = (LAS bf16_t*)(lds + C_KI); LAS bf16_t* VT = (LAS bf16_t*)(lds + C_VT); LAS bf16_t* PP = (LAS bf16_t*)(lds + C_PP);
  LAS float* CUM = (LAS float*)(lds + C_CUM); LAS float* OO = (LAS float*)lds; LAS float* SCL = (LAS float*)(lds + G_MISC + 1280);
  for (int it = bid; it < 1024; it += nb) {
    const int c = it >> 2, h = it & 3;
    if (IS_ML) {
      ml_gates(lds, P, c, h, w1, tid);
      if (tid < 64) { const float mp = ((const float*)(ws + WS_SMALL + SM_MST))[c * 4 + h]; const float bt = GM(0)[tid]; const float inter = bt + mp;
        float mx = -1e30f; for (int s = 0; s <= tid; ++s) mx = fmaxf(mx, GM(1)[s] - GM(0)[s]);
        const float mt = fmaxf(inter, mx + bt); GM(2)[tid] = mt; GM(4)[tid] = __expf(inter - mt); GM(3)[tid] = 0.f; }
      __syncthreads();
    } else gla_cum(lds, P, c, h, w1, w2, tid);
    {
      u32x4 qv[2], kv[2];
#pragma unroll
      for (int g = 0; g < 2; ++g) { const bf16_t* rp = P + (size_t)(c * 64 + lane) * 3328 + h * 128 + 8 * (2 * wid + g); qv[g] = *(const u32x4*)rp; kv[g] = *(const u32x4*)(rp + 512); }
      stage_vt(lds, P, c, h, wid, lane);
#pragma unroll
      for (int g = 0; g < 2; ++g) { const int d0 = 8 * (2 * wid + g); float q8[8], k8[8]; unpack8(qv[g], q8); unpack8(kv[g], k8);
        if (IS_ML) { for (int e = 0; e < 8; ++e) k8[e] *= QSCALE; }
        else { const f32x4 ca = *(const LAS f32x4*)(CUM + lane * CS + d0), cb = *(const LAS f32x4*)(CUM + lane * CS + d0 + 4); const float cu[8] = {ca.x, ca.y, ca.z, ca.w, cb.x, cb.y, cb.z, cb.w};
#pragma unroll
          for (int e = 0; e < 8; ++e) { const float ex = __expf(cu[e]); q8[e] *= ex * QSCALE; k8[e] *= __builtin_amdgcn_rcpf(ex); } }
        *(LAS u32x4*)(lds + C_QD + (lane * 136 + d0) * 2) = pack8(q8); *(LAS u32x4*)(lds + C_KI + (lane * 136 + d0) * 2) = pack8(k8); }
    }
    __syncthreads();
    float dinter = 0.f;
    if (IS_ML) {
      const int t = tid >> 3, part = tid & 7; const float* NST = (const float*)(ws + WS_SMALL + SM_NST) + (c * 4 + h) * 128;
      float s = 0.f; for (int j = 0; j < 16; ++j) { const int d = part * 16 + j; s += bf2f(QD[t * 136 + d]) * NST[d]; }
      s += sx<1>(s); s += sx<2>(s); s += sx<4>(s); dinter = s;
    }
    { const int tt = wid >> 1;
#pragma unroll
      for (int q = 0; q < 2; ++q) { const int st = 2 * (wid & 1) + q; f32x4 sc = (f32x4){0.f, 0.f, 0.f, 0.f};
        if (st <= tt) {
#pragma unroll
          for (int ks = 0; ks < 4; ++ks) sc = mfma16(LDSV8(C_QD + ((tt * 16 + fr) * 136 + ks * 32 + kg * 8) * 2), LDSV8(C_KI + ((st * 16 + fr) * 136 + ks * 32 + kg * 8) * 2), sc);
        }
        const int s = st * 16 + fr;
#pragma unroll
        for (int r = 0; r < 4; ++r) { const int t = tt * 16 + 4 * kg + r; float v = (s <= t) ? sc[r] : 0.f;
          if (IS_ML) { v = (s <= t) ? v * __expf(GM(0)[t] - GM(0)[s] + GM(1)[s] - GM(2)[t]) : 0.f;
            float rs = v; rs += sx<1>(rs); rs += sx<2>(rs); rs += sx<4>(rs); rs += sx<8>(rs);
            if (fr == 0) atomicAdd((float*)&GM(3)[t], rs); }
          PP[t * 72 + s] = (bf16_t)f2bf(v); }
      }
    }
    __syncthreads();
    f32x4 acc[8], acc2[8];
    { const int tt = wid & 3, vb = (wid >> 2) * 8;
#pragma unroll
      for (int j = 0; j < 8; ++j) { acc[j] = (f32x4){0.f, 0.f, 0.f, 0.f}; acc2[j] = (f32x4){0.f, 0.f, 0.f, 0.f}; }
#pragma unroll
      for (int ks = 0; ks < 2; ++ks) { const bf16x8 a = LDSV8(C_PP + ((tt * 16 + fr) * 72 + ks * 32 + kg * 8) * 2);
#pragma unroll
        for (int j = 0; j < 8; ++j) acc[j] = mfma16(a, LDSV8(C_VT + (((vb + j) * 16 + fr) * 72 + ks * 32 + kg * 8) * 2), acc[j]); }
#pragma unroll 2
      for (int ks = 0; ks < 4; ++ks) { const bf16x8 a = LDSV8(C_QD + ((tt * 16 + fr) * 136 + ks * 32 + kg * 8) * 2);
#pragma unroll
        for (int j = 0; j < 8; ++j) { const bf16x8 bv = *(const bf16x8*)(BS + ((size_t)(c * 4 + h) * 256 + (vb + j) * 16 + fr) * 128 + ks * 32 + kg * 8);
          if (IS_ML) acc2[j] = mfma16(a, bv, acc2[j]); else acc[j] = mfma16(a, bv, acc[j]); } }
    }
    __syncthreads();
    { const int tt = wid & 3, vb = (wid >> 2) * 8;
#pragma unroll
      for (int r = 0; r < 4; ++r) { const int t = tt * 16 + 4 * kg + r;
        float sc = 1.f, inv = 1.f;
        if (IS_ML) { sc = GM(4)[t]; }
#pragma unroll
        for (int j = 0; j < 8; ++j) { float o = acc[j][r]; if (IS_ML) o += sc * acc2[j][r]; OO[t * 260 + (vb + j) * 16 + fr] = o * inv; } }
    }
    __syncthreads();
    { const int t = tid >> 3, part = tid & 7, v0 = part * 32;
      float dn = 1.f;
      if (IS_ML) { const float den = GM(3)[t] + GM(4)[t] * dinter; dn = 1.f / fmaxf(fabsf(den), __expf(-GM(2)[t])); }
      float ov[32]; float ss = 0.f;
#pragma unroll
      for (int i = 0; i < 8; ++i) { const f32x4 o4 = *(const LAS f32x4*)(OO + t * 260 + v0 + 4 * i); ov[4 * i] = o4.x * dn; ov[4 * i + 1] = o4.y * dn; ov[4 * i + 2] = o4.z * dn; ov[4 * i + 3] = o4.w * dn; }
#pragma unroll
      for (int i = 0; i < 32; ++i) ss += ov[i] * ov[i];
      ss += sx<1>(ss); ss += sx<2>(ss); ss += sx<4>(ss);
      const float rs = 1.0f / sqrtf(ss * (1.f / 256.f) + 1e-6f);
      const bf16_t* gp = P + (size_t)(c * 64 + t) * 3328 + 2048 + h * 256 + v0; bf16_t* op = AO + (size_t)(c * 64 + t) * 1024 + h * 256 + v0;
#pragma unroll
      for (int i = 0; i < 4; ++i) { float g8[8]; unpack8(*(const u32x4*)(gp + 8 * i), g8); const f32x4 n0 = *(const f32x4*)(onorm + h * 256 + v0 + 8 * i), n1 = *(const f32x4*)(onorm + h * 256 + v0 + 8 * i + 4);
        const float nn[8] = {n0.x, n0.y, n0.z, n0.w, n1.x, n1.y, n1.z, n1.w}; float o8[8];
#pragma unroll
        for (int e = 0; e < 8; ++e) { const float gz = g8[e]; const float gate = IS_ML ? sigm(gz) : gz * sigm(gz); o8[e] = ov[8 * i + e] * rs * nn[e] * gate; }
        *(u32x4*)(op + 8 * i) = pack8(o8); }
    }
    __syncthreads();
  }
}

constexpr int S_Q = 0, S_K = 18432, S_V = 27648, S_Z = 36864, S_P = 70144, S_CARRY = 88576, S_FLAG = 89088;
constexpr float SB_EXIT = -120.f;
__device__ __forceinline__ void sb_attn(LAS unsigned char* lds, unsigned char* ws, int bid, int nb, int wid_s) {
  const int tid = opaque_tid_w(wid_s), wid = tid >> 6, lane = tid & 63, fr = lane & 15, kg = lane >> 4;
  const bf16_t* QKV = (const bf16_t*)(ws + A_P); bf16_t* AO = (bf16_t*)(ws + A0);
  LAS bf16_t* QS = (LAS bf16_t*)(lds + S_Q); LAS bf16_t* KS = (LAS bf16_t*)(lds + S_K); LAS bf16_t* VT = (LAS bf16_t*)(lds + S_V);
  LAS float* Z = (LAS float*)(lds + S_Z); LAS bf16_t* PP = (LAS bf16_t*)(lds + S_P); LAS float* CARRY = (LAS float*)(lds + S_CARRY); LAS volatile int* FLAG = (LAS volatile int*)(lds + S_FLAG);
  for (int it = bid; it < 2048; it += nb) {
    const int h = it & 15, qb = it >> 4;
    { const int row = tid >> 2, part = tid & 3; const bf16_t* src = QKV + (size_t)(qb * 128 + row) * 3072 + h * 64 + part * 16;
      u32x4 a = *(const u32x4*)src, b = *(const u32x4*)(src + 8);
      unsigned w[8] = {a.x, a.y, a.z, a.w, b.x, b.y, b.z, b.w}; unsigned o[8];
#pragma unroll
      for (int e = 0; e < 8; ++e) o[e] = pk2(bflo(w[e]) * 0.125f, bfhi(w[e]) * 0.125f);
      *(LAS u32x4*)(lds + S_Q + (row * 72 + part * 16) * 2) = (u32x4){o[0], o[1], o[2], o[3]};
      *(LAS u32x4*)(lds + S_Q + (row * 72 + part * 16 + 8) * 2) = (u32x4){o[4], o[5], o[6], o[7]};
      if (tid < 128) CARRY[tid] = 0.f;
      if (tid < 2) FLAG[tid] = 0;
    }
    f32x4 acc[4];
#pragma unroll
    for (int j = 0; j < 4; ++j) acc[j] = (f32x4){0.f, 0.f, 0.f, 0.f};
    int iter = 0;
    u32x4 kwn, vwn;
    { const int row = tid >> 3, part = tid & 7; const bf16_t* src = QKV + (size_t)((2 * qb + 1) * 64 + row) * 3072 + 1024 + h * 64 + part * 8; kwn = *(const u32x4*)src; vwn = *(const u32x4*)(src + 1024); }
    for (int kb = 2 * qb + 1; kb >= 0; --kb, ++iter) {
      { const int row = tid >> 3, part = tid & 7;
        const u32x4 kw = kwn; const u32x4 vw = vwn;
        if (kb > 0) { const bf16_t* src = QKV + (size_t)((kb - 1) * 64 + row) * 3072 + 1024 + h * 64 + part * 8; kwn = *(const u32x4*)src; vwn = *(const u32x4*)(src + 1024); }
        *(LAS u32x4*)(lds + S_K + (row * 72 + part * 8) * 2) = kw;
        const unsigned vv[4] = {vw.x, vw.y, vw.z, vw.w};
#pragma unroll
        for (int e = 0; e < 4; ++e) { VT[(part * 8 + 2 * e) * 72 + row] = (bf16_t)(vv[e] & 0xffffu); VT[(part * 8 + 2 * e + 1) * 72 + row] = (bf16_t)(vv[e] >> 16); }
      }
      __syncthreads();
      if (tid == 0) FLAG[(iter + 1) & 1] = 0;
#pragma unroll
      for (int kt = 0; kt < 4; ++kt) { f32x4 z = (f32x4){0.f, 0.f, 0.f, 0.f};
#pragma unroll
        for (int ks = 0; ks < 2; ++ks) z = mfma16(LDSV8(S_Q + ((wid * 16 + fr) * 72 + ks * 32 + kg * 8) * 2), LDSV8(S_K + ((kt * 16 + fr) * 72 + ks * 32 + kg * 8) * 2), z);
#pragma unroll
        for (int r = 0; r < 4; ++r) Z[(wid * 16 + 4 * kg + r) * 65 + kt * 16 + fr] = z[r]; }
      __syncthreads();
      { const int row = tid >> 2, seg = tid & 3; const int tq = qb * 128 + row; const int s0 = kb * 64 + seg * 16;
        float lbv[16], lkv[16]; float segsum = 0.f;
#pragma unroll
        for (int j = 0; j < 16; ++j) { const float z = Z[row * 65 + seg * 16 + j]; const float lb = logsig(z); const bool valid = (s0 + j) < tq;
          lbv[j] = valid ? lb : -1e30f; lkv[j] = valid ? lb - z : 0.f; segsum += lkv[j]; }
        const float v0 = quad_bcast<0>(segsum), v1 = quad_bcast<1>(segsum), v2 = quad_bcast<2>(segsum), v3 = quad_bcast<3>(segsum);
        const float right = (seg < 1 ? v1 : 0.f) + (seg < 2 ? v2 : 0.f) + (seg < 3 ? v3 : 0.f);
        const float cin = CARRY[row];
        float run = cin + right;
#pragma unroll
        for (int j = 15; j >= 0; --j) { const float w = __expf(lbv[j] + run); run += lkv[j]; PP[row * 72 + seg * 16 + j] = (bf16_t)f2bf(w); }
        const float cnew = cin + v0 + v1 + v2 + v3;
        if (seg == 0) { CARRY[row] = cnew; if (cnew > SB_EXIT) FLAG[iter & 1] = 1; }
      }
      __syncthreads();
#pragma unroll
      for (int ks = 0; ks < 2; ++ks) { const bf16x8 a = LDSV8(S_P + ((wid * 16 + fr) * 72 + ks * 32 + kg * 8) * 2);
#pragma unroll
        for (int j = 0; j < 4; ++j) acc[j] = mfma16(a, LDSV8(S_V + ((j * 16 + fr) * 72 + ks * 32 + kg * 8) * 2), acc[j]); }
      const int cont = FLAG[iter & 1];
      if (!cont) break;
      __syncthreads();
    }
#pragma unroll
    for (int j = 0; j < 4; ++j)
#pragma unroll
      for (int r = 0; r < 4; ++r) AO[(size_t)(qb * 128 + wid * 16 + 4 * kg + r) * 1024 + h * 64 + j * 16 + fr] = (bf16_t)f2bf(acc[j][r]);
    __syncthreads();
  }
}

constexpr int RK_L = 128, RK_NC = M / RK_L, RK_STEP = 1536;
constexpr unsigned A_RB = A_Y, A_RP = A_Y + 32 * MiB;
typedef float f32x2 __attribute__((ext_vector_type(2)));
template <int NB> struct RRaw { unsigned r[NB], k[NB], v[NB], w[NB], a[NB]; };
__device__ __forceinline__ float wave_total(float v) { const float s = wave_scan63(v); return __builtin_bit_cast(float, __builtin_amdgcn_readlane(__builtin_bit_cast(int, s), 63)); }
template <int NB> __device__ __forceinline__ void rk_issue(RRaw<NB>& R, const unsigned char* ws, int ch, int t0) {
  const bf16_t* P1 = (const bf16_t*)(ws + A_P1); const bf16_t* P2 = (const bf16_t*)(ws + A0);
#pragma unroll
  for (int q = 0; q < NB; ++q) { const size_t t = (size_t)(t0 + q);
    R.r[q] = P1[t * 3328 + ch]; R.k[q] = P1[t * 3328 + 1024 + ch]; R.v[q] = P1[t * 3328 + 2048 + ch];
    R.w[q] = P2[t * 2048 + ch]; R.a[q] = P2[t * 2048 + 1024 + ch]; }
}
template <bool WSC, int NB>
__device__ __forceinline__ void rk_prep8(const RRaw<NB>& R, LAS unsigned char* wl, float w0c, float a0c, float kkc, float kac, float rkc, float* SC, int t0, int h, int lane) {
#pragma unroll
  for (int q = 0; q < NB; ++q) {
    const float r = bf2f(R.r[q]), kr = bf2f(R.k[q]), v = bf2f(R.v[q]);
    const float wp = bf2f(R.w[q]) + w0c, ap = bf2f(R.a[q]) + a0c;
    const float decay = __expf(-0.6065306597126334f * __builtin_amdgcn_rcpf(1.f + __expf(-wp)));
    const float a = __builtin_amdgcn_rcpf(1.f + __expf(-ap));
    const float kkv = kr * kkc; const float kk = kkv * __builtin_amdgcn_rsqf(fmaxf(wave_total(kkv * kkv), 1e-24f));
    const float kmod = kr * (1.f + (a - 1.f) * kac);
    LAS float* p = (LAS float*)(wl + q * RK_STEP) + lane;
    p[0] = decay; p[64] = -kk; p[128] = kk * a; p[192] = kmod; p[256] = r; p[320] = v;
    if (WSC) { const float scv = wave_total(r * kmod * rkc); if (lane == 0) SC[(size_t)(t0 + q) * 16 + h] = scv; }
  }
}
#define RK_V4(off) (*(const LAS f32x4*)(p + (off)))
template <int PASS>
__device__ __forceinline__ void rk_chunk(LAS unsigned char* lds, unsigned char* ws, const float* w0, const float* a0, const float* k_k, const float* k_a, const float* r_k, int item, int wid, int lane) {
  const int h = item >> 7, c = item & 127, ch = h * 64 + lane, tb = c * RK_L;
  LAS unsigned char* wl = lds + wid * 16384;
  const float w0c = w0[ch], a0c = a0[ch], kkc = k_k[ch], kac = k_a[ch], rkc = r_k[ch];
  float* SC = (float*)(ws + WS_SMALL + SM_SC); bf16_t* Y = (bf16_t*)(ws + A_RP);
  float* Bg = (float*)(ws + A_RB) + ((size_t)(h * RK_NC + c) * 64 + lane) * 64;
  float* Pg = (float*)(ws + A_RP) + ((size_t)(h * RK_NC + c) * 64 + lane) * 64;
  f32x2 SB[32], SP[32];
  float zf = 0.f; asm volatile("" : "+v"(zf));
#pragma unroll
  for (int q = 0; q < 32; ++q) { SB[q] = (f32x2){zf, zf}; SP[q] = (f32x2){(2 * q == lane) ? 1.f : 0.f, (2 * q + 1 == lane) ? 1.f : 0.f}; }
  if (PASS == 3 && c > 0) { const float* Sg = Bg - 4096;
#pragma unroll
    for (int q = 0; q < 16; ++q) { const f32x4 v = *(const f32x4*)(Sg + 4 * q); SB[2 * q] = (f32x2){v.x, v.y}; SB[2 * q + 1] = (f32x2){v.z, v.w}; } }
  constexpr int NB = (PASS == 1) ? 2 : 4;
  RRaw<NB> RA;
  rk_issue<NB>(RA, ws, ch, tb);
  for (int blk = 0; blk < RK_L / NB; ++blk) {
    rk_prep8<PASS == 3, NB>(RA, wl, w0c, a0c, kkc, kac, rkc, SC, tb + blk * NB, h, lane);
    if (blk + 1 < RK_L / NB) rk_issue<NB>(RA, ws, ch, tb + (blk + 1) * NB);
#pragma unroll 1
    for (int s = 0; s < NB; ++s) {
      const LAS float* p = (const LAS float*)(wl + s * RK_STEP);
      f32x2 y0, y1;
      if constexpr (PASS == 1) {
      f32x2 a0v = (f32x2){zf, zf}, a1v = a0v, b0v = a0v, b1v = a0v;
      f32x4 NK[4], W[2], KA[2], KX[2];
      NK[0] = RK_V4(64); NK[1] = RK_V4(68); NK[2] = RK_V4(72);
#pragma unroll
      for (int q = 0; q < 16; ++q) {
        if (q + 3 < 16) NK[(q + 3) & 3] = RK_V4(64 + 4 * (q + 3));
        if (q == 15) { W[0] = RK_V4(0); KA[0] = RK_V4(128); KX[0] = RK_V4(192); }
        const f32x4 nk = NK[q & 3]; const f32x2 lo = (f32x2){nk.x, nk.y}, hi = (f32x2){nk.z, nk.w};
        a0v += SB[2 * q] * lo; a1v += SB[2 * q + 1] * hi; b0v += SP[2 * q] * lo; b1v += SP[2 * q + 1] * hi;
        asm volatile("" ::: "memory");
      }
      const float sa = (a0v.x + a0v.y) + (a1v.x + a1v.y), sp = (b0v.x + b0v.y) + (b1v.x + b1v.y);
      const float vv = p[320 + lane];
      const f32x2 sa2 = (f32x2){sa, sa}, sp2 = (f32x2){sp, sp}, v2 = (f32x2){vv, vv};
      y0 = (f32x2){zf, zf}; y1 = y0;
#pragma unroll
      for (int q = 0; q < 16; ++q) {
        if (q + 1 < 16) { W[(q + 1) & 1] = RK_V4(4 * (q + 1)); KA[(q + 1) & 1] = RK_V4(128 + 4 * (q + 1)); KX[(q + 1) & 1] = RK_V4(192 + 4 * (q + 1)); }
        const f32x4 w4 = W[q & 1], ka4 = KA[q & 1], kx4 = KX[q & 1];
        const f32x2 wl2 = (f32x2){w4.x, w4.y}, wh2 = (f32x2){w4.z, w4.w}, kal = (f32x2){ka4.x, ka4.y}, kah = (f32x2){ka4.z, ka4.w}, kxl = (f32x2){kx4.x, kx4.y}, kxh = (f32x2){kx4.z, kx4.w};
        SB[2 * q] = SB[2 * q] * wl2 + sa2 * kal + v2 * kxl; SB[2 * q + 1] = SB[2 * q + 1] * wh2 + sa2 * kah + v2 * kxh;
        SP[2 * q] = SP[2 * q] * wl2 + sp2 * kal; SP[2 * q + 1] = SP[2 * q + 1] * wh2 + sp2 * kah;
        asm volatile("" ::: "memory");
      }
      } else {
      f32x2 a0v = (f32x2){zf, zf}, a1v = a0v, b0v = a0v, b1v = a0v;
      f32x4 NK[2][4];
#pragma unroll
      for (int j = 0; j < 4; ++j) NK[0][j] = RK_V4(64 + 4 * j);
      f32x4 W[2][2], KA[2][2], KX[2][2], RR[2][2];
#pragma unroll
      for (int g = 0; g < 4; ++g) {
        if (g + 1 < 4) {
#pragma unroll
          for (int j = 0; j < 4; ++j) NK[(g + 1) & 1][j] = RK_V4(64 + 4 * (4 * (g + 1) + j));
        } else {
#pragma unroll
          for (int j = 0; j < 2; ++j) { W[0][j] = RK_V4(4 * j); KA[0][j] = RK_V4(128 + 4 * j); KX[0][j] = RK_V4(192 + 4 * j); if (PASS == 3) RR[0][j] = RK_V4(256 + 4 * j); }
        }
#pragma unroll
        for (int j = 0; j < 4; ++j) { const int q = 4 * g + j; const f32x4 nk = NK[g & 1][j]; const f32x2 lo = (f32x2){nk.x, nk.y}, hi = (f32x2){nk.z, nk.w};
          a0v += SB[2 * q] * lo; a1v += SB[2 * q + 1] * hi;
          if (PASS == 1) { b0v += SP[2 * q] * lo; b1v += SP[2 * q + 1] * hi; } }
        asm volatile("" ::: "memory");
      }
      const float sa = (a0v.x + a0v.y) + (a1v.x + a1v.y), sp = (b0v.x + b0v.y) + (b1v.x + b1v.y);
      const float vv = p[320 + lane];
      const f32x2 sa2 = (f32x2){sa, sa}, sp2 = (f32x2){sp, sp}, v2 = (f32x2){vv, vv};
      y0 = (f32x2){zf, zf}; y1 = y0;
#pragma unroll
      for (int g = 0; g < 8; ++g) {
        if (g + 1 < 8) {
#pragma unroll
          for (int j = 0; j < 2; ++j) { const int qn = 2 * (g + 1) + j; W[(g + 1) & 1][j] = RK_V4(4 * qn); KA[(g + 1) & 1][j] = RK_V4(128 + 4 * qn); KX[(g + 1) & 1][j] = RK_V4(192 + 4 * qn); if (PASS == 3) RR[(g + 1) & 1][j] = RK_V4(256 + 4 * qn); }
        }
#pragma unroll
        for (int j = 0; j < 2; ++j) { const int q = 2 * g + j; const f32x4 w4 = W[g & 1][j], ka4 = KA[g & 1][j], kx4 = KX[g & 1][j];
          const f32x2 wl2 = (f32x2){w4.x, w4.y}, wh2 = (f32x2){w4.z, w4.w}, kal = (f32x2){ka4.x, ka4.y}, kah = (f32x2){ka4.z, ka4.w}, kxl = (f32x2){kx4.x, kx4.y}, kxh = (f32x2){kx4.z, kx4.w};
          SB[2 * q] = SB[2 * q] * wl2 + sa2 * kal + v2 * kxl; SB[2 * q + 1] = SB[2 * q + 1] * wh2 + sa2 * kah + v2 * kxh;
          if (PASS == 1) { SP[2 * q] = SP[2 * q] * wl2 + sp2 * kal; SP[2 * q + 1] = SP[2 * q + 1] * wh2 + sp2 * kah; }
          if (PASS == 3) { const f32x4 r4 = RR[g & 1][j]; y0 += SB[2 * q] * (f32x2){r4.x, r4.y}; y1 += SB[2 * q + 1] * (f32x2){r4.z, r4.w}; } }
        asm volatile("" ::: "memory");
      }
      }
      if (PASS == 3) Y[(size_t)(tb + blk * NB + s) * 1024 + ch] = (bf16_t)f2bf((y0.x + y0.y) + (y1.x + y1.y));
    }
  }
  if (PASS == 1) {
#pragma unroll
    for (int q = 0; q < 16; ++q) { *(f32x4*)(Bg + 4 * q) = (f32x4){SB[2 * q].x, SB[2 * q].y, SB[2 * q + 1].x, SB[2 * q + 1].y};
      *(f32x4*)(Pg + 4 * q) = (f32x4){SP[2 * q].x, SP[2 * q].y, SP[2 * q + 1].x, SP[2 * q + 1].y}; }
  }
}
__device__ __forceinline__ void rk_scan(LAS unsigned char* lds, unsigned char* ws, int bid, int wid_s) {
  if (bid >= 64) return;
  const int tid = opaque_tid_w(wid_s), wid = wid_s, lane = tid & 63, h = bid >> 2, i0 = (bid & 3) * 16, i = lane >> 2, q = lane & 3;
  const float* Pg = (const float*)(ws + A_RP) + (size_t)h * RK_NC * 4096; float* Bg = (float*)(ws + A_RB) + (size_t)h * RK_NC * 4096;
  LAS float* PL = (LAS float*)lds; LAS float* SX = (LAS float*)(lds + 32768);
  f32x2 S[8];
  float zf = 0.f; asm volatile("" : "+v"(zf));
#pragma unroll
  for (int j = 0; j < 8; ++j) S[j] = (f32x2){zf, zf};
  f32x4 p0 = *(const f32x4*)(Pg + tid * 8), p1 = *(const f32x4*)(Pg + tid * 8 + 4);
  *(LAS f32x4*)(PL + tid * 8) = p0; *(LAS f32x4*)(PL + tid * 8 + 4) = p1;
  const size_t brow = (size_t)(i0 + i) * 64 + 8 * wid;
  f32x4 bn0 = *(const f32x4*)(Bg + brow), bn1 = *(const f32x4*)(Bg + brow + 4);
  asm volatile("s_waitcnt vmcnt(0) lgkmcnt(0)" ::: "memory"); __builtin_amdgcn_s_barrier(); asm volatile("" ::: "memory");
  for (int c = 0; c < RK_NC; ++c) {
    const LAS float* pl = PL + (c & 1) * 4096 + 8 * wid + q * 16 * 64;
    const f32x4 b0 = bn0, b1 = bn1;
    if (c + 1 < RK_NC) { p0 = *(const f32x4*)(Pg + (size_t)(c + 1) * 4096 + tid * 8); p1 = *(const f32x4*)(Pg + (size_t)(c + 1) * 4096 + tid * 8 + 4);
      bn0 = *(const f32x4*)(Bg + (size_t)(c + 1) * 4096 + brow); bn1 = *(const f32x4*)(Bg + (size_t)(c + 1) * 4096 + brow + 4); }
    f32x2 o0 = (f32x2){zf, zf}, o1 = o0, o2 = o0, o3 = o0;
    f32x4 PA[2][4], PB[2][4];
#pragma unroll
    for (int j = 0; j < 4; ++j) { PA[0][j] = *(const LAS f32x4*)(pl + j * 64); PB[0][j] = *(const LAS f32x4*)(pl + j * 64 + 4); }
#pragma unroll
    for (int g = 0; g < 4; ++g) {
      if (g + 1 < 4) {
#pragma unroll
        for (int j = 0; j < 4; ++j) { PA[(g + 1) & 1][j] = *(const LAS f32x4*)(pl + (4 * (g + 1) + j) * 64); PB[(g + 1) & 1][j] = *(const LAS f32x4*)(pl + (4 * (g + 1) + j) * 64 + 4); }
      }
#pragma unroll
      for (int j = 0; j < 4; ++j) { const int k = 4 * g + j; const f32x4 pa = PA[g & 1][j], pb = PB[g & 1][j];
        const float s = (k & 1) ? S[k >> 1].y : S[k >> 1].x; const f32x2 s2 = (f32x2){s, s};
        o0 += s2 * (f32x2){pa.x, pa.y}; o1 += s2 * (f32x2){pa.z, pa.w}; o2 += s2 * (f32x2){pb.x, pb.y}; o3 += s2 * (f32x2){pb.z, pb.w}; }
      asm volatile("" ::: "memory");
    }
    float ov[8] = {o0.x, o0.y, o1.x, o1.y, o2.x, o2.y, o3.x, o3.y};
#pragma unroll
    for (int j = 0; j < 8; ++j) { float v = ov[j];
      v += __builtin_bit_cast(float, __builtin_amdgcn_update_dpp(0, __builtin_bit_cast(int, v), 0xB1, 0xf, 0xf, false));
      v += __builtin_bit_cast(float, __builtin_amdgcn_update_dpp(0, __builtin_bit_cast(int, v), 0x4E, 0xf, 0xf, false));
      ov[j] = v; }
    const f32x4 r0 = (f32x4){ov[0] + b0.x, ov[1] + b0.y, ov[2] + b0.z, ov[3] + b0.w}, r1 = (f32x4){ov[4] + b1.x, ov[5] + b1.y, ov[6] + b1.z, ov[7] + b1.w};
    if (q == 0) { *(LAS f32x4*)(SX + i * 68 + 8 * wid) = r0; *(LAS f32x4*)(SX + i * 68 + 8 * wid + 4) = r1;
      *(f32x4*)(Bg + (size_t)c * 4096 + brow) = r0; *(f32x4*)(Bg + (size_t)c * 4096 + brow + 4) = r1; }
    asm volatile("s_waitcnt lgkmcnt(0)" ::: "memory"); __builtin_amdgcn_s_barrier(); asm volatile("" ::: "memory");
#pragma unroll
    for (int j = 0; j < 4; ++j) { const f32x4 v = *(const LAS f32x4*)(SX + i * 68 + q * 16 + 4 * j); S[2 * j] = (f32x2){v.x, v.y}; S[2 * j + 1] = (f32x2){v.z, v.w}; }
    if (c + 1 < RK_NC) { LAS float* pn = PL + ((c + 1) & 1) * 4096; *(LAS f32x4*)(pn + tid * 8) = p0; *(LAS f32x4*)(pn + tid * 8 + 4) = p1; }
    asm volatile("s_waitcnt lgkmcnt(0)" ::: "memory"); __builtin_amdgcn_s_barrier(); asm volatile("" ::: "memory");
  }
}
__device__ __forceinline__ void rwkv_post(unsigned char* ws, const float* gng, const float* gnb, int gw, int ngw, int lane) {
  const bf16_t* Y = (const bf16_t*)(ws + A_RP); const bf16_t* P1 = (const bf16_t*)(ws + A_P1); const bf16_t* G = (const bf16_t*)(ws + A0);
  const float* SC = (const float*)(ws + WS_SMALL + SM_SC); bf16_t* AO = (bf16_t*)(ws + A_RA);
  const int c0 = lane * 16;
  float gg[16], gb_[16];
#pragma unroll
  for (int j = 0; j < 4; ++j) { const f32x4 a = *(const f32x4*)(gng + c0 + 4 * j), b = *(const f32x4*)(gnb + c0 + 4 * j);
    gg[4 * j] = a.x; gg[4 * j + 1] = a.y; gg[4 * j + 2] = a.z; gg[4 * j + 3] = a.w; gb_[4 * j] = b.x; gb_[4 * j + 1] = b.y; gb_[4 * j + 2] = b.z; gb_[4 * j + 3] = b.w; }
  for (int t0 = gw; t0 < M; t0 += 2 * ngw) {
    const int t1 = t0 + ngw; const bool has1 = t1 < M; const int tt[2] = {t0, has1 ? t1 : t0};
    u32x4 ya[2], yb[2], va[2], vb[2], ga[2], gb[2]; float scv[2];
#pragma unroll
    for (int r = 0; r < 2; ++r) { const size_t t = (size_t)tt[r];
      ya[r] = *(const u32x4*)(Y + t * 1024 + c0); yb[r] = *(const u32x4*)(Y + t * 1024 + c0 + 8);
      va[r] = *(const u32x4*)(P1 + t * 3328 + 2048 + c0); vb[r] = *(const u32x4*)(P1 + t * 3328 + 2048 + c0 + 8);
      ga[r] = *(const u32x4*)(G + t * 1024 + c0); gb[r] = *(const u32x4*)(G + t * 1024 + c0 + 8);
      scv[r] = SC[t * 16 + (lane >> 2)]; }
#pragma unroll
    for (int r = 0; r < 2; ++r) {
      if (r == 1 && !has1) break;
      float y[16]; float s = 0.f;
      const unsigned yw[8] = {ya[r].x, ya[r].y, ya[r].z, ya[r].w, yb[r].x, yb[r].y, yb[r].z, yb[r].w};
#pragma unroll
      for (int e = 0; e < 8; ++e) { y[2 * e] = bflo(yw[e]); y[2 * e + 1] = bfhi(yw[e]); s += y[2 * e] + y[2 * e + 1]; }
      s += sx<1>(s); s += sx<2>(s);
      const float mean = s * (1.f / 64.f); float q = 0.f;
#pragma unroll
      for (int j = 0; j < 16; ++j) { y[j] -= mean; q += y[j] * y[j]; }
      q += sx<1>(q); q += sx<2>(q);
      const float rs = 1.0f / sqrtf(q * (1.f / 64.f) + 64e-5f);
      const unsigned vw[8] = {va[r].x, va[r].y, va[r].z, va[r].w, vb[r].x, vb[r].y, vb[r].z, vb[r].w}; const unsigned gwv[8] = {ga[r].x, ga[r].y, ga[r].z, ga[r].w, gb[r].x, gb[r].y, gb[r].z, gb[r].w};
      unsigned o[8];
#pragma unroll
      for (int e = 0; e < 8; ++e) {
        const float o0 = (y[2 * e] * rs * gg[2 * e] + gb_[2 * e] + scv[r] * bflo(vw[e])) * bflo(gwv[e]);
        const float o1 = (y[2 * e + 1] * rs * gg[2 * e + 1] + gb_[2 * e + 1] + scv[r] * bfhi(vw[e])) * bfhi(gwv[e]);
        o[e] = pk2(o0, o1); }
      *(u32x4*)(AO + (size_t)tt[r] * 1024 + c0) = (u32x4){o[0], o[1], o[2], o[3]};
      *(u32x4*)(AO + (size_t)tt[r] * 1024 + c0 + 8) = (u32x4){o[4], o[5], o[6], o[7]};
    }
  }
}


#define XB_TMO      128
#define XB_XCNT(j)  (256  + 64 * (j))
#define XB_XSUB(j)  (1280 + 64 * (j))
#define XB_XGEN(j)  (2304 + 64 * (j))
#define XB_TOP      3328
#define XB_TOPGEN   3392
#define XCD_BAR_WORDS 3456
#define XB_SPIN_CAP (1u << 22)
__device__ __forceinline__ unsigned xb_ld(unsigned* p)              { return __hip_atomic_load(p, __ATOMIC_RELAXED, __HIP_MEMORY_SCOPE_AGENT); }
__device__ __forceinline__ unsigned xb_add(unsigned* p, unsigned v) { return __hip_atomic_fetch_add(p, v, __ATOMIC_RELAXED, __HIP_MEMORY_SCOPE_AGENT); }
__device__ __forceinline__ unsigned xb_xcc_id() { return (unsigned)__builtin_amdgcn_s_getreg((3 << 11) | 20) & 0xFu; }
#define XB_SPIN(cond, bar) do { unsigned _sp = 0; while (cond) { __builtin_amdgcn_s_sleep(1); \
    if ((++_sp & 255u) == 0u) { if (xb_ld(&(bar)[XB_TMO])) break; if (_sp > XB_SPIN_CAP) { atomicAdd(&(bar)[XB_TMO], 1u); break; } } } } while (0)
struct XcdBarrier { unsigned* bar; unsigned x; volatile LAS unsigned* st; };
__device__ __forceinline__ XcdBarrier xcd_barrier_post(unsigned* bar, volatile LAS unsigned* st) {
    XcdBarrier b; b.bar = bar; b.x = xb_xcc_id(); b.st = st;
    if (threadIdx.x == 0) (void)xb_add(&bar[XB_XCNT(b.x)], 1u);
    return b;
}
__device__ __forceinline__ void xcd_barrier_complete(unsigned* bar, unsigned x, unsigned& nloc, unsigned& nx) {
    const unsigned G = gridDim.x * gridDim.y * gridDim.z;
    unsigned sum, cnt, mine, sp = 0u;
    for (;;) {
        sum = 0u; cnt = 0u; mine = 0u;
#pragma unroll
        for (unsigned j = 0; j < 16; ++j) { const unsigned c = xb_ld(&bar[XB_XCNT(j)]); sum += c; cnt += (c > 0u) ? 1u : 0u; mine = (j == x) ? c : mine; }
        if (sum == G) break;
        __builtin_amdgcn_s_sleep(1);
        if ((++sp & 255u) == 0u) { if (xb_ld(&bar[XB_TMO])) break; if (sp > XB_SPIN_CAP) { atomicAdd(&bar[XB_TMO], 1u); break; } }
    }
    nloc = mine > 0u ? mine : 1u; nx = cnt > 0u ? cnt : 1u;
}
__device__ __forceinline__ void xcd_barrier(const XcdBarrier& b, int wid_s) {
    asm volatile("s_waitcnt vmcnt(0)" ::: "memory");
    __syncthreads();
    if (opaque_tid_w(wid_s) == 0) {
        unsigned* bar = b.bar;
        __builtin_amdgcn_s_waitcnt(0);
        unsigned nloc = b.st[0], nx = b.st[1];
        if (nloc == 0u) { xcd_barrier_complete(bar, b.x, nloc, nx); b.st[0] = nloc; b.st[1] = nx; }
        const unsigned old = xb_add(&bar[XB_XSUB(b.x)], 1u);
        const unsigned gen = old / nloc;
        if (old + 1u == (gen + 1u) * nloc) {
            __builtin_amdgcn_fence(__ATOMIC_RELEASE, "agent");
            asm volatile("s_waitcnt vmcnt(0)" ::: "memory");
            const unsigned og = xb_add(&bar[XB_TOP], 1u);
            const unsigned tg = og / nx;
            if (og + 1u == (tg + 1u) * nx) xb_add(&bar[XB_TOPGEN], 1u);
            else XB_SPIN(xb_ld(&bar[XB_TOPGEN]) == tg, bar);
            __builtin_amdgcn_fence(__ATOMIC_ACQUIRE, "agent");
            xb_add(&bar[XB_XGEN(b.x)], 1u);
            asm volatile("s_waitcnt vmcnt(0)" ::: "memory");
        } else {
            XB_SPIN(xb_ld(&bar[XB_XGEN(b.x)]) == gen, bar);
            __builtin_amdgcn_fence(__ATOMIC_ACQUIRE, "agent");
            asm volatile("s_waitcnt vmcnt(0)" ::: "memory");
        }
    }
    __syncthreads();
}

struct KArgs { const float* in[53]; float* out; unsigned char* ws; };
#define INP(i) ((const float*)(const __attribute__((address_space(1))) float*)PT[(i)])

__global__ void __launch_bounds__(512, 2) mega_fwd(KArgs args) {
  extern __shared__ __attribute__((aligned(16))) unsigned char lds_raw[];
  LAS unsigned char* lds = (LAS unsigned char*)lds_raw;
  LAS ull* PT = (LAS ull*)(lds + PT_OFF);
  const int wid_s = __builtin_amdgcn_readfirstlane((int)threadIdx.x >> 6);
  if (threadIdx.x == 0) {
#pragma unroll
    for (int i = 0; i < 53; ++i) PT[i] = (ull)args.in[i];
  }
  if (threadIdx.x < 2) ((LAS unsigned*)(lds + PT_OFF + 1024))[threadIdx.x] = 0u;
  unsigned* barw = (unsigned*)(args.ws + WS_SMALL + SM_BAR);
  if (blockIdx.x == 0) for (int i = threadIdx.x; i < XCD_BAR_WORDS; i += 512) __hip_atomic_store(barw + i, 0u, __ATOMIC_RELAXED, __HIP_MEMORY_SCOPE_AGENT);
  __syncthreads();
  cg::grid_group grid = cg::this_grid();
  grid.sync();
  (void)xcd_barrier_post(barw, (volatile LAS unsigned*)(lds + PT_OFF + 1024));
  for (int pq = 0; pq < 2 * NPH; ++pq) {
    const int ph = pq >> 1;
    const PhaseDesc d = PROG[ph];
    if ((pq & 1) && !((REPMASK >> d.kind) & 1)) continue;
    __attribute__((address_space(1))) unsigned char* wsg = (__attribute__((address_space(1))) unsigned char*)args.ws; __attribute__((address_space(1))) float* Xg = (__attribute__((address_space(1))) float*)args.out;
    asm volatile("" : "+s"(wsg), "+s"(Xg));
    unsigned char* ws = (unsigned char*)wsg; float* X = (float*)Xg;
    { unsigned lb = 0; asm volatile("" : "+s"(lb)); lds = (LAS unsigned char*)lds_raw + lb; PT = (LAS ull*)(lds + PT_OFF); }
    int bid = blockIdx.x, G = gridDim.x; asm volatile("" : "+s"(bid), "+s"(G));
    const int wave = wid_s;
#define TIDS const int tid = opaque_tid_w(wid_s), lane = tid & 63, gw = bid * 8 + wave, ngw = G * 8, gtid = bid * 512 + tid, ngt = G * 512; (void)lane; (void)gw; (void)ngw; (void)gtid; (void)ngt
    switch (d.kind) {
      case K_PREP: { TIDS;
        if (d.lda == 1) norm_rows(INP(0), X, INP(d.K), (bf16_t*)(ws + d.a), 1, gw, ngw, lane);
        else norm_rows(X, nullptr, INP(d.K), (bf16_t*)(ws + d.a), d.lda, gw, ngw, lane);
      } break;
      case K_GEMM:
      case K_GEMMR: {
        const int mode = (d.kind == K_GEMMR) ? 0 : (d.act == 2 ? 2 : 1);
        pg8::Gemm g{(const bf16_t*)(ws + d.a), (const bf16_t*)(ws + d.b), d.Mr, d.N, d.K, d.lda, mode == 2 ? 254 : 256}; pg8::StaticOrder S; S.init(d.Mr, d.N, G, bid);
        void* outp = (mode == 0) ? (void*)X : (mode == 2 ? (void*)(ws + A_H) : (void*)(ws + d.c));
        pg8::EpiAny E{mode, outp, d.ldc, d.act, d.x1, lds};
        pg8::gemm_phase<pg8::EpiAny>(lds, g, S, E, wid_s);
      } break;
      case K_CLOCAL: if (d.x0) chunk_local<true>(lds, ws, INP(44), nullptr, bid, G, wid_s); else chunk_local<false>(lds, ws, INP(3), INP(4), bid, G, wid_s); break;
      case K_CSCAN: { TIDS; if (d.x0) chunk_scan<true>(ws, gtid, ngt); else chunk_scan<false>(ws, gtid, ngt); } break;
      case K_COUT: if (d.x0) chunk_out<true>(lds, ws, INP(44), nullptr, INP(45), bid, G, wid_s); else chunk_out<false>(lds, ws, INP(3), INP(4), INP(5), bid, G, wid_s); break;
      case K_RP1: { TIDS; for (int it = bid * 8 + wave; it < 2048; it += G * 8) rk_chunk<1>(lds, ws, INP(15), INP(18), INP(23), INP(24), INP(25), it, wave, lane); } break;
      case K_RSCAN: rk_scan(lds, ws, bid, wid_s); break;
      case K_RREC: { TIDS; for (int it = bid * 8 + wave; it < 2048; it += G * 8) rk_chunk<3>(lds, ws, INP(15), INP(18), INP(23), INP(24), INP(25), it, wave, lane); } break;
      case K_RPOST: { TIDS; rwkv_post(ws, INP(26), INP(27), gw, ngw, lane); } break;
      case K_SB: sb_attn(lds, ws, bid, G, wid_s); break;
      case K_FINAL: { TIDS; norm_rows(X, X, INP(d.K), nullptr, 3, gw, ngw, lane); } break;
      default: break;
    }
    {
      const int j0 = (d.kind == K_PREP) ? d.x0 : d.sj0, j1 = (d.kind == K_PREP) ? d.x1 : d.sj1;
      if (j1 > j0) {
        __syncthreads();
        const int lane2 = opaque_tid_w(wid_s) & 63;
        const bool sideg = (d.kind == K_GEMM) && G > 150;
        const int sw = sideg ? (bid - 150) * 8 + wave : bid * 8 + wave, nsw = sideg ? (G - 150) * 8 : G * 8;
        if (sw >= 0 && nsw > 0) {
          LAS float* scr = (LAS float*)(lds + wave * 16384);
          int base = 0;
          for (int j = j0; j < j1; ++j) { const ConvJob J = JOBS[j]; const int items = (J.KP / 64) * (J.NP / 32);
            const float* W = INP(J.in_idx) + J.in_off; const float* sc = INP(13) + J.sc_off; bf16_t* out = (bf16_t*)(ws + J.out_off);
            int it = sw - base; if (it < 0) it += nsw;
            for (; it < items; it += nsw) conv_item(J, W, sc, out, scr, it, lane2);
            base = (base + items) % nsw; }
        }
      }
    }
    { XcdBarrier xbar; xbar.bar = (unsigned*)(ws + WS_SMALL + SM_BAR); xbar.x = xb_xcc_id(); xbar.st = (volatile LAS unsigned*)(lds + PT_OFF + 1024);
      for (int xs = 0; xs < XSYNC; ++xs) xcd_barrier(xbar, wid_s);
      xcd_barrier(xbar, wid_s); }
  }
}

extern "C" void kernel_launch(void* const* d_in, const int* in_sizes, int n_in, void* d_out, int out_size, void* d_ws, size_t ws_size, hipStream_t stream) {
  static int grid = 0;
  if (grid == 0) {
    if (n_in != 53 || out_size != M * D || ws_size < WS_NEED) { fprintf(stderr, "kernel_launch: unexpected shapes n_in %d out %d ws %zu\n", n_in, out_size, ws_size); grid = -1; return; }
    int dev = 0, cus = 0, per_cu = 0;
    hipGetDevice(&dev); hipDeviceGetAttribute(&cus, hipDeviceAttributeMultiprocessorCount, dev);
    hipFuncSetAttribute((const void*)mega_fwd, hipFuncAttributeMaxDynamicSharedMemorySize, LDS_BYTES);
    hipOccupancyMaxActiveBlocksPerMultiprocessor(&per_cu, (const void*)mega_fwd, 512, LDS_BYTES);
    (void)hipGetLastError();
    if (per_cu < 1) per_cu = 1;
    grid = cus;
  }
  if (grid < 0) return;
  KArgs a{};
  for (int i = 0; i < 53; ++i) a.in[i] = (const float*)d_in[i];
  a.out = (float*)d_out; a.ws = (unsigned char*)d_ws;
  void* params[] = {&a};
  hipError_t e = hipLaunchCooperativeKernel((const void*)mega_fwd, dim3(grid), dim3(512), params, LDS_BYTES, stream);
  if (e != hipSuccess) fprintf(stderr, "cooperative launch failed: %s (grid %d)\n", hipGetErrorString(e), grid);
}
```

```cpp
#include <hip/hip_runtime.h>
#include <hip/hip_cooperative_groups.h>
#include <cstdio>
#include <cstdint>
namespace cg = cooperative_groups;

#define LAS __attribute__((address_space(3)))
typedef unsigned short bf16_t;
typedef short bf16x8 __attribute__((ext_vector_type(8)));
typedef float f32x4 __attribute__((ext_vector_type(4)));
typedef unsigned u32x4 __attribute__((ext_vector_type(4)));
typedef unsigned u32x2 __attribute__((ext_vector_type(2)));
typedef unsigned long long ull;

#ifndef EN_GLA
#define EN_GLA 1
#endif
#ifndef EN_RWKV
#define EN_RWKV 1
#endif
#ifndef EN_SB
#define EN_SB 1
#endif
#ifndef EN_ML
#define EN_ML 1
#endif
#ifndef EN_FFN
#define EN_FFN 1
#endif
#define REPMASK 0
#define XSYNC 0

constexpr int M = 16384, D = 1024, FF = 2816, FF2 = 5632;
constexpr unsigned MiB = 1u << 20;
constexpr unsigned WS_SMALL = 0;
constexpr unsigned SM_DTOT = 0;
constexpr unsigned SM_NST = 512 * 1024;
constexpr unsigned SM_BL = 1024 * 1024;
constexpr unsigned SM_ML = SM_BL + 4096;
constexpr unsigned SM_MST = SM_ML + 4096;
constexpr unsigned SM_UH = SM_MST + 4096;
constexpr unsigned SM_SC = 2 * MiB;
constexpr unsigned SM_BAR = 3 * MiB;
constexpr unsigned WS_W = 4 * MiB;
constexpr unsigned WS_ACT = 22 * MiB;
constexpr unsigned A0 = WS_ACT;
constexpr unsigned A_U = WS_ACT + 32 * MiB;
constexpr unsigned A_H = WS_ACT + 120 * MiB;
constexpr unsigned A_P = WS_ACT + 32 * MiB;
constexpr unsigned A_BS = WS_ACT + 136 * MiB;
constexpr unsigned A_P1 = WS_ACT + 64 * MiB;
constexpr unsigned A_Y = WS_ACT + 168 * MiB;
constexpr unsigned A_RA = WS_ACT + 32 * MiB;
constexpr size_t WS_NEED = 256ull * MiB;
constexpr unsigned W_GLA_IN = WS_W, W_GLA_OUT = WS_W + 3328u * 1024 * 2;
constexpr unsigned W_UP = WS_W, W_DOWN = WS_W + 5632u * 1024 * 2;
constexpr unsigned W_R1 = WS_W, W_R2A = W_R1 + 3328u * 2048 * 2, W_R2G = W_R2A + 2048u * 256 * 2, W_ROUT = W_R2G + 1024u * 256 * 2;
constexpr unsigned W_QKV = WS_ACT + 208 * MiB, W_SBOUT = W_QKV + 3072u * 1024 * 2;
constexpr unsigned WF_A = WS_ACT + 208 * MiB, WF_B = WS_ACT + 216 * MiB + 512 * 1024;
constexpr unsigned DOWN_OFF = 5632u * 1024 * 2;
static_assert(W_ROUT + 2u * MiB <= WS_ACT && W_DOWN + 1024u * 2816 * 2 <= WS_ACT, "weights region");
constexpr int RING_BYTES = 131072, PT_OFF = RING_BYTES, LDS_BYTES = 147456;

struct ConvJob { int in_idx, in_off, K, N, NP, KP, k_off, col_base, ldo, row_off, sc_off, sc_mode; unsigned out_off; int perm; };
#define MU(j) ((j) * 1024)
__constant__ ConvJob JOBS[] = {
    {2, 0, 1024, 3088, 3328, 1024, 0, 0, 1024, 0, 0, 0, W_GLA_IN},
    {6, 0, 1024, 1024, 1024, 1024, 0, 0, 1024, 0, 0, 0, W_GLA_OUT},
    {14, 0,       1024, 1024, 1024, 1024, 0, 0,    2048, 0,    MU(0), 2, W_R1},
    {14, 0,       1024, 1024, 1024, 1024, 0, 1024, 2048, 0,    MU(0), 1, W_R1},
    {14, 1048576, 1024, 1024, 1024, 1024, 0, 0,    2048, 1024, MU(2), 2, W_R1},
    {14, 1048576, 1024, 1024, 1024, 1024, 0, 1024, 2048, 1024, MU(2), 1, W_R1},
    {14, 2097152, 1024, 1024, 1024, 1024, 0, 0,    2048, 2048, MU(3), 2, W_R1},
    {14, 2097152, 1024, 1024, 1024, 1024, 0, 1024, 2048, 2048, MU(3), 1, W_R1},
    {16, 0, 1024, 64, 64, 1024, 0, 0,    2048, 3072, MU(1), 2, W_R1},
    {16, 0, 1024, 64, 64, 1024, 0, 1024, 2048, 3072, MU(1), 1, W_R1},
    {19, 0, 1024, 64, 64, 1024, 0, 0,    2048, 3136, MU(4), 2, W_R1},
    {19, 0, 1024, 64, 64, 1024, 0, 1024, 2048, 3136, MU(4), 1, W_R1},
    {21, 0, 1024, 128, 128, 1024, 0, 0,    2048, 3200, MU(5), 2, W_R1},
    {21, 0, 1024, 128, 128, 1024, 0, 1024, 2048, 3200, MU(5), 1, W_R1},
    {17, 0, 64, 1024, 1024, 256, 0, 0, 256, 0, 0, 0, W_R2A},
    {20, 0, 64, 1024, 1024, 256, 64, 0, 256, 1024, 0, 0, W_R2A},
    {22, 0, 128, 1024, 1024, 256, 128, 0, 256, 0, 0, 0, W_R2G},
    {28, 0, 1024, 1024, 1024, 1024, 0, 0, 1024, 0, 0, 0, W_ROUT},
    {35, 0, 1024, 3072, 3072, 1024, 0, 0, 1024, 0, 0, 0, W_QKV},
    {36, 0, 1024, 1024, 1024, 1024, 0, 0, 1024, 0, 0, 0, W_SBOUT},
    {43, 0, 1024, 3080, 3328, 1024, 0, 0, 1024, 0, 0, 0, W_GLA_IN},
    {46, 0, 1024, 1024, 1024, 1024, 0, 0, 1024, 0, 0, 0, W_GLA_OUT},
    {8, 0, 1024, 5632, 5632, 1024, 0, 0, 1024, 0, 0, 0, WF_A, 1},   {11, 0, 2816, 1024, 1024, 2816, 0, 0, 2816, 0, 0, 0, WF_A + DOWN_OFF},
    {30, 0, 1024, 5632, 5632, 1024, 0, 0, 1024, 0, 0, 0, W_UP, 1},  {33, 0, 2816, 1024, 1024, 2816, 0, 0, 2816, 0, 0, 0, W_DOWN},
    {38, 0, 1024, 5632, 5632, 1024, 0, 0, 1024, 0, 0, 0, WF_B, 1},  {41, 0, 2816, 1024, 1024, 2816, 0, 0, 2816, 0, 0, 0, WF_B + DOWN_OFF},
    {48, 0, 1024, 5632, 5632, 1024, 0, 0, 1024, 0, 0, 0, WF_A, 1},  {51, 0, 2816, 1024, 1024, 2816, 0, 0, 2816, 0, 0, 0, WF_A + DOWN_OFF},
};

enum { K_PREP = 0, K_GEMM, K_GEMMR, K_CLOCAL, K_CSCAN, K_COUT, K_CONV, K_RREC, K_RPOST, K_SB, K_FINAL, K_RP1, K_RSCAN, K_NOP };
struct PhaseDesc { int kind; unsigned a, b, c; int lda, K, Mr, N, ldc, act, x0, x1, sj0, sj1; };
#define FFN_PHASES(fb, wf, pj0, pj1, sj0_, sj1_) \
  {K_PREP, A0 + 4096u, 0, 0, 4, fb, 0, 0, 0, 0, pj0, pj1, 0, 0}, \
  {EN_FFN ? K_GEMM : K_NOP, A0, wf, 0, 1024, 1024, 16640, 5632, 0, 2, 0, fb, sj0_, sj1_}, \
  {EN_FFN ? K_GEMMR : K_NOP, A_H, (wf) + DOWN_OFF, 0, 2816, 2816, 16384, 1024, 0, 0, 0, 0, 0, 0}
__constant__ PhaseDesc PROG[] = {
  {K_PREP, A0, 0, 0, 1, 1, 0, 0, 0, 0, 0, 2},
  {EN_GLA ? K_GEMM : K_NOP, A0, W_GLA_IN, A_P, 1024, 1024, 16384, 3328, 3328, 0, 0, 0},
  {EN_GLA ? K_CLOCAL : K_NOP, 0, 0, 0, 0, 0, 0, 0, 0, 0, 0, 0},
  {EN_GLA ? K_CSCAN : K_NOP, 0, 0, 0, 0, 0, 0, 0, 0, 0, 0, 0},
  {EN_GLA ? K_COUT : K_NOP, 0, 0, 0, 0, 0, 0, 0, 0, 0, 0, 0, 22, 24},
  {EN_GLA ? K_GEMMR : K_NOP, A0, W_GLA_OUT, 0, 1024, 1024, 16384, 1024, 0, 0, 0, 0},
  FFN_PHASES(7, WF_A, 0, 0, 2, 18),
  {K_PREP, A0, 0, 0, 2, 12, 0, 0, 0, 0, 0, 0, 0, 0},
  {EN_RWKV ? K_GEMM : K_NOP, A0, W_R1, A_P1, 2048, 2048, 16384, 3328, 3328, 1, 0, 0},
  {EN_RWKV ? K_GEMM : K_NOP, A_P1 + 3072u * 2, W_R2A, A0, 3328, 256, 16384, 2048, 2048, 0, 0, 0},
  {EN_RWKV ? K_RP1 : K_NOP, 0, 0, 0, 0, 0, 0, 0, 0, 0, 0, 0},
  {EN_RWKV ? K_RSCAN : K_NOP, 0, 0, 0, 0, 0, 0, 0, 0, 0, 0, 0},
  {EN_RWKV ? K_RREC : K_NOP, 0, 0, 0, 0, 0, 0, 0, 0, 0, 0, 0},
  {EN_RWKV ? K_GEMM : K_NOP, A_P1 + 3072u * 2, W_R2G, A0, 3328, 256, 16384, 1024, 1024, 0, 0, 0},
  {EN_RWKV ? K_RPOST : K_NOP, 0, 0, 0, 0, 0, 0, 0, 0, 0, 0, 0},
  {EN_RWKV ? K_GEMMR : K_NOP, A_RA, W_ROUT, 0, 1024, 1024, 16384, 1024, 0, 0, 0, 0},
  FFN_PHASES(29, W_UP, 24, 26, 18, 20),
  {K_PREP, A0, 0, 0, 0, 34, 0, 0, 0, 0, 0, 0, 0, 0},
  {EN_SB ? K_GEMM : K_NOP, A0, W_QKV, A_P, 1024, 1024, 16384, 3072, 3072, 0, 0, 0},
  {EN_SB ? K_SB : K_NOP, 0, 0, 0, 0, 0, 0, 0, 0, 0, 0, 0, 26, 28},
  {EN_SB ? K_GEMMR : K_NOP, A0, W_SBOUT, 0, 1024, 1024, 16384, 1024, 0, 0, 0, 0},
  FFN_PHASES(37, WF_B, 0, 0, 20, 22),
  {K_PREP, A0, 0, 0, 0, 42, 0, 0, 0, 0, 0, 0, 0, 0},
  {EN_ML ? K_GEMM : K_NOP, A0, W_GLA_IN, A_P, 1024, 1024, 16384, 3328, 3328, 0, 0, 0},
  {EN_ML ? K_CLOCAL : K_NOP, 0, 0, 0, 0, 0, 0, 0, 0, 0, 1, 0},
  {EN_ML ? K_CSCAN : K_NOP, 0, 0, 0, 0, 0, 0, 0, 0, 0, 1, 0},
  {EN_ML ? K_COUT : K_NOP, 0, 0, 0, 0, 0, 0, 0, 0, 0, 1, 0, 28, 30},
  {EN_ML ? K_GEMMR : K_NOP, A0, W_GLA_OUT, 0, 1024, 1024, 16384, 1024, 0, 0, 0, 0},
  FFN_PHASES(47, WF_A, 0, 0, 0, 0),
  {K_FINAL, 0, 0, 0, 0, 52, 0, 0, 0, 0, 0, 0},
};
constexpr int NPH = sizeof(PROG) / sizeof(PhaseDesc);

__device__ __forceinline__ int opaque_tid_w(int wid_s) { unsigned z = 0u; asm volatile("" : "+v"(z)); int t = (wid_s << 6) | (int)__builtin_amdgcn_mbcnt_hi(~0u, __builtin_amdgcn_mbcnt_lo(~0u, z)); return t; }
__device__ __forceinline__ unsigned f2bf(float f) { unsigned u = __builtin_bit_cast(unsigned, f); return (u + 0x7fffu + ((u >> 16) & 1u)) >> 16; }
__device__ __forceinline__ float bf2f(unsigned b) { return __builtin_bit_cast(float, b << 16); }
__device__ __forceinline__ unsigned pk2(float lo, float hi) { return f2bf(lo) | (f2bf(hi) << 16); }
__device__ __forceinline__ float bflo(unsigned w) { return __builtin_bit_cast(float, w << 16); }
__device__ __forceinline__ float bfhi(unsigned w) { return __builtin_bit_cast(float, w & 0xffff0000u); }
template <int MASK> __device__ __forceinline__ float sx(float v) { return __builtin_bit_cast(float, __builtin_amdgcn_ds_swizzle(__builtin_bit_cast(int, v), (MASK << 10) | 0x1f)); }
template <int Q> __device__ __forceinline__ float quad_bcast(float v) { return __builtin_bit_cast(float, __builtin_amdgcn_update_dpp(0, __builtin_bit_cast(int, v), Q * 0x55, 0xf, 0xf, false)); }
__device__ __forceinline__ float wave_sum(float v) {
#pragma unroll
  for (int o = 1; o < 64; o <<= 1) v += __shfl_xor(v, o);
  return v;
}
__device__ __forceinline__ float logsig(float z) { return fminf(z, 0.f) - __logf(1.f + __expf(-fabsf(z))); }
__device__ __forceinline__ float sigm(float z) { return 1.f / (1.f + __expf(-z)); }
__device__ __forceinline__ float dpp_row_shr(float v, int n) {
  const int iv = __builtin_bit_cast(int, v); int r;
  switch (n) { case 1: r = __builtin_amdgcn_update_dpp(0, iv, 0x111, 0xf, 0xf, true); break; case 2: r = __builtin_amdgcn_update_dpp(0, iv, 0x112, 0xf, 0xf, true); break;
               case 4: r = __builtin_amdgcn_update_dpp(0, iv, 0x114, 0xf, 0xf, true); break; default: r = __builtin_amdgcn_update_dpp(0, iv, 0x118, 0xf, 0xf, true); break; }
  return __builtin_bit_cast(float, r);
}
__device__ __forceinline__ float wave_scan63(float v) {
  v += dpp_row_shr(v, 1); v += dpp_row_shr(v, 2); v += dpp_row_shr(v, 4); v += dpp_row_shr(v, 8);
  v += __builtin_bit_cast(float, __builtin_amdgcn_update_dpp(0, __builtin_bit_cast(int, v), 0x142, 0xa, 0xf, false));
  v += __builtin_bit_cast(float, __builtin_amdgcn_update_dpp(0, __builtin_bit_cast(int, v), 0x143, 0xc, 0xf, false));
  return v;
}
__device__ __forceinline__ f32x4 mfma16(bf16x8 a, bf16x8 b, f32x4 c) { return __builtin_amdgcn_mfma_f32_16x16x32_bf16(a, b, c, 0, 0, 0); }
#define LDSV8(off) (*(const LAS bf16x8*)(lds + (off)))

namespace pg8 {
constexpr int BM = 256, BK = 64, HALF = 128, HTB = HALF * BK * 2, NXCD = 8, WGM = 8;
__device__ __forceinline__ int lds_byte(int r, int c) { const int st = (r >> 4) * 2 + (c >> 5), rr = r & 15, cc = c & 31, ob = rr * 64 + cc * 2; return st * 1024 + (ob ^ (((ob >> 9) & 1) << 5)); }
__device__ __forceinline__ void stage_rc(int b, int& R, int& C) { const int st = b / 1024, sb = b % 1024, swz = sb ^ (((sb >> 9) & 1) << 5); R = (st >> 1) * 16 + swz / 64; C = (st & 1) * 32 + (swz % 64) / 2; }
__device__ __forceinline__ int perm32(int rho) { const int n = rho >> 4, i = rho & 15; return 8 * (i >> 2) + 4 * n + (i & 3); }
struct Unit { int pm, pn; };
struct Gemm { const bf16_t* A; const bf16_t* Bt; int M, N, K, lda, mrows; };
struct StaticOrder {
  int nM, nN, nwg, G, c;
  __device__ void init(int M_, int N_, int G_, int c_) { nM = M_ / BM; nN = N_ / BM; nwg = nM * nN; G = G_; c = c_; }
  __device__ bool next(int i, Unit& u) const {
    const long L = (long)i * G + c; if (L >= nwg) return false;
    int wgid = (int)L; { const int q = nwg / NXCD, r = nwg % NXCD, xcd = wgid % NXCD, off = wgid / NXCD; wgid = (xcd < r ? xcd * (q + 1) : r * (q + 1) + (xcd - r) * q) + off; }
    const int nig = WGM * nN, gid = wgid / nig, fm = gid * WGM, gsz = (nM - fm) < WGM ? (nM - fm) : WGM;
    u.pm = fm + ((wgid % nig) % gsz); u.pn = (wgid % nig) / gsz; return true;
  }
};
__device__ __forceinline__ unsigned cvt_pk_bf16(float lo, float hi) { unsigned r; asm volatile("v_cvt_pk_bf16_f32 %0, %1, %2" : "=v"(r) : "v"(lo), "v"(hi)); return r; }

struct EpiBf16 {
  static constexpr bool PERM = true;
  bf16_t* O; int ldc; int act;
  __device__ __forceinline__ void operator()(const f32x4 (&acc)[2][2][4][2], const Unit& u, int wr, int wc, int fr, int fq) const {
    const int row0 = u.pm * BM + wr * 64 + fr; const int col0 = u.pn * BM + wc * 32 + 8 * fq;
    const bool sp = (act == 1) && (u.pn == 12);
#pragma unroll
    for (int ai = 0; ai < 2; ++ai)
#pragma unroll
      for (int m = 0; m < 4; ++m) { bf16_t* rowp = O + (size_t)(row0 + ai * HALF + m * 16) * ldc + col0;
#pragma unroll
        for (int bj = 0; bj < 2; ++bj) { f32x4 v0 = acc[ai][bj][m][0], v1 = acc[ai][bj][m][1];
          if (sp) {
            if (bj == 1) { for (int e = 0; e < 4; ++e) { v0[e] = sigm(v0[e]); v1[e] = sigm(v1[e]); } }
            else if (wc < 2) { for (int e = 0; e < 4; ++e) { v0[e] = tanhf(v0[e]); v1[e] = tanhf(v1[e]); } }
          }
          u32x4 w; w.x = cvt_pk_bf16(v0[0], v0[1]); w.y = cvt_pk_bf16(v0[2], v0[3]); w.z = cvt_pk_bf16(v1[0], v1[1]); w.w = cvt_pk_bf16(v1[2], v1[3]);
          *(u32x4*)(rowp + bj * HALF) = w; } }
  }
};
struct EpiResid {
  static constexpr bool PERM = false;
  float* X;
  __device__ __forceinline__ void operator()(const f32x4 (&acc)[2][2][4][2], const Unit& u, int wr, int wc, int fr, int fq) const {
#pragma unroll
    for (int ai = 0; ai < 2; ++ai) {
      f32x4 xv[4][2][2];
#pragma unroll
      for (int m = 0; m < 4; ++m) { const int row = u.pm * BM + ai * HALF + wr * 64 + m * 16 + fr;
#pragma unroll
        for (int bj = 0; bj < 2; ++bj)
#pragma unroll
          for (int n = 0; n < 2; ++n) xv[m][bj][n] = *(const f32x4*)(X + (size_t)row * 1024 + u.pn * BM + bj * HALF + wc * 32 + n * 16 + 4 * fq); }
#pragma unroll
      for (int m = 0; m < 4; ++m) { const int row = u.pm * BM + ai * HALF + wr * 64 + m * 16 + fr;
#pragma unroll
        for (int bj = 0; bj < 2; ++bj)
#pragma unroll
          for (int n = 0; n < 2; ++n) *(f32x4*)(X + (size_t)row * 1024 + u.pn * BM + bj * HALF + wc * 32 + n * 16 + 4 * fq) = xv[m][bj][n] + acc[ai][bj][m][n]; }
    }
  }
};
__device__ __forceinline__ float dpp_ror1(float v) { return __builtin_bit_cast(float, __builtin_amdgcn_update_dpp(0, __builtin_bit_cast(int, v), 0x121, 0xf, 0xf, false)); }
__device__ __forceinline__ float dpp_ror2(float v) { return __builtin_bit_cast(float, __builtin_amdgcn_update_dpp(0, __builtin_bit_cast(int, v), 0x122, 0xf, 0xf, false)); }
struct EpiFfn {
  bf16_t* H; int fb; LAS unsigned char* ldsb;
  __device__ __forceinline__ void operator()(const f32x4 (&acc)[2][2][4][2], const Unit& u, int wr, int wc, int fr, int fq) const {
    LAS float* HB = (LAS float*)(ldsb + PT_OFF + 2048); const LAS ull* PTt = (const LAS ull*)(ldsb + PT_OFF);
    const float* cw = (const float*)(const __attribute__((address_space(1))) float*)PTt[fb + 2]; const float* cb = (const float*)(const __attribute__((address_space(1))) float*)PTt[fb + 3];
    if (fr >= 14) {
#pragma unroll
      for (int ai = 0; ai < 2; ++ai)
#pragma unroll
        for (int bj = 0; bj < 2; ++bj)
#pragma unroll
          for (int n = 0; n < 2; ++n) *(LAS f32x4*)(HB + ((ai * 2 + wr) * 2 + (fr - 14)) * 256 + bj * 128 + wc * 32 + 8 * fq + 4 * n) = acc[ai][bj][3][n];
    }
    asm volatile("s_waitcnt lgkmcnt(0)" ::: "memory"); __builtin_amdgcn_s_barrier(); asm volatile("" ::: "memory");
    const int c0 = u.pn * 128 + wc * 32 + 8 * fq;
#pragma unroll
    for (int n = 0; n < 2; ++n) {
      asm volatile("" ::: "memory");
      const int c = c0 + 4 * n;
      const f32x4 wg0 = *(const f32x4*)(cw + c), wg1 = *(const f32x4*)(cw + FF2 + c), wg2 = *(const f32x4*)(cw + 2 * FF2 + c), bg = *(const f32x4*)(cb + c);
      const f32x4 wu0 = *(const f32x4*)(cw + FF + c), wu1 = *(const f32x4*)(cw + FF2 + FF + c), wu2 = *(const f32x4*)(cw + 2 * FF2 + FF + c), bu = *(const f32x4*)(cb + FF + c);
#pragma unroll
      for (int ai = 0; ai < 2; ++ai) {
        asm volatile("" ::: "memory");
        f32x4 hg1 = (f32x4){0.f, 0.f, 0.f, 0.f}, hg2 = hg1, hu1 = hg1, hu2 = hg1;
        const int ps = (wr == 1) ? ai * 2 : (ai == 1 ? 1 : -1);
        if (ps >= 0 && fr < 2) { const LAS float* hb = HB + ps * 512 + wc * 32 + 8 * fq + 4 * n;
          const f32x4 g62 = *(const LAS f32x4*)(hb), g63 = *(const LAS f32x4*)(hb + 256), u62 = *(const LAS f32x4*)(hb + 128), u63 = *(const LAS f32x4*)(hb + 256 + 128);
          hg1 = g63; hu1 = u63; hg2 = (fr == 0) ? g62 : g63; hu2 = (fr == 0) ? u62 : u63; }
#pragma unroll
        for (int m = 0; m < 4; ++m) {
          const f32x4 xg = acc[ai][0][m][n], xu = acc[ai][1][m][n];
          float hh[4];
#pragma unroll
          for (int e = 0; e < 4; ++e) {
            const float tg1 = dpp_ror1(xg[e]), tg2 = dpp_ror2(xg[e]), tu1 = dpp_ror1(xu[e]), tu2 = dpp_ror2(xu[e]);
            float qg1, qg2, qu1, qu2;
            if (m > 0) { qg1 = dpp_ror1(acc[ai][0][m - 1][n][e]); qg2 = dpp_ror2(acc[ai][0][m - 1][n][e]); qu1 = dpp_ror1(acc[ai][1][m - 1][n][e]); qu2 = dpp_ror2(acc[ai][1][m - 1][n][e]); }
            else { qg1 = hg1[e]; qg2 = hg2[e]; qu1 = hu1[e]; qu2 = hu2[e]; }
            const float pg1 = (fr == 0) ? qg1 : tg1, pg2 = (fr < 2) ? qg2 : tg2, pu1 = (fr == 0) ? qu1 : tu1, pu2 = (fr < 2) ? qu2 : tu2;
            const float gv = wg0[e] * pg2 + wg1[e] * pg1 + wg2[e] * xg[e] + bg[e];
            const float uv = wu0[e] * pu2 + wu1[e] * pu1 + wu2[e] * xu[e] + bu[e];
            hh[e] = gv * __builtin_amdgcn_rcpf(1.f + __expf(-gv)) * uv;
          }
          const int rl = ai * HALF + wr * 64 + m * 16 + fr; const int gr = 254 * u.pm - 2 + rl;
          if (rl >= 2 && gr < 16384) { u32x2 w; w.x = cvt_pk_bf16(hh[0], hh[1]); w.y = cvt_pk_bf16(hh[2], hh[3]); *(u32x2*)(H + (size_t)gr * 2816 + c) = w; }
          asm volatile("" ::: "memory"); __builtin_amdgcn_sched_barrier(0);
        }
      }
    }
  }
};
struct EpiAny {
  int mode; void* P; int ldc, act, fb; LAS unsigned char* ldsb;
  bool perm_() const { return mode != 0; }
  __device__ __forceinline__ void operator()(const f32x4 (&acc)[2][2][4][2], const Unit& u, int wr, int wc, int fr, int fq) const {
    if (mode == 2) { EpiFfn ef{(bf16_t*)P, fb, ldsb}; ef(acc, u, wr, wc, fr, fq); }
    else if (mode == 1) { EpiBf16 eb{(bf16_t*)P, ldc, act}; eb(acc, u, wr, wc, fr, fq); }
    else { EpiResid er{(float*)P}; er(acc, u, wr, wc, fr, fq); }
  }
};
template <class Epi>
__device__ __forceinline__ void gemm_phase(LAS unsigned char* lds, const Gemm g, const StaticOrder& S, const Epi& E, int wid_s) {
  const int tid = opaque_tid_w(wid_s), wid = __builtin_amdgcn_readfirstlane(tid >> 6), lane = tid & 63, wr = wid >> 2, wc = wid & 3, fr = lane & 15, fq = lane >> 4;
  const int K = g.K, nt = K / BK, lda = g.lda;
  unsigned voffA[2], voffB[2];
#pragma unroll
  for (int i = 0; i < 2; ++i) { int R, C; stage_rc(tid * 16 + i * 8192, R, C); const int Rb = (E.mode != 0) ? ((R & ~31) + perm32(R & 31)) : R;
    voffA[i] = (unsigned)(R * lda + C) * 2u; voffB[i] = (unsigned)(Rb * K + C) * 2u; }
  const size_t kstep = (size_t)(BK * 2);
  const size_t hA = (size_t)HALF * lda * 2, tA = (size_t)g.mrows * lda * 2, hB = (size_t)HALF * K * 2, tB = 2 * hB;
  const unsigned ldsw = (unsigned)wid * 1024u;
  const int aoff = lds_byte(wr * 64 + fr, fq * 8), boff = lds_byte(wc * 32 + fr, fq * 8);
#define PG8_SA(b, h) (((b) * 2 + (h)) * HTB)
#define PG8_SB(b, h) ((4 + (b) * 2 + (h)) * HTB)
#define PG8_STAGE(bufoff, gbase, voff) do { _Pragma("unroll") for (int _i = 0; _i < 2; ++_i) \
    __builtin_amdgcn_global_load_lds((const unsigned*)((const char*)(gbase) + (voff)[_i]), (LAS unsigned*)(lds + (bufoff) + ldsw + _i * 8192), 16, 0, 0); } while (0)
#define PG8_LDA(dst, b, h) do { _Pragma("unroll") for (int m = 0; m < 4; ++m) _Pragma("unroll") for (int k = 0; k < 2; ++k) dst[m][k] = *(const LAS bf16x8*)(lds + PG8_SA(b, h) + aoff + m * 2048 + k * 1024); } while (0)
#define PG8_LDB(dst, b, h) do { _Pragma("unroll") for (int n = 0; n < 2; ++n) _Pragma("unroll") for (int k = 0; k < 2; ++k) dst[n][k] = *(const LAS bf16x8*)(lds + PG8_SB(b, h) + boff + n * 2048 + k * 1024); } while (0)
#define PG8_MMA(ai, bj, At, Bt) do { __builtin_amdgcn_s_setprio(1); _Pragma("unroll") for (int m = 0; m < 4; ++m) _Pragma("unroll") for (int n = 0; n < 2; ++n) _Pragma("unroll") for (int k = 0; k < 2; ++k) \
    acc[ai][bj][m][n] = __builtin_amdgcn_mfma_f32_16x16x32_bf16(Bt[n][k], At[m][k], acc[ai][bj][m][n], 0, 0, 0); __builtin_amdgcn_s_setprio(0); } while (0)
#define PG8_WAIT_V(n) asm volatile("s_waitcnt vmcnt(" #n ")" ::: "memory")
#define PG8_WAIT_L(n) asm volatile("s_waitcnt lgkmcnt(" #n ")" ::: "memory")
#define PG8_BAR __builtin_amdgcn_s_barrier()
#define PG8_SCHED __builtin_amdgcn_sched_barrier(0)
  Unit cur, nxt; int ui = 0;
  if (!S.next(0, cur)) return;
  f32x4 acc[2][2][4][2];
#pragma unroll
  for (int a = 0; a < 2; ++a)
#pragma unroll
    for (int b = 0; b < 2; ++b)
#pragma unroll
      for (int m = 0; m < 4; ++m)
#pragma unroll
        for (int n = 0; n < 2; ++n) acc[a][b][m][n] = (f32x4){0.f, 0.f, 0.f, 0.f};
  bf16x8 At[4][2], B0[2][2], B1[2][2];
  const char* cA = (const char*)g.A + (size_t)cur.pm * tA; const char* cB = (const char*)g.Bt + (size_t)cur.pn * tB;
  PG8_STAGE(PG8_SB(0, 0), cB, voffB); PG8_STAGE(PG8_SB(0, 1), cB + hB, voffB); PG8_STAGE(PG8_SA(0, 0), cA, voffA); PG8_STAGE(PG8_SA(0, 1), cA + hA, voffA);
  if (wr == 1) PG8_BAR;
  PG8_WAIT_V(2); PG8_BAR;
  PG8_STAGE(PG8_SB(1, 0), cB + kstep, voffB); PG8_STAGE(PG8_SA(1, 0), cA + kstep, voffA); PG8_STAGE(PG8_SB(1, 1), cB + hB + kstep, voffB);
  PG8_WAIT_V(6); PG8_BAR;
  for (;;) {
    const bool has_next = S.next(ui + 1, nxt);
    const char* nA = has_next ? (const char*)g.A + (size_t)nxt.pm * tA : cA; const char* nB = has_next ? (const char*)g.Bt + (size_t)nxt.pn * tB : cB;
    for (int t = 0; t < nt; t += 2) {
      const bool last = (t == nt - 2);
      const char* a1 = cA + (size_t)(t + 1) * kstep;
      const char* a2 = last ? nA : cA + (size_t)(t + 2) * kstep; const char* b2 = last ? nB : cB + (size_t)(t + 2) * kstep;
      const char* a3 = a2 + kstep; const char* b3 = b2 + kstep;
      PG8_LDB(B0, 0, 0); PG8_LDB(B1, 0, 1); PG8_SCHED; PG8_LDA(At, 0, 0); PG8_STAGE(PG8_SA(1, 1), a1 + hA, voffA);
      PG8_WAIT_V(8); PG8_WAIT_L(0); PG8_BAR; PG8_MMA(0, 0, At, B0); PG8_MMA(0, 1, At, B1); PG8_BAR; PG8_SCHED;
      PG8_LDA(At, 0, 1); PG8_STAGE(PG8_SB(0, 0), b2, voffB); PG8_STAGE(PG8_SB(0, 1), b2 + hB, voffB); PG8_STAGE(PG8_SA(0, 0), a2, voffA);
      PG8_WAIT_V(8); PG8_WAIT_L(0); PG8_BAR; PG8_MMA(1, 0, At, B0); PG8_MMA(1, 1, At, B1); PG8_BAR; PG8_SCHED;
      PG8_LDB(B0, 1, 0); PG8_LDB(B1, 1, 1); PG8_SCHED; PG8_LDA(At, 1, 0); PG8_STAGE(PG8_SA(0, 1), a2 + hA, voffA);
      PG8_WAIT_V(8); PG8_WAIT_L(0); PG8_BAR; PG8_MMA(0, 0, At, B0); PG8_MMA(0, 1, At, B1); PG8_BAR; PG8_SCHED;
      PG8_LDA(At, 1, 1); PG8_STAGE(PG8_SB(1, 0), b3, voffB); PG8_STAGE(PG8_SB(1, 1), b3 + hB, voffB); PG8_STAGE(PG8_SA(1, 0), a3, voffA);
      PG8_WAIT_V(8); PG8_WAIT_L(0); PG8_BAR; PG8_MMA(1, 0, At, B0); PG8_MMA(1, 1, At, B1); PG8_BAR; PG8_SCHED;
    }
    if (wr == 0) PG8_BAR;
    { const int l2 = opaque_tid_w(wid_s) & 63; E(acc, cur, wr, wc, l2 & 15, l2 >> 4); }
    if (!has_next) break;
#pragma unroll
    for (int a = 0; a < 2; ++a)
#pragma unroll
      for (int b = 0; b < 2; ++b)
#pragma unroll
        for (int m = 0; m < 4; ++m)
#pragma unroll
          for (int n = 0; n < 2; ++n) acc[a][b][m][n] = (f32x4){0.f, 0.f, 0.f, 0.f};
    cur = nxt; cA = nA; cB = nB; ++ui;
    if (wr == 1) PG8_BAR;
  }
  PG8_WAIT_V(0);
  PG8_BAR;
#undef PG8_SA
#undef PG8_SB
#undef PG8_STAGE
#undef PG8_LDA
#undef PG8_LDB
#undef PG8_MMA
#undef PG8_WAIT_V
#undef PG8_WAIT_L
#undef PG8_BAR
#undef PG8_SCHED
}
}

__device__ __forceinline__ void conv_item(const ConvJob& J, const float* W, const float* sc, bf16_t* out, LAS float* scr, int item, int lane) {
  const int nblk = J.NP / 32, cb = item / nblk, nb = item % nblk, c0 = 64 * cb, n0 = 32 * nb;
#pragma unroll 8
  for (int i = 0; i < 32; ++i) { const int cc = 2 * i + (lane >> 5); const int k = c0 + cc - J.k_off; const int n = n0 + (lane & 31);
    float v = 0.f;
    if (k >= 0 && k < J.K && n < J.N) { v = W[(size_t)k * J.N + n]; if (J.sc_mode == 1) v *= sc[k]; else if (J.sc_mode == 2) v *= (1.f - sc[k]); }
    scr[cc * 33 + (lane & 31)] = v; }
  asm volatile("s_waitcnt lgkmcnt(0)" ::: "memory");
  const int c = lane & 7;
#pragma unroll
  for (int j = 0; j < 4; ++j) { const int n = (lane >> 3) + 8 * j; const LAS float* s = scr + (8 * c) * 33 + n;
    u32x4 o; o.x = pk2(s[0 * 33], s[1 * 33]); o.y = pk2(s[2 * 33], s[3 * 33]); o.z = pk2(s[4 * 33], s[5 * 33]); o.w = pk2(s[6 * 33], s[7 * 33]);
    int nr = n0 + n; if (J.perm) { const int half = nr >= FF ? 1 : 0; const int cc = nr - half * FF; nr = (cc >> 7) * 256 + half * 128 + (cc & 127); }
    *(u32x4*)(out + (size_t)(J.row_off + nr) * J.ldo + J.col_base + c0 + 8 * c) = o; }
  asm volatile("s_waitcnt lgkmcnt(0)" ::: "memory");
}

__device__ __forceinline__ float wave_total_n(float v) {
  v += dpp_row_shr(v, 1); v += dpp_row_shr(v, 2); v += dpp_row_shr(v, 4); v += dpp_row_shr(v, 8);
  v += __builtin_bit_cast(float, __builtin_amdgcn_update_dpp(0, __builtin_bit_cast(int, v), 0x142, 0xa, 0xf, false));
  v += __builtin_bit_cast(float, __builtin_amdgcn_update_dpp(0, __builtin_bit_cast(int, v), 0x143, 0xc, 0xf, false));
  return __builtin_bit_cast(float, __builtin_amdgcn_readlane(__builtin_bit_cast(int, v), 63));
}
__device__ __forceinline__ void norm_rows(const float* src, float* cpy, const float* g, bf16_t* out, int mode, int gw, int ngw, int lane) {
  f32x4 gg[4];
#pragma unroll
  for (int j = 0; j < 4; ++j) gg[j] = ((const f32x4*)g)[lane + 64 * j];
  if (mode == 4) { if (gw == 0) { unsigned zz = 0u; asm volatile("" : "+v"(zz)); for (int j = 0; j < 4; ++j) ((u32x4*)(out - 2048))[lane + 64 * j] = (u32x4){zz, zz, zz, zz}; } mode = 0; }
  for (int m0 = gw; m0 < M; m0 += 2 * ngw) {
    const int m1 = m0 + ngw;
    const bool has1 = m1 < M;
    f32x4 v[2][4]; float ss0 = 0.f, ss1 = 0.f;
#pragma unroll
    for (int j = 0; j < 4; ++j) { v[0][j] = ((const f32x4*)(src + (size_t)m0 * D))[lane + 64 * j]; v[1][j] = has1 ? ((const f32x4*)(src + (size_t)m1 * D))[lane + 64 * j] : (f32x4){0.f, 0.f, 0.f, 0.f}; }
#pragma unroll
    for (int j = 0; j < 4; ++j) { ss0 += (v[0][j].x * v[0][j].x + v[0][j].y * v[0][j].y) + (v[0][j].z * v[0][j].z + v[0][j].w * v[0][j].w);
      ss1 += (v[1][j].x * v[1][j].x + v[1][j].y * v[1][j].y) + (v[1][j].z * v[1][j].z + v[1][j].w * v[1][j].w); }
    ss0 = wave_total_n(ss0); ss1 = wave_total_n(ss1);
#pragma unroll
    for (int rr = 0; rr < 2; ++rr) {
      if (rr == 1 && !has1) break;
      const int m = rr ? m1 : m0; const float rs = 1.0f / sqrtf((rr ? ss1 : ss0) * (1.f / D) + 1e-6f);
#pragma unroll
      for (int j = 0; j < 4; ++j) {
        const f32x4 y = v[rr][j] * rs * gg[j];
        if (mode == 3) { ((f32x4*)(cpy + (size_t)m * D))[lane + 64 * j] = y; }
        else {
          if (mode == 1) ((f32x4*)(cpy + (size_t)m * D))[lane + 64 * j] = v[rr][j];
          u32x2 w; w.x = pk2(y.x, y.y); w.y = pk2(y.z, y.w);
          if (mode == 2) {
            *(u32x2*)(out + (size_t)m * 2048 + 4 * (lane + 64 * j)) = w;
            if (m + 1 < M) *(u32x2*)(out + (size_t)(m + 1) * 2048 + 1024 + 4 * (lane + 64 * j)) = w;
            if (m == 0) { unsigned zz = 0u; asm volatile("" : "+v"(zz)); *(u32x2*)(out + 1024 + 4 * (lane + 64 * j)) = (u32x2){zz, zz}; }
          } else *(u32x2*)(out + (size_t)m * 1024 + 4 * (lane + 64 * j)) = w;
        }
      }
    }
  }
}

__device__ __forceinline__ void conv_load8(const bf16_t* U, const bf16_t* UH, int t, int half, int col, float (&o)[8]) {
  if (t < 0) { for (int e = 0; e < 8; ++e) o[e] = 0.f; return; }
  const bf16_t* p = (t >= half * 8192) ? U + (size_t)(t - half * 8192) * FF2 + col : UH + (size_t)(t - 8190) * FF2 + col;
  const u32x4 w = *(const u32x4*)p;
  o[0] = bflo(w.x); o[1] = bfhi(w.x); o[2] = bflo(w.y); o[3] = bfhi(w.y); o[4] = bflo(w.z); o[5] = bfhi(w.z); o[6] = bflo(w.w); o[7] = bfhi(w.w);
}
__device__ __forceinline__ void ffn_conv(unsigned char* ws, const float* cw, const float* cb, int half, int gtid, int ngt) {
  const bf16_t* U = (const bf16_t*)(ws + A_U); bf16_t* UH = (bf16_t*)(ws + WS_SMALL + SM_UH); bf16_t* H = (bf16_t*)(ws + A_H);
  constexpr int RUN = 16, NCG = FF / 8, NP = (8192 / RUN) * NCG;
  for (int p = gtid; p < NP; p += ngt) {
    const int run = p / NCG, cg8 = p % NCG, c = cg8 * 8; const int t0 = half * 8192 + run * RUN;
    float wg[3][8], wu[3][8], bg[8], bu[8];
#pragma unroll
    for (int j = 0; j < 3; ++j)
#pragma unroll
      for (int e = 0; e < 8; ++e) { wg[j][e] = cw[j * FF2 + c + e]; wu[j][e] = cw[j * FF2 + FF + c + e]; }
#pragma unroll
    for (int e = 0; e < 8; ++e) { bg[e] = cb[c + e]; bu[e] = cb[FF + c + e]; }
    float g2[8], g1[8], u2[8], u1[8], g0[8], u0[8];
    conv_load8(U, UH, t0 - 2, half, c, g2); conv_load8(U, UH, t0 - 1, half, c, g1);
    conv_load8(U, UH, t0 - 2, half, FF + c, u2); conv_load8(U, UH, t0 - 1, half, FF + c, u1);
    for (int i = 0; i < RUN; ++i) {
      const int t = t0 + i;
      conv_load8(U, UH, t, half, c, g0); conv_load8(U, UH, t, half, FF + c, u0);
      float o[8];
#pragma unroll
      for (int e = 0; e < 8; ++e) {
        const float gv = wg[0][e] * g2[e] + wg[1][e] * g1[e] + wg[2][e] * g0[e] + bg[e];
        const float uv = wu[0][e] * u2[e] + wu[1][e] * u1[e] + wu[2][e] * u0[e] + bu[e];
        o[e] = gv * sigm(gv) * uv; g2[e] = g1[e]; g1[e] = g0[e]; u2[e] = u1[e]; u1[e] = u0[e];
      }
      u32x4 w; w.x = pk2(o[0], o[1]); w.y = pk2(o[2], o[3]); w.z = pk2(o[4], o[5]); w.w = pk2(o[6], o[7]);
      *(u32x4*)(H + (size_t)t * FF + c) = w;
    }
  }
  if (half == 0) {
    for (int p = gtid; p < 2 * FF2 / 8; p += ngt) { const int r = p / (FF2 / 8), cc = (p % (FF2 / 8)) * 8;
      *(u32x4*)(UH + (size_t)r * FF2 + cc) = *(const u32x4*)(U + (size_t)(8190 + r) * FF2 + cc); }
  }
}

constexpr int CS = 132;
constexpr int C_CUM = 0, C_QD = 33792, C_KI = 51200, C_VT = 68608, C_PP = 105472, C_GATE = 114688;
constexpr int G_AL = C_GATE, G_SEG = C_GATE + 4096, G_MISC = C_GATE + 6144;
constexpr float QSCALE = 0.08838834764831845f;
#define GM(i) ((LAS float*)(lds + G_MISC + (i) * 256))
__device__ __forceinline__ void unpack8(const u32x4 w, float (&o)[8]) { o[0] = bflo(w.x); o[1] = bfhi(w.x); o[2] = bflo(w.y); o[3] = bfhi(w.y); o[4] = bflo(w.z); o[5] = bfhi(w.z); o[6] = bflo(w.w); o[7] = bfhi(w.w); }
__device__ __forceinline__ u32x4 pack8(const float (&o)[8]) { return (u32x4){pk2(o[0], o[1]), pk2(o[2], o[3]), pk2(o[4], o[5]), pk2(o[6], o[7])}; }

__device__ __forceinline__ void gla_cum(LAS unsigned char* lds, const bf16_t* P, int c, int h, const float* wau, const float* balpha, int tid) {
  LAS float* AL = (LAS float*)(lds + G_AL); LAS float* SEG = (LAS float*)(lds + G_SEG); LAS float* CUM = (LAS float*)(lds + C_CUM);
  if (tid < 128) { const int t = tid >> 1, hf = tid & 1; float o[8]; unpack8(*(const u32x4*)(P + (size_t)(c * 64 + t) * 3328 + 3072 + hf * 8), o);
#pragma unroll
    for (int e = 0; e < 8; ++e) AL[t * 16 + hf * 8 + e] = o[e]; }
  __syncthreads();
  const int d = tid & 127, tq = tid >> 7;
  float wa[16];
#pragma unroll
  for (int j = 0; j < 16; ++j) wa[j] = wau[j * 512 + h * 128 + d];
  const float b = balpha[h * 128 + d];
  float run = 0.f;
#pragma unroll 2
  for (int i = 0; i < 16; ++i) { const int t = tq * 16 + i; float z = b;
#pragma unroll
    for (int j = 0; j < 16; ++j) z += AL[t * 16 + j] * wa[j];
    run += logsig(z) * (1.f / 16.f); CUM[t * CS + d] = run; }
  SEG[tq * 128 + d] = run;
  __syncthreads();
  float off = 0.f;
  for (int q = 0; q < tq; ++q) off += SEG[q * 128 + d];
  for (int i = 0; i < 16; ++i) CUM[(tq * 16 + i) * CS + d] += off;
  __syncthreads();
}
__device__ __forceinline__ void ml_gates(LAS unsigned char* lds, const bf16_t* P, int c, int h, const float* bif, int tid) {
  if (tid < 64) { const size_t r = (size_t)(c * 64 + tid) * 3328;
    GM(1)[tid] = bf2f(P[r + 3072 + h]) + bif[h];
    GM(0)[tid] = logsig(bf2f(P[r + 3076 + h]) + bif[4 + h]); }
  __syncthreads();
  if (tid == 0) { float run = 0.f; for (int t = 0; t < 64; ++t) { run += GM(0)[t]; GM(0)[t] = run; } }
  __syncthreads();
}
__device__ __forceinline__ void stage_vt(LAS unsigned char* lds, const bf16_t* P, int c, int h, int wid, int lane) {
  LAS bf16_t* VT = (LAS bf16_t*)(lds + C_VT);
  u32x4 vv[4];
#pragma unroll
  for (int g = 0; g < 4; ++g) vv[g] = *(const u32x4*)(P + (size_t)(c * 64 + lane) * 3328 + 1024 + h * 256 + 8 * (4 * wid + g));
#pragma unroll
  for (int g = 0; g < 4; ++g) { const unsigned w[4] = {vv[g].x, vv[g].y, vv[g].z, vv[g].w}; const int v0 = 8 * (4 * wid + g);
#pragma unroll
    for (int e = 0; e < 4; ++e) { VT[(v0 + 2 * e) * 72 + lane] = (bf16_t)(w[e] & 0xffffu); VT[(v0 + 2 * e + 1) * 72 + lane] = (bf16_t)(w[e] >> 16); } }
}

template <bool IS_ML>
__device__ __forceinline__ void chunk_local(LAS unsigned char* lds, unsigned char* ws, const float* w1, const float* w2, int bid, int nb, int wid_s) {
  const int tid = opaque_tid_w(wid_s), wid = wid_s, lane = tid & 63;
  const bf16_t* P = (const bf16_t*)(ws + A_P); bf16_t* BS = (bf16_t*)(ws + A_BS);
  float* DT = (float*)(ws + WS_SMALL + SM_DTOT);
  LAS bf16_t* KT = (LAS bf16_t*)(lds + C_QD); LAS float* CUM = (LAS float*)(lds + C_CUM);
  LAS float* SCL = (LAS float*)(lds + G_MISC + 1280);
  for (int it = bid; it < 1024; it += nb) {
    const int c = it >> 2, h = it & 3;
    if (IS_ML) {
      ml_gates(lds, P, c, h, w1, tid);
      if (tid == 0) { const float bl = GM(0)[63]; float mx = -1e30f; for (int s = 0; s < 64; ++s) mx = fmaxf(mx, bl - GM(0)[s] + GM(1)[s]); SCL[0] = bl; SCL[1] = mx;
        ((float*)(ws + WS_SMALL + SM_BL))[c * 4 + h] = bl; ((float*)(ws + WS_SMALL + SM_ML))[c * 4 + h] = mx; }
      __syncthreads();
    } else gla_cum(lds, P, c, h, w1, w2, tid);
    {
      u32x4 kv[2];
#pragma unroll
      for (int g = 0; g < 2; ++g) kv[g] = *(const u32x4*)(P + (size_t)(c * 64 + lane) * 3328 + 512 + h * 128 + 8 * (2 * wid + g));
      stage_vt(lds, P, c, h, wid, lane);
      const float fml = IS_ML ? __expf(SCL[0] - GM(0)[lane] + GM(1)[lane] - SCL[1]) * QSCALE : 0.f;
#pragma unroll
      for (int g = 0; g < 2; ++g) { const int d0 = 8 * (2 * wid + g); float k8[8]; unpack8(kv[g], k8);
        float f8[8];
        if (IS_ML) { for (int e = 0; e < 8; ++e) f8[e] = fml; }
        else { const f32x4 ca = *(const LAS f32x4*)(CUM + lane * CS + d0), cb = *(const LAS f32x4*)(CUM + lane * CS + d0 + 4), la = *(const LAS f32x4*)(CUM + 63 * CS + d0), lb = *(const LAS f32x4*)(CUM + 63 * CS + d0 + 4);
          f8[0] = __expf(la.x - ca.x); f8[1] = __expf(la.y - ca.y); f8[2] = __expf(la.z - ca.z); f8[3] = __expf(la.w - ca.w);
          f8[4] = __expf(lb.x - cb.x); f8[5] = __expf(lb.y - cb.y); f8[6] = __expf(lb.z - cb.z); f8[7] = __expf(lb.w - cb.w);
          if (lane == 63) { *(f32x4*)(DT + (c * 4 + h) * 128 + d0) = la; *(f32x4*)(DT + (c * 4 + h) * 128 + d0 + 4) = lb; } }
#pragma unroll
        for (int e = 0; e < 8; ++e) { const float kw = k8[e] * f8[e]; KT[(d0 + e) * 72 + lane] = (bf16_t)f2bf(kw);
          if (IS_ML) { const float ns = wave_total_n(kw); if (lane == 0) DT[(c * 4 + h) * 128 + d0 + e] = ns; } }
      }
    }
    __syncthreads();
    f32x4 acc[2][8];
#pragma unroll
    for (int a = 0; a < 2; ++a)
#pragma unroll
      for (int b = 0; b < 8; ++b) acc[a][b] = (f32x4){0.f, 0.f, 0.f, 0.f};
    const int fr = lane & 15, kg = lane >> 4;
#pragma unroll
    for (int ks = 0; ks < 2; ++ks) {
      bf16x8 av[2];
#pragma unroll
      for (int a = 0; a < 2; ++a) av[a] = LDSV8(C_VT + (((wid * 2 + a) * 16 + fr) * 72 + ks * 32 + kg * 8) * 2);
#pragma unroll
      for (int b = 0; b < 8; ++b) { const bf16x8 bv = LDSV8(C_QD + ((b * 16 + fr) * 72 + ks * 32 + kg * 8) * 2);
#pragma unroll
        for (int a = 0; a < 2; ++a) acc[a][b] = mfma16(av[a], bv, acc[a][b]); }
    }
#pragma unroll
    for (int a = 0; a < 2; ++a)
#pragma unroll
      for (int b = 0; b < 8; ++b)
#pragma unroll
        for (int r = 0; r < 4; ++r) { const int v = (wid * 2 + a) * 16 + 4 * kg + r, d = b * 16 + fr;
          BS[((size_t)(c * 4 + h) * 256 + v) * 128 + d] = (bf16_t)f2bf(acc[a][b][r]); }
    __syncthreads();
  }
}

template <bool IS_ML>
__device__ __forceinline__ void chunk_scan(unsigned char* ws, int gtid, int ngt) {
  bf16_t* BS = (bf16_t*)(ws + A_BS);
  const float* DT = (const float*)(ws + WS_SMALL + SM_DTOT); float* NST = (float*)(ws + WS_SMALL + SM_NST);
  const float* BL = (const float*)(ws + WS_SMALL + SM_BL); const float* MLc = (const float*)(ws + WS_SMALL + SM_ML); float* MST = (float*)(ws + WS_SMALL + SM_MST);
  for (int e = gtid; e < 131072; e += ngt) {
    const int h = e >> 15, v = (e >> 7) & 255, d = e & 127;
    float st = 0.f, m = 0.f, n = 0.f;
#pragma unroll 16
    for (int c = 0; c < 256; ++c) {
      const size_t idx = ((size_t)(c * 4 + h) * 256 + v) * 128 + d;
      const float b = bf2f(BS[idx]); BS[idx] = (bf16_t)f2bf(st);
      if (IS_ML) {
        const float bl = BL[c * 4 + h], ml = MLc[c * 4 + h]; const float mn = fmaxf(bl + m, ml);
        const float cs = __expf(bl + m - mn), wsc = __expf(ml - mn);
        st = cs * st + wsc * b;
        if (v == 0) { NST[(c * 4 + h) * 128 + d] = n; n = cs * n + wsc * DT[(c * 4 + h) * 128 + d]; if (d == 0) MST[c * 4 + h] = m; }
        m = mn;
      } else st = st * __expf(DT[(c * 4 + h) * 128 + d]) + b;
    }
  }
}

template <bool IS_ML>
__device__ __forceinline__ void chunk_out(LAS unsigned char* lds, unsigned char* ws, const float* w1, const float* w2, const float* onorm, int bid, int nb, int wid_s) {
  const int tid = opaque_tid_w(wid_s), wid = tid >> 6, lane = tid & 63, fr = lane & 15, kg = lane >> 4;
  const bf16_t* P = (const bf16_t*)(ws + A_P); const bf16_t* BS = (const bf16_t*)(ws + A_BS); bf16_t* AO = (bf16_t*)(ws + A0);
  LAS bf16_t* QD = (LAS bf16_t*)(lds + C_QD); LAS bf16_t* KI = (LAS bf16_t*)(lds + C_KI); LAS bf16_t* VT = (LAS bf16_t*)(lds + C_VT); LAS bf16_t* PP = (LAS bf16_t*)(lds + C_PP);
  LAS float* CUM = (LAS float*)(lds + C_CUM); LAS float* OO = (LAS float*)lds; LAS float* SCL = (LAS float*)(lds + G_MISC + 1280);
  for (int it = bid; it < 1024; it += nb) {
    const int c = it >> 2, h = it & 3;
    if (IS_ML) {
      ml_gates(lds, P, c, h, w1, tid);
      if (tid < 64) { const float mp = ((const float*)(ws + WS_SMALL + SM_MST))[c * 4 + h]; const float bt = GM(0)[tid]; const float inter = bt + mp;
        float mx = -1e30f; for (int s = 0; s <= tid; ++s) mx = fmaxf(mx, GM(1)[s] - GM(0)[s]);
        const float mt = fmaxf(inter, mx + bt); GM(2)[tid] = mt; GM(4)[tid] = __expf(inter - mt); GM(3)[tid] = 0.f; }
      __syncthreads();
    } else gla_cum(lds, P, c, h, w1, w2, tid);
    {
      u32x4 qv[2], kv[2];
#pragma unroll
      for (int g = 0; g < 2; ++g) { const bf16_t* rp = P + (size_t)(c * 64 + lane) * 3328 + h * 128 + 8 * (2 * wid + g); qv[g] = *(const u32x4*)rp; kv[g] = *(const u32x4*)(rp + 512); }
      stage_vt(lds, P, c, h, wid, lane);
#pragma unroll
      for (int g = 0; g < 2; ++g) { const int d0 = 8 * (2 * wid + g); float q8[8], k8[8]; unpack8(qv[g], q8); unpack8(kv[g], k8);
        if (IS_ML) { for (int e = 0; e < 8; ++e) k8[e] *= QSCALE; }
        else { const f32x4 ca = *(const LAS f32x4*)(CUM + lane * CS + d0), cb = *(const LAS f32x4*)(CUM + lane * CS + d0 + 4); const float cu[8] = {ca.x, ca.y, ca.z, ca.w, cb.x, cb.y, cb.z, cb.w};
#pragma unroll
          for (int e = 0; e < 8; ++e) { const float ex = __expf(cu[e]); q8[e] *= ex * QSCALE; k8[e] *= __builtin_amdgcn_rcpf(ex); } }
        *(LAS u32x4*)(lds + C_QD + (lane * 136 + d0) * 2) = pack8(q8); *(LAS u32x4*)(lds + C_KI + (lane * 136 + d0) * 2) = pack8(k8); }
    }
    __syncthreads();
    float dinter = 0.f;
    if (IS_ML) {
      const int t = tid >> 3, part = tid & 7; const float* NST = (const float*)(ws + WS_SMALL + SM_NST) + (c * 4 + h) * 128;
      float s = 0.f; for (int j = 0; j < 16; ++j) { const int d = part * 16 + j; s += bf2f(QD[t * 136 + d]) * NST[d]; }
      s += sx<1>(s); s += sx<2>(s); s += sx<4>(s); dinter = s;
    }
    { const int tt = wid >> 1;
#pragma unroll
      for (int q = 0; q < 2; ++q) { const int st = 2 * (wid & 1) + q; f32x4 sc = (f32x4){0.f, 0.f, 0.f, 0.f};
        if (st <= tt) {
#pragma unroll
          for (int ks = 0; ks < 4; ++ks) sc = mfma16(LDSV8(C_QD + ((tt * 16 + fr) * 136 + ks * 32 + kg * 8) * 2), LDSV8(C_KI + ((st * 16 + fr) * 136 + ks * 32 + kg * 8) * 2), sc);
        }
        const int s = st * 16 + fr;
#pragma unroll
        for (int r = 0; r < 4; ++r) { const int t = tt * 16 + 4 * kg + r; float v = (s <= t) ? sc[r] : 0.f;
          if (IS_ML) { v = (s <= t) ? v * __expf(GM(0)[t] - GM(0)[s] + GM(1)[s] - GM(2)[t]) : 0.f;
            float rs = v; rs += sx<1>(rs); rs += sx<2>(rs); rs += sx<4>(rs); rs += sx<8>(rs);
            if (fr == 0) atomicAdd((float*)&GM(3)[t], rs); }
          PP[t * 72 + s] = (bf16_t)f2bf(v); }
      }
    }
    __syncthreads();
    f32x4 acc[8], acc2[8];
    { const int tt = wid & 3, vb = (wid >> 2) * 8;
#pragma unroll
      for (int j = 0; j < 8; ++j) { acc[j] = (f32x4){0.f, 0.f, 0.f, 0.f}; acc2[j] = (f32x4){0.f, 0.f, 0.f, 0.f}; }
#pragma unroll
      for (int ks = 0; ks < 2; ++ks) { const bf16x8 a = LDSV8(C_PP + ((tt * 16 + fr) * 72 + ks * 32 + kg * 8) * 2);
#pragma unroll
        for (int j = 0; j < 8; ++j) acc[j] = mfma16(a, LDSV8(C_VT + (((vb + j) * 16 + fr) * 72 + ks * 32 + kg * 8) * 2), acc[j]); }
#pragma unroll 2
      for (int ks = 0; ks < 4; ++ks) { const bf16x8 a = LDSV8(C_QD + ((tt * 16 + fr) * 136 + ks * 32 + kg * 8) * 2);
#pragma unroll
        for (int j = 0; j < 8; ++j) { const bf16x8 bv = *(const bf16x8*)(BS + ((size_t)(c * 4 + h) * 256 + (vb + j) * 16 + fr) * 128 + ks * 32 + kg * 8);
          if (IS_ML) acc2[j] = mfma16(a, bv, acc2[j]); else acc[j] = mfma16(a, bv, acc[j]); } }
    }
    __syncthreads();
    { const int tt = wid & 3, vb = (wid >> 2) * 8;
#pragma unroll
      for (int r = 0; r < 4; ++r) { const int t = tt * 16 + 4 * kg + r;
        float sc = 1.f, inv = 1.f;
        if (IS_ML) { sc = GM(4)[t]; }
#pragma unroll
        for (int j = 0; j < 8; ++j) { float o = acc[j][r]; if (IS_ML) o += sc * acc2[j][r]; OO[t * 260 + (vb + j) * 16 + fr] = o * inv; } }
    }
    __syncthreads();
    { const int t = tid >> 3, part = tid & 7, v0 = part * 32;
      float dn = 1.f;
      if (IS_ML) { const float den = GM(3)[t] + GM(4)[t] * dinter; dn = 1.f / fmaxf(fabsf(den), __expf(-GM(2)[t])); }
      float ov[32]; float ss = 0.f;
#pragma unroll
      for (int i = 0; i < 8; ++i) { const f32x4 o4 = *(const LAS f32x4*)(OO + t * 260 + v0 + 4 * i); ov[4 * i] = o4.x * dn; ov[4 * i + 1] = o4.y * dn; ov[4 * i + 2] = o4.z * dn; ov[4 * i + 3] = o4.w * dn; }
#pragma unroll
      for (int i = 0; i < 32; ++i) ss += ov[i] * ov[i];
      ss += sx<1>(ss); ss += sx<2>(ss); ss += sx<4>(ss);
      const float rs = 1.0f / sqrtf(ss * (1.f / 256.f) + 1e-6f);
      const bf16_t* gp = P + (size_t)(c * 64 + t) * 3328 + 2048 + h * 256 + v0; bf16_t* op = AO + (size_t)(c * 64 + t) * 1024 + h * 256 + v0;
#pragma unroll
      for (int i = 0; i < 4; ++i) { float g8[8]; unpack8(*(const u32x4*)(gp + 8 * i), g8); const f32x4 n0 = *(const f32x4*)(onorm + h * 256 + v0 + 8 * i), n1 = *(const f32x4*)(onorm + h * 256 + v0 + 8 * i + 4);
        const float nn[8] = {n0.x, n0.y, n0.z, n0.w, n1.x, n1.y, n1.z, n1.w}; float o8[8];
#pragma unroll
        for (int e = 0; e < 8; ++e) { const float gz = g8[e]; const float gate = IS_ML ? sigm(gz) : gz * sigm(gz); o8[e] = ov[8 * i + e] * rs * nn[e] * gate; }
        *(u32x4*)(op + 8 * i) = pack8(o8); }
    }
    __syncthreads();
  }
}

constexpr int S_Q = 0, S_K = 18432, S_V = 27648, S_Z = 36864, S_P = 70144, S_CARRY = 88576, S_FLAG = 89088;
constexpr float SB_EXIT = -120.f;
__device__ __forceinline__ void sb_attn(LAS unsigned char* lds, unsigned char* ws, int bid, int nb, int wid_s) {
  const int tid = opaque_tid_w(wid_s), wid = tid >> 6, lane = tid & 63, fr = lane & 15, kg = lane >> 4;
  const bf16_t* QKV = (const bf16_t*)(ws + A_P); bf16_t* AO = (bf16_t*)(ws + A0);
  LAS bf16_t* QS = (LAS bf16_t*)(lds + S_Q); LAS bf16_t* KS = (LAS bf16_t*)(lds + S_K); LAS bf16_t* VT = (LAS bf16_t*)(lds + S_V);
  LAS float* Z = (LAS float*)(lds + S_Z); LAS bf16_t* PP = (LAS bf16_t*)(lds + S_P); LAS float* CARRY = (LAS float*)(lds + S_CARRY); LAS volatile int* FLAG = (LAS volatile int*)(lds + S_FLAG);
  for (int it = bid; it < 2048; it += nb) {
    const int h = it & 15, qb = it >> 4;
    { const int row = tid >> 2, part = tid & 3; const bf16_t* src = QKV + (size_t)(qb * 128 + row) * 3072 + h * 64 + part * 16;
      u32x4 a = *(const u32x4*)src, b = *(const u32x4*)(src + 8);
      unsigned w[8] = {a.x, a.y, a.z, a.w, b.x, b.y, b.z, b.w}; unsigned o[8];
#pragma unroll
      for (int e = 0; e < 8; ++e) o[e] = pk2(bflo(w[e]) * 0.125f, bfhi(w[e]) * 0.125f);
      *(LAS u32x4*)(lds + S_Q + (row * 72 + part * 16) * 2) = (u32x4){o[0], o[1], o[2], o[3]};
      *(LAS u32x4*)(lds + S_Q + (row * 72 + part * 16 + 8) * 2) = (u32x4){o[4], o[5], o[6], o[7]};
      if (tid < 128) CARRY[tid] = 0.f;
      if (tid < 2) FLAG[tid] = 0;
    }
    f32x4 acc[4];
#pragma unroll
    for (int j = 0; j < 4; ++j) acc[j] = (f32x4){0.f, 0.f, 0.f, 0.f};
    int iter = 0;
    u32x4 kwn, vwn;
    { const int row = tid >> 3, part = tid & 7; const bf16_t* src = QKV + (size_t)((2 * qb + 1) * 64 + row) * 3072 + 1024 + h * 64 + part * 8; kwn = *(const u32x4*)src; vwn = *(const u32x4*)(src + 1024); }
    for (int kb = 2 * qb + 1; kb >= 0; --kb, ++iter) {
      { const int row = tid >> 3, part = tid & 7;
        const u32x4 kw = kwn; const u32x4 vw = vwn;
        if (kb > 0) { const bf16_t* src = QKV + (size_t)((kb - 1) * 64 + row) * 3072 + 1024 + h * 64 + part * 8; kwn = *(const u32x4*)src; vwn = *(const u32x4*)(src + 1024); }
        *(LAS u32x4*)(lds + S_K + (row * 72 + part * 8) * 2) = kw;
        const unsigned vv[4] = {vw.x, vw.y, vw.z, vw.w};
#pragma unroll
        for (int e = 0; e < 4; ++e) { VT[(part * 8 + 2 * e) * 72 + row] = (bf16_t)(vv[e] & 0xffffu); VT[(part * 8 + 2 * e + 1) * 72 + row] = (bf16_t)(vv[e] >> 16); }
      }
      __syncthreads();
      if (tid == 0) FLAG[(iter + 1) & 1] = 0;
#pragma unroll
      for (int kt = 0; kt < 4; ++kt) { f32x4 z = (f32x4){0.f, 0.f, 0.f, 0.f};
#pragma unroll
        for (int ks = 0; ks < 2; ++ks) z = mfma16(LDSV8(S_Q + ((wid * 16 + fr) * 72 + ks * 32 + kg * 8) * 2), LDSV8(S_K + ((kt * 16 + fr) * 72 + ks * 32 + kg * 8) * 2), z);
#pragma unroll
        for (int r = 0; r < 4; ++r) Z[(wid * 16 + 4 * kg + r) * 65 + kt * 16 + fr] = z[r]; }
      __syncthreads();
      { const int row = tid >> 2, seg = tid & 3; const int tq = qb * 128 + row; const int s0 = kb * 64 + seg * 16;
        float lbv[16], lkv[16]; float segsum = 0.f;
#pragma unroll
        for (int j = 0; j < 16; ++j) { const float z = Z[row * 65 + seg * 16 + j]; const float lb = logsig(z); const bool valid = (s0 + j) < tq;
          lbv[j] = valid ? lb : -1e30f; lkv[j] = valid ? lb - z : 0.f; segsum += lkv[j]; }
        const float v0 = quad_bcast<0>(segsum), v1 = quad_bcast<1>(segsum), v2 = quad_bcast<2>(segsum), v3 = quad_bcast<3>(segsum);
        const float right = (seg < 1 ? v1 : 0.f) + (seg < 2 ? v2 : 0.f) + (seg < 3 ? v3 : 0.f);
        const float cin = CARRY[row];
        float run = cin + right;
#pragma unroll
        for (int j = 15; j >= 0; --j) { const float w = __expf(lbv[j] + run); run += lkv[j]; PP[row * 72 + seg * 16 + j] = (bf16_t)f2bf(w); }
        const float cnew = cin + v0 + v1 + v2 + v3;
        if (seg == 0) { CARRY[row] = cnew; if (cnew > SB_EXIT) FLAG[iter & 1] = 1; }
      }
      __syncthreads();
#pragma unroll
      for (int ks = 0; ks < 2; ++ks) { const bf16x8 a = LDSV8(S_P + ((wid * 16 + fr) * 72 + ks * 32 + kg * 8) * 2);
#pragma unroll
        for (int j = 0; j < 4; ++j) acc[j] = mfma16(a, LDSV8(S_V + ((j * 16 + fr) * 72 + ks * 32 + kg * 8) * 2), acc[j]); }
      const int cont = FLAG[iter & 1];
      if (!cont) break;
      __syncthreads();
    }
#pragma unroll
    for (int j = 0; j < 4; ++j)
#pragma unroll
      for (int r = 0; r < 4; ++r) AO[(size_t)(qb * 128 + wid * 16 + 4 * kg + r) * 1024 + h * 64 + j * 16 + fr] = (bf16_t)f2bf(acc[j][r]);
    __syncthreads();
  }
}

constexpr int RK_L = 128, RK_NC = M / RK_L, RK_STEP = 1536;
constexpr unsigned A_RB = A_Y, A_RP = A_Y + 32 * MiB;
typedef float f32x2 __attribute__((ext_vector_type(2)));
template <int NB> struct RRaw { unsigned r[NB], k[NB], v[NB], w[NB], a[NB]; };
__device__ __forceinline__ float wave_total(float v) { const float s = wave_scan63(v); return __builtin_bit_cast(float, __builtin_amdgcn_readlane(__builtin_bit_cast(int, s), 63)); }
template <int NB> __device__ __forceinline__ void rk_issue(RRaw<NB>& R, const unsigned char* ws, int ch, int t0) {
  const bf16_t* P1 = (const bf16_t*)(ws + A_P1); const bf16_t* P2 = (const bf16_t*)(ws + A0);
#pragma unroll
  for (int q = 0; q < NB; ++q) { const size_t t = (size_t)(t0 + q);
    R.r[q] = P1[t * 3328 + ch]; R.k[q] = P1[t * 3328 + 1024 + ch]; R.v[q] = P1[t * 3328 + 2048 + ch];
    R.w[q] = P2[t * 2048 + ch]; R.a[q] = P2[t * 2048 + 1024 + ch]; }
}
template <bool WSC, int NB>
__device__ __forceinline__ void rk_prep8(const RRaw<NB>& R, LAS unsigned char* wl, float w0c, float a0c, float kkc, float kac, float rkc, float* SC, int t0, int h, int lane) {
#pragma unroll
  for (int q = 0; q < NB; ++q) {
    const float r = bf2f(R.r[q]), kr = bf2f(R.k[q]), v = bf2f(R.v[q]);
    const float wp = bf2f(R.w[q]) + w0c, ap = bf2f(R.a[q]) + a0c;
    const float decay = __expf(-0.6065306597126334f * __builtin_amdgcn_rcpf(1.f + __expf(-wp)));
    const float a = __builtin_amdgcn_rcpf(1.f + __expf(-ap));
    const float kkv = kr * kkc; const float kk = kkv * __builtin_amdgcn_rsqf(fmaxf(wave_total(kkv * kkv), 1e-24f));
    const float kmod = kr * (1.f + (a - 1.f) * kac);
    LAS float* p = (LAS float*)(wl + q * RK_STEP) + lane;
    p[0] = decay; p[64] = -kk; p[128] = kk * a; p[192] = kmod; p[256] = r; p[320] = v;
    if (WSC) { const float scv = wave_total(r * kmod * rkc); if (lane == 0) SC[(size_t)(t0 + q) * 16 + h] = scv; }
  }
}
#define RK_V4(off) (*(const LAS f32x4*)(p + (off)))
template <int PASS>
__device__ __forceinline__ void rk_chunk(LAS unsigned char* lds, unsigned char* ws, const float* w0, const float* a0, const float* k_k, const float* k_a, const float* r_k, int item, int wid, int lane) {
  const int h = item >> 7, c = item & 127, ch = h * 64 + lane, tb = c * RK_L;
  LAS unsigned char* wl = lds + wid * 16384;
  const float w0c = w0[ch], a0c = a0[ch], kkc = k_k[ch], kac = k_a[ch], rkc = r_k[ch];
  float* SC = (float*)(ws + WS_SMALL + SM_SC); bf16_t* Y = (bf16_t*)(ws + A_RP);
  float* Bg = (float*)(ws + A_RB) + ((size_t)(h * RK_NC + c) * 64 + lane) * 64;
  float* Pg = (float*)(ws + A_RP) + ((size_t)(h * RK_NC + c) * 64 + lane) * 64;
  f32x2 SB[32], SP[32];
  float zf = 0.f; asm volatile("" : "+v"(zf));
#pragma unroll
  for (int q = 0; q < 32; ++q) { SB[q] = (f32x2){zf, zf}; SP[q] = (f32x2){(2 * q == lane) ? 1.f : 0.f, (2 * q + 1 == lane) ? 1.f : 0.f}; }
  if (PASS == 3 && c > 0) { const float* Sg = Bg - 4096;
#pragma unroll
    for (int q = 0; q < 16; ++q) { const f32x4 v = *(const f32x4*)(Sg + 4 * q); SB[2 * q] = (f32x2){v.x, v.y}; SB[2 * q + 1] = (f32x2){v.z, v.w}; } }
  constexpr int NB = (PASS == 1) ? 2 : 4;
  RRaw<NB> RA;
  rk_issue<NB>(RA, ws, ch, tb);
  for (int blk = 0; blk < RK_L / NB; ++blk) {
    rk_prep8<PASS == 3, NB>(RA, wl, w0c, a0c, kkc, kac, rkc, SC, tb + blk * NB, h, lane);
    if (blk + 1 < RK_L / NB) rk_issue<NB>(RA, ws, ch, tb + (blk + 1) * NB);
#pragma unroll 1
    for (int s = 0; s < NB; ++s) {
      const LAS float* p = (const LAS float*)(wl + s * RK_STEP);
      f32x2 y0, y1;
      if constexpr (PASS == 1) {
      f32x2 a0v = (f32x2){zf, zf}, a1v = a0v, b0v = a0v, b1v = a0v;
      f32x4 NK[4], W[2], KA[2], KX[2];
      NK[0] = RK_V4(64); NK[1] = RK_V4(68); NK[2] = RK_V4(72);
#pragma unroll
      for (int q = 0; q < 16; ++q) {
        if (q + 3 < 16) NK[(q + 3) & 3] = RK_V4(64 + 4 * (q + 3));
        if (q == 15) { W[0] = RK_V4(0); KA[0] = RK_V4(128); KX[0] = RK_V4(192); }
        const f32x4 nk = NK[q & 3]; const f32x2 lo = (f32x2){nk.x, nk.y}, hi = (f32x2){nk.z, nk.w};
        a0v += SB[2 * q] * lo; a1v += SB[2 * q + 1] * hi; b0v += SP[2 * q] * lo; b1v += SP[2 * q + 1] * hi;
        asm volatile("" ::: "memory");
      }
      const float sa = (a0v.x + a0v.y) + (a1v.x + a1v.y), sp = (b0v.x + b0v.y) + (b1v.x + b1v.y);
      const float vv = p[320 + lane];
      const f32x2 sa2 = (f32x2){sa, sa}, sp2 = (f32x2){sp, sp}, v2 = (f32x2){vv, vv};
      y0 = (f32x2){zf, zf}; y1 = y0;
#pragma unroll
      for (int q = 0; q < 16; ++q) {
        if (q + 1 < 16) { W[(q + 1) & 1] = RK_V4(4 * (q + 1)); KA[(q + 1) & 1] = RK_V4(128 + 4 * (q + 1)); KX[(q + 1) & 1] = RK_V4(192 + 4 * (q + 1)); }
        const f32x4 w4 = W[q & 1], ka4 = KA[q & 1], kx4 = KX[q & 1];
        const f32x2 wl2 = (f32x2){w4.x, w4.y}, wh2 = (f32x2){w4.z, w4.w}, kal = (f32x2){ka4.x, ka4.y}, kah = (f32x2){ka4.z, ka4.w}, kxl = (f32x2){kx4.x, kx4.y}, kxh = (f32x2){kx4.z, kx4.w};
        SB[2 * q] = SB[2 * q] * wl2 + sa2 * kal + v2 * kxl; SB[2 * q + 1] = SB[2 * q + 1] * wh2 + sa2 * kah + v2 * kxh;
        SP[2 * q] = SP[2 * q] * wl2 + sp2 * kal; SP[2 * q + 1] = SP[2 * q + 1] * wh2 + sp2 * kah;
        asm volatile("" ::: "memory");
      }
      } else {
      f32x2 a0v = (f32x2){zf, zf}, a1v = a0v, b0v = a0v, b1v = a0v;
      f32x4 NK[2][4];
#pragma unroll
      for (int j = 0; j < 4; ++j) NK[0][j] = RK_V4(64 + 4 * j);
      f32x4 W[2][2], KA[2][2], KX[2][2], RR[2][2];
#pragma unroll
      for (int g = 0; g < 4; ++g) {
        if (g + 1 < 4) {
#pragma unroll
          for (int j = 0; j < 4; ++j) NK[(g + 1) & 1][j] = RK_V4(64 + 4 * (4 * (g + 1) + j));
        } else {
#pragma unroll
          for (int j = 0; j < 2; ++j) { W[0][j] = RK_V4(4 * j); KA[0][j] = RK_V4(128 + 4 * j); KX[0][j] = RK_V4(192 + 4 * j); if (PASS == 3) RR[0][j] = RK_V4(256 + 4 * j); }
        }
#pragma unroll
        for (int j = 0; j < 4; ++j) { const int q = 4 * g + j; const f32x4 nk = NK[g & 1][j]; const f32x2 lo = (f32x2){nk.x, nk.y}, hi = (f32x2){nk.z, nk.w};
          a0v += SB[2 * q] * lo; a1v += SB[2 * q + 1] * hi;
          if (PASS == 1) { b0v += SP[2 * q] * lo; b1v += SP[2 * q + 1] * hi; } }
        asm volatile("" ::: "memory");
      }
      const float sa = (a0v.x + a0v.y) + (a1v.x + a1v.y), sp = (b0v.x + b0v.y) + (b1v.x + b1v.y);
      const float vv = p[320 + lane];
      const f32x2 sa2 = (f32x2){sa, sa}, sp2 = (f32x2){sp, sp}, v2 = (f32x2){vv, vv};
      y0 = (f32x2){zf, zf}; y1 = y0;
#pragma unroll
      for (int g = 0; g < 8; ++g) {
        if (g + 1 < 8) {
#pragma unroll
          for (int j = 0; j < 2; ++j) { const int qn = 2 * (g + 1) + j; W[(g + 1) & 1][j] = RK_V4(4 * qn); KA[(g + 1) & 1][j] = RK_V4(128 + 4 * qn); KX[(g + 1) & 1][j] = RK_V4(192 + 4 * qn); if (PASS == 3) RR[(g + 1) & 1][j] = RK_V4(256 + 4 * qn); }
        }
#pragma unroll
        for (int j = 0; j < 2; ++j) { const int q = 2 * g + j; const f32x4 w4 = W[g & 1][j], ka4 = KA[g & 1][j], kx4 = KX[g & 1][j];
          const f32x2 wl2 = (f32x2){w4.x, w4.y}, wh2 = (f32x2){w4.z, w4.w}, kal = (f32x2){ka4.x, ka4.y}, kah = (f32x2){ka4.z, ka4.w}, kxl = (f32x2){kx4.x, kx4.y}, kxh = (f32x2){kx4.z, kx4.w};
          SB[2 * q] = SB[2 * q] * wl2 + sa2 * kal + v2 * kxl; SB[2 * q + 1] = SB[2 * q + 1] * wh2 + sa2 * kah + v2 * kxh;
          if (PASS == 1) { SP[2 * q] = SP[2 * q] * wl2 + sp2 * kal; SP[2 * q + 1] = SP[2 * q + 1] * wh2 + sp2 * kah; }
          if (PASS == 3) { const f32x4 r4 = RR[g & 1][j]; y0 += SB[2 * q] * (f32x2){r4.x, r4.y}; y1 += SB[2 * q + 1] * (f32x2){r4.z, r4.w}; } }
        asm volatile("" ::: "memory");
      }
      }
      if (PASS == 3) Y[(size_t)(tb + blk * NB + s) * 1024 + ch] = (bf16_t)f2bf((y0.x + y0.y) + (y1.x + y1.y));
    }
  }
  if (PASS == 1) {
#pragma unroll
    for (int q = 0; q < 16; ++q) { *(f32x4*)(Bg + 4 * q) = (f32x4){SB[2 * q].x, SB[2 * q].y, SB[2 * q + 1].x, SB[2 * q + 1].y};
      *(f32x4*)(Pg + 4 * q) = (f32x4){SP[2 * q].x, SP[2 * q].y, SP[2 * q + 1].x, SP[2 * q + 1].y}; }
  }
}
__device__ __forceinline__ void rk_scan(LAS unsigned char* lds, unsigned char* ws, int bid, int wid_s) {
  if (bid >= 64) return;
  const int tid = opaque_tid_w(wid_s), wid = wid_s, lane = tid & 63, h = bid >> 2, i0 = (bid & 3) * 16, i = lane >> 2, q = lane & 3;
  const float* Pg = (const float*)(ws + A_RP) + (size_t)h * RK_NC * 4096; float* Bg = (float*)(ws + A_RB) + (size_t)h * RK_NC * 4096;
  LAS float* PL = (LAS float*)lds; LAS float* SX = (LAS float*)(lds + 32768);
  f32x2 S[8];
  float zf = 0.f; asm volatile("" : "+v"(zf));
#pragma unroll
  for (int j = 0; j < 8; ++j) S[j] = (f32x2){zf, zf};
  f32x4 p0 = *(const f32x4*)(Pg + tid * 8), p1 = *(const f32x4*)(Pg + tid * 8 + 4);
  *(LAS f32x4*)(PL + tid * 8) = p0; *(LAS f32x4*)(PL + tid * 8 + 4) = p1;
  const size_t brow = (size_t)(i0 + i) * 64 + 8 * wid;
  f32x4 bn0 = *(const f32x4*)(Bg + brow), bn1 = *(const f32x4*)(Bg + brow + 4);
  asm volatile("s_waitcnt vmcnt(0) lgkmcnt(0)" ::: "memory"); __builtin_amdgcn_s_barrier(); asm volatile("" ::: "memory");
  for (int c = 0; c < RK_NC; ++c) {
    const LAS float* pl = PL + (c & 1) * 4096 + 8 * wid + q * 16 * 64;
    const f32x4 b0 = bn0, b1 = bn1;
    if (c + 1 < RK_NC) { p0 = *(const f32x4*)(Pg + (size_t)(c + 1) * 4096 + tid * 8); p1 = *(const f32x4*)(Pg + (size_t)(c + 1) * 4096 + tid * 8 + 4);
      bn0 = *(const f32x4*)(Bg + (size_t)(c + 1) * 4096 + brow); bn1 = *(const f32x4*)(Bg + (size_t)(c + 1) * 4096 + brow + 4); }
    f32x2 o0 = (f32x2){zf, zf}, o1 = o0, o2 = o0, o3 = o0;
    f32x4 PA[2][4], PB[2][4];
#pragma unroll
    for (int j = 0; j < 4; ++j) { PA[0][j] = *(const LAS f32x4*)(pl + j * 64); PB[0][j] = *(const LAS f32x4*)(pl + j * 64 + 4); }
#pragma unroll
    for (int g = 0; g < 4; ++g) {
      if (g + 1 < 4) {
#pragma unroll
        for (int j = 0; j < 4; ++j) { PA[(g + 1) & 1][j] = *(const LAS f32x4*)(pl + (4 * (g + 1) + j) * 64); PB[(g + 1) & 1][j] = *(const LAS f32x4*)(pl + (4 * (g + 1) + j) * 64 + 4); }
      }
#pragma unroll
      for (int j = 0; j < 4; ++j) { const int k = 4 * g + j; const f32x4 pa = PA[g & 1][j], pb = PB[g & 1][j];
        const float s = (k & 1) ? S[k >> 1].y : S[k >> 1].x; const f32x2 s2 = (f32x2){s, s};
        o0 += s2 * (f32x2){pa.x, pa.y}; o1 += s2 * (f32x2){pa.z, pa.w}; o2 += s2 * (f32x2){pb.x, pb.y}; o3 += s2 * (f32x2){pb.z, pb.w}; }
      asm volatile("" ::: "memory");
    }
    float ov[8] = {o0.x, o0.y, o1.x, o1.y, o2.x, o2.y, o3.x, o3.y};
#pragma unroll
    for (int j = 0; j < 8; ++j) { float v = ov[j];
      v += __builtin_bit_cast(float, __builtin_amdgcn_update_dpp(0, __builtin_bit_cast(int, v), 0xB1, 0xf, 0xf, false));
      v += __builtin_bit_cast(float, __builtin_amdgcn_update_dpp(0, __builtin_bit_cast(int, v), 0x4E, 0xf, 0xf, false));
      ov[j] = v; }
    const f32x4 r0 = (f32x4){ov[0] + b0.x, ov[1] + b0.y, ov[2] + b0.z, ov[3] + b0.w}, r1 = (f32x4){ov[4] + b1.x, ov[5] + b1.y, ov[6] + b1.z, ov[7] + b1.w};
    if (q == 0) { *(LAS f32x4*)(SX + i * 68 + 8 * wid) = r0; *(LAS f32x4*)(SX + i * 68 + 8 * wid + 4) = r1;
      *(f32x4*)(Bg + (size_t)c * 4096 + brow) = r0; *(f32x4*)(Bg + (size_t)c * 4096 + brow + 4) = r1; }
    asm volatile("s_waitcnt lgkmcnt(0)" ::: "memory"); __builtin_amdgcn_s_barrier(); asm volatile("" ::: "memory");
#pragma unroll
    for (int j = 0; j < 4; ++j) { const f32x4 v = *(const LAS f32x4*)(SX + i * 68 + q * 16 + 4 * j); S[2 * j] = (f32x2){v.x, v.y}; S[2 * j + 1] = (f32x2){v.z, v.w}; }
    if (c + 1 < RK_NC) { LAS float* pn = PL + ((c + 1) & 1) * 4096; *(LAS f32x4*)(pn + tid * 8) = p0; *(LAS f32x4*)(pn + tid * 8 + 4) = p1; }
    asm volatile("s_waitcnt lgkmcnt(0)" ::: "memory"); __builtin_amdgcn_s_barrier(); asm volatile("" ::: "memory");
  }
}
__device__ __forceinline__ void rwkv_post(unsigned char* ws, const float* gng, const float* gnb, int gw, int ngw, int lane) {
  const bf16_t* Y = (const bf16_t*)(ws + A_RP); const bf16_t* P1 = (const bf16_t*)(ws + A_P1); const bf16_t* G = (const bf16_t*)(ws + A0);
  const float* SC = (const float*)(ws + WS_SMALL + SM_SC); bf16_t* AO = (bf16_t*)(ws + A_RA);
  const int c0 = lane * 16;
  float gg[16], gb_[16];
#pragma unroll
  for (int j = 0; j < 4; ++j) { const f32x4 a = *(const f32x4*)(gng + c0 + 4 * j), b = *(const f32x4*)(gnb + c0 + 4 * j);
    gg[4 * j] = a.x; gg[4 * j + 1] = a.y; gg[4 * j + 2] = a.z; gg[4 * j + 3] = a.w; gb_[4 * j] = b.x; gb_[4 * j + 1] = b.y; gb_[4 * j + 2] = b.z; gb_[4 * j + 3] = b.w; }
  for (int t0 = gw; t0 < M; t0 += 2 * ngw) {
    const int t1 = t0 + ngw; const bool has1 = t1 < M; const int tt[2] = {t0, has1 ? t1 : t0};
    u32x4 ya[2], yb[2], va[2], vb[2], ga[2], gb[2]; float scv[2];
#pragma unroll
    for (int r = 0; r < 2; ++r) { const size_t t = (size_t)tt[r];
      ya[r] = *(const u32x4*)(Y + t * 1024 + c0); yb[r] = *(const u32x4*)(Y + t * 1024 + c0 + 8);
      va[r] = *(const u32x4*)(P1 + t * 3328 + 2048 + c0); vb[r] = *(const u32x4*)(P1 + t * 3328 + 2048 + c0 + 8);
      ga[r] = *(const u32x4*)(G + t * 1024 + c0); gb[r] = *(const u32x4*)(G + t * 1024 + c0 + 8);
      scv[r] = SC[t * 16 + (lane >> 2)]; }
#pragma unroll
    for (int r = 0; r < 2; ++r) {
      if (r == 1 && !has1) break;
      float y[16]; float s = 0.f;
      const unsigned yw[8] = {ya[r].x, ya[r].y, ya[r].z, ya[r].w, yb[r].x, yb[r].y, yb[r].z, yb[r].w};
#pragma unroll
      for (int e = 0; e < 8; ++e) { y[2 * e] = bflo(yw[e]); y[2 * e + 1] = bfhi(yw[e]); s += y[2 * e] + y[2 * e + 1]; }
      s += sx<1>(s); s += sx<2>(s);
      const float mean = s * (1.f / 64.f); float q = 0.f;
#pragma unroll
      for (int j = 0; j < 16; ++j) { y[j] -= mean; q += y[j] * y[j]; }
      q += sx<1>(q); q += sx<2>(q);
      const float rs = 1.0f / sqrtf(q * (1.f / 64.f) + 64e-5f);
      const unsigned vw[8] = {va[r].x, va[r].y, va[r].z, va[r].w, vb[r].x, vb[r].y, vb[r].z, vb[r].w}; const unsigned gwv[8] = {ga[r].x, ga[r].y, ga[r].z, ga[r].w, gb[r].x, gb[r].y, gb[r].z, gb[r].w};
      unsigned o[8];
#pragma unroll
      for (int e = 0; e < 8; ++e) {
        const float o0 = (y[2 * e] * rs * gg[2 * e] + gb_[2 * e] + scv[r] * bflo(vw[e])) * bflo(gwv[e]);
        const float o1 = (y[2 * e + 1] * rs * gg[2 * e + 1] + gb_[2 * e + 1] + scv[r] * bfhi(vw[e])) * bfhi(gwv[e]);
        o[e] = pk2(o0, o1); }
      *(u32x4*)(AO + (size_t)tt[r] * 1024 + c0) = (u32x4){o[0], o[1], o[2], o[3]};
      *(u32x4*)(AO + (size_t)tt[r] * 1024 + c0 + 8) = (u32x4){o[4], o[5], o[6], o[7]};
    }
  }
}


#define XB_TMO      128
#define XB_XCNT(j)  (256  + 64 * (j))
#define XB_XSUB(j)  (1280 + 64 * (j))
#define XB_XGEN(j)  (2304 + 64 * (j))
#define XB_TOP      3328
#define XB_TOPGEN   3392
#define XCD_BAR_WORDS 3456
#define XB_SPIN_CAP (1u << 22)
__device__ __forceinline__ unsigned xb_ld(unsigned* p)              { return __hip_atomic_load(p, __ATOMIC_RELAXED, __HIP_MEMORY_SCOPE_AGENT); }
__device__ __forceinline__ unsigned xb_add(unsigned* p, unsigned v) { return __hip_atomic_fetch_add(p, v, __ATOMIC_RELAXED, __HIP_MEMORY_SCOPE_AGENT); }
__device__ __forceinline__ unsigned xb_xcc_id() { return (unsigned)__builtin_amdgcn_s_getreg((3 << 11) | 20) & 0xFu; }
#define XB_SPIN(cond, bar) do { unsigned _sp = 0; while (cond) { __builtin_amdgcn_s_sleep(1); \
    if ((++_sp & 255u) == 0u) { if (xb_ld(&(bar)[XB_TMO])) break; if (_sp > XB_SPIN_CAP) { atomicAdd(&(bar)[XB_TMO], 1u); break; } } } } while (0)
struct XcdBarrier { unsigned* bar; unsigned x; volatile LAS unsigned* st; };
__device__ __forceinline__ XcdBarrier xcd_barrier_post(unsigned* bar, volatile LAS unsigned* st) {
    XcdBarrier b; b.bar = bar; b.x = xb_xcc_id(); b.st = st;
    if (threadIdx.x == 0) (void)xb_add(&bar[XB_XCNT(b.x)], 1u);
    return b;
}
__device__ __forceinline__ void xcd_barrier_complete(unsigned* bar, unsigned x, unsigned& nloc, unsigned& nx) {
    const unsigned G = gridDim.x * gridDim.y * gridDim.z;
    unsigned sum, cnt, mine, sp = 0u;
    for (;;) {
        sum = 0u; cnt = 0u; mine = 0u;
#pragma unroll
        for (unsigned j = 0; j < 16; ++j) { const unsigned c = xb_ld(&bar[XB_XCNT(j)]); sum += c; cnt += (c > 0u) ? 1u : 0u; mine = (j == x) ? c : mine; }
        if (sum == G) break;
        __builtin_amdgcn_s_sleep(1);
        if ((++sp & 255u) == 0u) { if (xb_ld(&bar[XB_TMO])) break; if (sp > XB_SPIN_CAP) { atomicAdd(&bar[XB_TMO], 1u); break; } }
    }
    nloc = mine > 0u ? mine : 1u; nx = cnt > 0u ? cnt : 1u;
}
__device__ __forceinline__ void xcd_barrier(const XcdBarrier& b, int wid_s) {
    asm volatile("s_waitcnt vmcnt(0)" ::: "memory");
    __syncthreads();
    if (opaque_tid_w(wid_s) == 0) {
        unsigned* bar = b.bar;
        __builtin_amdgcn_s_waitcnt(0);
        unsigned nloc = b.st[0], nx = b.st[1];
        if (nloc == 0u) { xcd_barrier_complete(bar, b.x, nloc, nx); b.st[0] = nloc; b.st[1] = nx; }
        const unsigned old = xb_add(&bar[XB_XSUB(b.x)], 1u);
        const unsigned gen = old / nloc;
        if (old + 1u == (gen + 1u) * nloc) {
            __builtin_amdgcn_fence(__ATOMIC_RELEASE, "agent");
            asm volatile("s_waitcnt vmcnt(0)" ::: "memory");
            const unsigned og = xb_add(&bar[XB_TOP], 1u);
            const unsigned tg = og / nx;
            if (og + 1u == (tg + 1u) * nx) xb_add(&bar[XB_TOPGEN], 1u);
            else XB_SPIN(xb_ld(&bar[XB_TOPGEN]) == tg, bar);
            __builtin_amdgcn_fence(__ATOMIC_ACQUIRE, "agent");
            xb_add(&bar[XB_XGEN(b.x)], 1u);
            asm volatile("s_waitcnt vmcnt(0)" ::: "memory");
        } else {
            XB_SPIN(xb_ld(&bar[XB_XGEN(b.x)]) == gen, bar);
            __builtin_amdgcn_fence(__ATOMIC_ACQUIRE, "agent");
            asm volatile("s_waitcnt vmcnt(0)" ::: "memory");
        }
    }
    __syncthreads();
}

struct KArgs { const float* in[53]; float* out; unsigned char* ws; };
#define INP(i) ((const float*)(const __attribute__((address_space(1))) float*)PT[(i)])

__global__ void __launch_bounds__(512, 2) mega_fwd(KArgs args) {
  extern __shared__ __attribute__((aligned(16))) unsigned char lds_raw[];
  LAS unsigned char* lds = (LAS unsigned char*)lds_raw;
  LAS ull* PT = (LAS ull*)(lds + PT_OFF);
  const int wid_s = __builtin_amdgcn_readfirstlane((int)threadIdx.x >> 6);
  if (threadIdx.x == 0) {
#pragma unroll
    for (int i = 0; i < 53; ++i) PT[i] = (ull)args.in[i];
  }
  if (threadIdx.x < 2) ((LAS unsigned*)(lds + PT_OFF + 1024))[threadIdx.x] = 0u;
  unsigned* barw = (unsigned*)(args.ws + WS_SMALL + SM_BAR);
  if (blockIdx.x == 0) for (int i = threadIdx.x; i < XCD_BAR_WORDS; i += 512) __hip_atomic_store(barw + i, 0u, __ATOMIC_RELAXED, __HIP_MEMORY_SCOPE_AGENT);
  __syncthreads();
  cg::grid_group grid = cg::this_grid();
  grid.sync();
  (void)xcd_barrier_post(barw, (volatile LAS unsigned*)(lds + PT_OFF + 1024));
  for (int pq = 0; pq < 2 * NPH; ++pq) {
    const int ph = pq >> 1;
    const PhaseDesc d = PROG[ph];
    if ((pq & 1) && !((REPMASK >> d.kind) & 1)) continue;
    __attribute__((address_space(1))) unsigned char* wsg = (__attribute__((address_space(1))) unsigned char*)args.ws; __attribute__((address_space(1))) float* Xg = (__attribute__((address_space(1))) float*)args.out;
    asm volatile("" : "+s"(wsg), "+s"(Xg));
    unsigned char* ws = (unsigned char*)wsg; float* X = (float*)Xg;
    { unsigned lb = 0; asm volatile("" : "+s"(lb)); lds = (LAS unsigned char*)lds_raw + lb; PT = (LAS ull*)(lds + PT_OFF); }
    int bid = blockIdx.x, G = gridDim.x; asm volatile("" : "+s"(bid), "+s"(G));
    const int wave = wid_s;
#define TIDS const int tid = opaque_tid_w(wid_s), lane = tid & 63, gw = bid * 8 + wave, ngw = G * 8, gtid = bid * 512 + tid, ngt = G * 512; (void)lane; (void)gw; (void)ngw; (void)gtid; (void)ngt
    switch (d.kind) {
      case K_PREP: { TIDS;
        if (d.lda == 1) norm_rows(INP(0), X, INP(d.K), (bf16_t*)(ws + d.a), 1, gw, ngw, lane);
        else norm_rows(X, nullptr, INP(d.K), (bf16_t*)(ws + d.a), d.lda, gw, ngw, lane);
      } break;
      case K_GEMM:
      case K_GEMMR: {
        const int mode = (d.kind == K_GEMMR) ? 0 : (d.act == 2 ? 2 : 1);
        pg8::Gemm g{(const bf16_t*)(ws + d.a), (const bf16_t*)(ws + d.b), d.Mr, d.N, d.K, d.lda, mode == 2 ? 254 : 256}; pg8::StaticOrder S; S.init(d.Mr, d.N, G, bid);
        void* outp = (mode == 0) ? (void*)X : (mode == 2 ? (void*)(ws + A_H) : (void*)(ws + d.c));
        pg8::EpiAny E{mode, outp, d.ldc, d.act, d.x1, lds};
        pg8::gemm_phase<pg8::EpiAny>(lds, g, S, E, wid_s);
      } break;
      case K_CLOCAL: if (d.x0) chunk_local<true>(lds, ws, INP(44), nullptr, bid, G, wid_s); else chunk_local<false>(lds, ws, INP(3), INP(4), bid, G, wid_s); break;
      case K_CSCAN: { TIDS; if (d.x0) chunk_scan<true>(ws, gtid, ngt); else chunk_scan<false>(ws, gtid, ngt); } break;
      case K_COUT: if (d.x0) chunk_out<true>(lds, ws, INP(44), nullptr, INP(45), bid, G, wid_s); else chunk_out<false>(lds, ws, INP(3), INP(4), INP(5), bid, G, wid_s); break;
      case K_RP1: { TIDS; for (int it = bid * 8 + wave; it < 2048; it += G * 8) rk_chunk<1>(lds, ws, INP(15), INP(18), INP(23), INP(24), INP(25), it, wave, lane); } break;
      case K_RSCAN: rk_scan(lds, ws, bid, wid_s); break;
      case K_RREC: { TIDS; for (int it = bid * 8 + wave; it < 2048; it += G * 8) rk_chunk<3>(lds, ws, INP(15), INP(18), INP(23), INP(24), INP(25), it, wave, lane); } break;
      case K_RPOST: { TIDS; rwkv_post(ws, INP(26), INP(27), gw, ngw, lane); } break;
      case K_SB: sb_attn(lds, ws, bid, G, wid_s); break;
      case K_FINAL: { TIDS; norm_rows(X, X, INP(d.K), nullptr, 3, gw, ngw, lane); } break;
      default: break;
    }
    {
      const int j0 = (d.kind == K_PREP) ? d.x0 : d.sj0, j1 = (d.kind == K_PREP) ? d.x1 : d.sj1;
      if (j1 > j0) {
        __syncthreads();
        const int lane2 = opaque_tid_w(wid_s) & 63;
        const bool sideg = (d.kind == K_GEMM) && G > 150;
        const int sw = sideg ? (bid - 150) * 8 + wave : bid * 8 + wave, nsw = sideg ? (G - 150) * 8 : G * 8;
        if (sw >= 0 && nsw > 0) {
          LAS float* scr = (LAS float*)(lds + wave * 16384);
          int base = 0;
          for (int j = j0; j < j1; ++j) { const ConvJob J = JOBS[j]; const int items = (J.KP / 64) * (J.NP / 32);
            const float* W = INP(J.in_idx) + J.in_off; const float* sc = INP(13) + J.sc_off; bf16_t* out = (bf16_t*)(ws + J.out_off);
            int it = sw - base; if (it < 0) it += nsw;
            for (; it < items; it += nsw) conv_item(J, W, sc, out, scr, it, lane2);
            base = (base + items) % nsw; }
        }
      }
    }
    { XcdBarrier xbar; xbar.bar = (unsigned*)(ws + WS_SMALL + SM_BAR); xbar.x = xb_xcc_id(); xbar.st = (volatile LAS unsigned*)(lds + PT_OFF + 1024);
      for (int xs = 0; xs < XSYNC; ++xs) xcd_barrier(xbar, wid_s);
      xcd_barrier(xbar, wid_s); }
  }
}

extern "C" void kernel_launch(void* const* d_in, const int* in_sizes, int n_in, void* d_out, int out_size, void* d_ws, size_t ws_size, hipStream_t stream) {
  static int grid = 0;
  if (grid == 0) {
    if (n_in != 53 || out_size != M * D || ws_size < WS_NEED) { fprintf(stderr, "kernel_launch: unexpected shapes n_in %d out %d ws %zu\n", n_in, out_size, ws_size); grid = -1; return; }
    int dev = 0, cus = 0, per_cu = 0;
    hipGetDevice(&dev); hipDeviceGetAttribute(&cus, hipDeviceAttributeMultiprocessorCount, dev);
    hipFuncSetAttribute((const void*)mega_fwd, hipFuncAttributeMaxDynamicSharedMemorySize, LDS_BYTES);
    hipOccupancyMaxActiveBlocksPerMultiprocessor(&per_cu, (const void*)mega_fwd, 512, LDS_BYTES);
    (void)hipGetLastError();
    if (per_cu < 1) per_cu = 1;
    grid = cus;
  }
  if (grid < 0) return;
  KArgs a{};
  for (int i = 0; i < 53; ++i) a.in[i] = (const float*)d_in[i];
  a.out = (float*)d_out; a.ws = (unsigned char*)d_ws;
  void* params[] = {&a};
  hipError_t e = hipLaunchCooperativeKernel((const void*)mega_fwd, dim3(grid), dim3(512), params, LDS_BYTES, stream);
  if (e != hipSuccess) fprintf(stderr, "cooperative launch failed: %s (grid %d)\n", hipGetErrorString(e), grid);
}
```

```cpp
#include <hip/hip_runtime.h>
#include <hip/hip_cooperative_groups.h>
#include <cstdio>
#include <cstdint>
namespace cg = cooperative_groups;

#define LAS __attribute__((address_space(3)))
typedef unsigned short bf16_t;
typedef short bf16x8 __attribute__((ext_vector_type(8)));
typedef float f32x4 __attribute__((ext_vector_type(4)));
typedef unsigned u32x4 __attribute__((ext_vector_type(4)));
typedef unsigned u32x2 __attribute__((ext_vector_type(2)));
typedef unsigned long long ull;

#ifndef EN_GLA
#define EN_GLA 1
#endif
#ifndef EN_RWKV
#define EN_RWKV 1
#endif
#ifndef EN_SB
#define EN_SB 1
#endif
#ifndef EN_ML
#define EN_ML 1
#endif
#ifndef EN_FFN
#define EN_FFN 1
#endif
#define REPMASK 0
#define XSYNC 0

constexpr int M = 16384, D = 1024, FF = 2816, FF2 = 5632;
constexpr unsigned MiB = 1u << 20;
constexpr unsigned WS_SMALL = 0;
constexpr unsigned SM_DTOT = 0;
constexpr unsigned SM_NST = 512 * 1024;
constexpr unsigned SM_BL = 1024 * 1024;
constexpr unsigned SM_ML = SM_BL + 4096;
constexpr unsigned SM_MST = SM_ML + 4096;
constexpr unsigned SM_UH = SM_MST + 4096;
constexpr unsigned SM_SC = 2 * MiB;
constexpr unsigned SM_BAR = 3 * MiB;
constexpr unsigned WS_W = 4 * MiB;
constexpr unsigned WS_ACT = 22 * MiB;
constexpr unsigned A0 = WS_ACT;
constexpr unsigned A_U = WS_ACT + 32 * MiB;
constexpr unsigned A_H = WS_ACT + 120 * MiB;
constexpr unsigned A_P = WS_ACT + 32 * MiB;
constexpr unsigned A_BS = WS_ACT + 136 * MiB;
constexpr unsigned A_P1 = WS_ACT + 64 * MiB;
constexpr unsigned A_Y = WS_ACT + 168 * MiB;
constexpr unsigned A_RA = WS_ACT + 32 * MiB;
constexpr size_t WS_NEED = 256ull * MiB;
constexpr unsigned W_GLA_IN = WS_W, W_GLA_OUT = WS_W + 3328u * 1024 * 2;
constexpr unsigned W_UP = WS_W, W_DOWN = WS_W + 5632u * 1024 * 2;
constexpr unsigned W_R1 = WS_W, W_R2A = W_R1 + 3328u * 2048 * 2, W_R2G = W_R2A + 2048u * 256 * 2, W_ROUT = W_R2G + 1024u * 256 * 2;
constexpr unsigned W_QKV = WS_ACT + 208 * MiB, W_SBOUT = W_QKV + 3072u * 1024 * 2;
constexpr unsigned WF_A = WS_ACT + 208 * MiB, WF_B = WS_ACT + 216 * MiB + 512 * 1024;
constexpr unsigned DOWN_OFF = 5632u * 1024 * 2;
static_assert(W_ROUT + 2u * MiB <= WS_ACT && W_DOWN + 1024u * 2816 * 2 <= WS_ACT, "weights region");
constexpr int RING_BYTES = 131072, PT_OFF = RING_BYTES, LDS_BYTES = 147456;

struct ConvJob { int in_idx, in_off, K, N, NP, KP, k_off, col_base, ldo, row_off, sc_off, sc_mode; unsigned out_off; int perm; };
#define MU(j) ((j) * 1024)
__constant__ ConvJob JOBS[] = {
    {2, 0, 1024, 3088, 3328, 1024, 0, 0, 1024, 0, 0, 0, W_GLA_IN},
    {6, 0, 1024, 1024, 1024, 1024, 0, 0, 1024, 0, 0, 0, W_GLA_OUT},
    {14, 0,       1024, 1024, 1024, 1024, 0, 0,    2048, 0,    MU(0), 2, W_R1},
    {14, 0,       1024, 1024, 1024, 1024, 0, 1024, 2048, 0,    MU(0), 1, W_R1},
    {14, 1048576, 1024, 1024, 1024, 1024, 0, 0,    2048, 1024, MU(2), 2, W_R1},
    {14, 1048576, 1024, 1024, 1024, 1024, 0, 1024, 2048, 1024, MU(2), 1, W_R1},
    {14, 2097152, 1024, 1024, 1024, 1024, 0, 0,    2048, 2048, MU(3), 2, W_R1},
    {14, 2097152, 1024, 1024, 1024, 1024, 0, 1024, 2048, 2048, MU(3), 1, W_R1},
    {16, 0, 1024, 64, 64, 1024, 0, 0,    2048, 3072, MU(1), 2, W_R1},
    {16, 0, 1024, 64, 64, 1024, 0, 1024, 2048, 3072, MU(1), 1, W_R1},
    {19, 0, 1024, 64, 64, 1024, 0, 0,    2048, 3136, MU(4), 2, W_R1},
    {19, 0, 1024, 64, 64, 1024, 0, 1024, 2048, 3136, MU(4), 1, W_R1},
    {21, 0, 1024, 128, 128, 1024, 0, 0,    2048, 3200, MU(5), 2, W_R1},
    {21, 0, 1024, 128, 128, 1024, 0, 1024, 2048, 3200, MU(5), 1, W_R1},
    {17, 0, 64, 1024, 1024, 256, 0, 0, 256, 0, 0, 0, W_R2A},
    {20, 0, 64, 1024, 1024, 256, 64, 0, 256, 1024, 0, 0, W_R2A},
    {22, 0, 128, 1024, 1024, 256, 128, 0, 256, 0, 0, 0, W_R2G},
    {28, 0, 1024, 1024, 1024, 1024, 0, 0, 1024, 0, 0, 0, W_ROUT},
    {35, 0, 1024, 3072, 3072, 1024, 0, 0, 1024, 0, 0, 0, W_QKV},
    {36, 0, 1024, 1024, 1024, 1024, 0, 0, 1024, 0, 0, 0, W_SBOUT},
    {43, 0, 1024, 3080, 3328, 1024, 0, 0, 1024, 0, 0, 0, W_GLA_IN},
    {46, 0, 1024, 1024, 1024, 1024, 0, 0, 1024, 0, 0, 0, W_GLA_OUT},
    {8, 0, 1024, 5632, 5632, 1024, 0, 0, 1024, 0, 0, 0, WF_A, 1},   {11, 0, 2816, 1024, 1024, 2816, 0, 0, 2816, 0, 0, 0, WF_A + DOWN_OFF},
    {30, 0, 1024, 5632, 5632, 1024, 0, 0, 1024, 0, 0, 0, W_UP, 1},  {33, 0, 2816, 1024, 1024, 2816, 0, 0, 2816, 0, 0, 0, W_DOWN},
    {38, 0, 1024, 5632, 5632, 1024, 0, 0, 1024, 0, 0, 0, WF_B, 1},  {41, 0, 2816, 1024, 1024, 2816, 0, 0, 2816, 0, 0, 0, WF_B + DOWN_OFF},
    {48, 0, 1024, 5632, 5632, 1024, 0, 0, 1024, 0, 0, 0, WF_A, 1},  {51, 0, 2816, 1024, 1024, 2816, 0, 0, 2816, 0, 0, 0, WF_A + DOWN_OFF},
};

enum { K_PREP = 0, K_GEMM, K_GEMMR, K_CLOCAL, K_CSCAN, K_COUT, K_CONV, K_RREC, K_RPOST, K_SB, K_FINAL, K_RP1, K_RSCAN, K_NOP };
struct PhaseDesc { int kind; unsigned a, b, c; int lda, K, Mr, N, ldc, act, x0, x1, sj0, sj1; };
#define FFN_PHASES(fb, wf, pj0, pj1, sj0_, sj1_) \
  {K_PREP, A0 + 4096u, 0, 0, 4, fb, 0, 0, 0, 0, pj0, pj1, 0, 0}, \
  {EN_FFN ? K_GEMM : K_NOP, A0, wf, 0, 1024, 1024, 16640, 5632, 0, 2, 0, fb, sj0_, sj1_}, \
  {EN_FFN ? K_GEMMR : K_NOP, A_H, (wf) + DOWN_OFF, 0, 2816, 2816, 16384, 1024, 0, 0, 0, 0, 0, 0}
__constant__ PhaseDesc PROG[] = {
  {K_PREP, A0, 0, 0, 1, 1, 0, 0, 0, 0, 0, 2},
  {EN_GLA ? K_GEMM : K_NOP, A0, W_GLA_IN, A_P, 1024, 1024, 16384, 3328, 3328, 0, 0, 0},
  {EN_GLA ? K_CLOCAL : K_NOP, 0, 0, 0, 0, 0, 0, 0, 0, 0, 0, 0},
  {EN_GLA ? K_CSCAN : K_NOP, 0, 0, 0, 0, 0, 0, 0, 0, 0, 0, 0},
  {EN_GLA ? K_COUT : K_NOP, 0, 0, 0, 0, 0, 0, 0, 0, 0, 0, 0, 22, 24},
  {EN_GLA ? K_GEMMR : K_NOP, A0, W_GLA_OUT, 0, 1024, 1024, 16384, 1024, 0, 0, 0, 0},
  FFN_PHASES(7, WF_A, 0, 0, 2, 18),
  {K_PREP, A0, 0, 0, 2, 12, 0, 0, 0, 0, 0, 0, 0, 0},
  {EN_RWKV ? K_GEMM : K_NOP, A0, W_R1, A_P1, 2048, 2048, 16384, 3328, 3328, 1, 0, 0},
  {EN_RWKV ? K_GEMM : K_NOP, A_P1 + 3072u * 2, W_R2A, A0, 3328, 256, 16384, 2048, 2048, 0, 0, 0},
  {EN_RWKV ? K_RP1 : K_NOP, 0, 0, 0, 0, 0, 0, 0, 0, 0, 0, 0},
  {EN_RWKV ? K_RSCAN : K_NOP, 0, 0, 0, 0, 0, 0, 0, 0, 0, 0, 0},
  {EN_RWKV ? K_RREC : K_NOP, 0, 0, 0, 0, 0, 0, 0, 0, 0, 0, 0},
  {EN_RWKV ? K_GEMM : K_NOP, A_P1 + 3072u * 2, W_R2G, A0, 3328, 256, 16384, 1024, 1024, 0, 0, 0},
  {EN_RWKV ? K_RPOST : K_NOP, 0, 0, 0, 0, 0, 0, 0, 0, 0, 0, 0},
  {EN_RWKV ? K_GEMMR : K_NOP, A_RA, W_ROUT, 0, 1024, 1024, 16384, 1024, 0, 0, 0, 0},
  FFN_PHASES(29, W_UP, 24, 26, 18, 20),
  {K_PREP, A0, 0, 0, 0, 34, 0, 0, 0, 0, 0, 0, 0, 0},
  {EN_SB ? K_GEMM : K_NOP, A0, W_QKV, A_P, 1024, 1024, 16384, 3072, 3072, 0, 0, 0},
  {EN_SB ? K_SB : K_NOP, 0, 0, 0, 0, 0, 0, 0, 0, 0, 0, 0, 26, 28},
  {EN_SB ? K_GEMMR : K_NOP, A0, W_SBOUT, 0, 1024, 1024, 16384, 1024, 0, 0, 0, 0},
  FFN_PHASES(37, WF_B, 0, 0, 20, 22),
  {K_PREP, A0, 0, 0, 0, 42, 0, 0, 0, 0, 0, 0, 0, 0},
  {EN_ML ? K_GEMM : K_NOP, A0, W_GLA_IN, A_P, 1024, 1024, 16384, 3328, 3328, 0, 0, 0},
  {EN_ML ? K_CLOCAL : K_NOP, 0, 0, 0, 0, 0, 0, 0, 0, 0, 1, 0},
  {EN_ML ? K_CSCAN : K_NOP, 0, 0, 0, 0, 0, 0, 0, 0, 0, 1, 0},
  {EN_ML ? K_COUT : K_NOP, 0, 0, 0, 0, 0, 0, 0, 0, 0, 1, 0, 28, 30},
  {EN_ML ? K_GEMMR : K_NOP, A0, W_GLA_OUT, 0, 1024, 1024, 16384, 1024, 0, 0, 0, 0},
  FFN_PHASES(47, WF_A, 0, 0, 0, 0),
  {K_FINAL, 0, 0, 0, 0, 52, 0, 0, 0, 0, 0, 0},
};
constexpr int NPH = sizeof(PROG) / sizeof(PhaseDesc);

__device__ __forceinline__ int opaque_tid_w(int wid_s) { unsigned z = 0u; asm volatile("" : "+v"(z)); int t = (wid_s << 6) | (int)__builtin_amdgcn_mbcnt_hi(~0u, __builtin_amdgcn_mbcnt_lo(~0u, z)); return t; }
__device__ __forceinline__ unsigned f2bf(float f) { unsigned u = __builtin_bit_cast(unsigned, f); return (u + 0x7fffu + ((u >> 16) & 1u)) >> 16; }
__device__ __forceinline__ float bf2f(unsigned b) { return __builtin_bit_cast(float, b << 16); }
__device__ __forceinline__ unsigned pk2(float lo, float hi) { return f2bf(lo) | (f2bf(hi) << 16); }
__device__ __forceinline__ float bflo(unsigned w) { return __builtin_bit_cast(float, w << 16); }
__device__ __forceinline__ float bfhi(unsigned w) { return __builtin_bit_cast(float, w & 0xffff0000u); }
template <int MASK> __device__ __forceinline__ float sx(float v) { return __builtin_bit_cast(float, __builtin_amdgcn_ds_swizzle(__builtin_bit_cast(int, v), (MASK << 10) | 0x1f)); }
template <int Q> __device__ __forceinline__ float quad_bcast(float v) { return __builtin_bit_cast(float, __builtin_amdgcn_update_dpp(0, __builtin_bit_cast(int, v), Q * 0x55, 0xf, 0xf, false)); }
__device__ __forceinline__ float wave_sum(float v) {
#pragma unroll
  for (int o = 1; o < 64; o <<= 1) v += __shfl_xor(v, o);
  return v;
}
__device__ __forceinline__ float logsig(float z) { return fminf(z, 0.f) - __logf(1.f + __expf(-fabsf(z))); }
__device__ __forceinline__ float sigm(float z) { return 1.f / (1.f + __expf(-z)); }
__device__ __forceinline__ float dpp_row_shr(float v, int n) {
  const int iv = __builtin_bit_cast(int, v); int r;
  switch (n) { case 1: r = __builtin_amdgcn_update_dpp(0, iv, 0x111, 0xf, 0xf, true); break; case 2: r = __builtin_amdgcn_update_dpp(0, iv, 0x112, 0xf, 0xf, true); break;
               case 4: r = __builtin_amdgcn_update_dpp(0, iv, 0x114, 0xf, 0xf, true); break; default: r = __builtin_amdgcn_update_dpp(0, iv, 0x118, 0xf, 0xf, true); break; }
  return __builtin_bit_cast(float, r);
}
__device__ __forceinline__ float wave_scan63(float v) {
  v += dpp_row_shr(v, 1); v += dpp_row_shr(v, 2); v += dpp_row_shr(v, 4); v += dpp_row_shr(v, 8);
  v += __builtin_bit_cast(float, __builtin_amdgcn_update_dpp(0, __builtin_bit_cast(int, v), 0x142, 0xa, 0xf, false));
  v += __builtin_bit_cast(float, __builtin_amdgcn_update_dpp(0, __builtin_bit_cast(int, v), 0x143, 0xc, 0xf, false));
  return v;
}
__device__ __forceinline__ f32x4 mfma16(bf16x8 a, bf16x8 b, f32x4 c) { return __builtin_amdgcn_mfma_f32_16x16x32_bf16(a, b, c, 0, 0, 0); }
#define LDSV8(off) (*(const LAS bf16x8*)(lds + (off)))

namespace pg8 {
constexpr int BM = 256, BK = 64, HALF = 128, HTB = HALF * BK * 2, NXCD = 8, WGM = 8;
__device__ __forceinline__ int lds_byte(int r, int c) { const int st = (r >> 4) * 2 + (c >> 5), rr = r & 15, cc = c & 31, ob = rr * 64 + cc * 2; return st * 1024 + (ob ^ (((ob >> 9) & 1) << 5)); }
__device__ __forceinline__ void stage_rc(int b, int& R, int& C) { const int st = b / 1024, sb = b % 1024, swz = sb ^ (((sb >> 9) & 1) << 5); R = (st >> 1) * 16 + swz / 64; C = (st & 1) * 32 + (swz % 64) / 2; }
__device__ __forceinline__ int perm32(int rho) { const int n = rho >> 4, i = rho & 15; return 8 * (i >> 2) + 4 * n + (i & 3); }
struct Unit { int pm, pn; };
struct Gemm { const bf16_t* A; const bf16_t* Bt; int M, N, K, lda, mrows; };
struct StaticOrder {
  int nM, nN, nwg, G, c;
  __device__ void init(int M_, int N_, int G_, int c_) { nM = M_ / BM; nN = N_ / BM; nwg = nM * nN; G = G_; c = c_; }
  __device__ bool next(int i, Unit& u) const {
    const long L = (long)i * G + c; if (L >= nwg) return false;
    int wgid = (int)L; { const int q = nwg / NXCD, r = nwg % NXCD, xcd = wgid % NXCD, off = wgid / NXCD; wgid = (xcd < r ? xcd * (q + 1) : r * (q + 1) + (xcd - r) * q) + off; }
    const int nig = WGM * nN, gid = wgid / nig, fm = gid * WGM, gsz = (nM - fm) < WGM ? (nM - fm) : WGM;
    u.pm = fm + ((wgid % nig) % gsz); u.pn = (wgid % nig) / gsz; return true;
  }
};
__device__ __forceinline__ unsigned cvt_pk_bf16(float lo, float hi) { unsigned r; asm volatile("v_cvt_pk_bf16_f32 %0, %1, %2" : "=v"(r) : "v"(lo), "v"(hi)); return r; }

struct EpiBf16 {
  static constexpr bool PERM = true;
  bf16_t* O; int ldc; int act;
  __device__ __forceinline__ void operator()(const f32x4 (&acc)[2][2][4][2], const Unit& u, int wr, int wc, int fr, int fq) const {
    const int row0 = u.pm * BM + wr * 64 + fr; const int col0 = u.pn * BM + wc * 32 + 8 * fq;
    const bool sp = (act == 1) && (u.pn == 12);
#pragma unroll
    for (int ai = 0; ai < 2; ++ai)
#pragma unroll
      for (int m = 0; m < 4; ++m) { bf16_t* rowp = O + (size_t)(row0 + ai * HALF + m * 16) * ldc + col0;
#pragma unroll
        for (int bj = 0; bj < 2; ++bj) { f32x4 v0 = acc[ai][bj][m][0], v1 = acc[ai][bj][m][1];
          if (sp) {
            if (bj == 1) { for (int e = 0; e < 4; ++e) { v0[e] = sigm(v0[e]); v1[e] = sigm(v1[e]); } }
            else if (wc < 2) { for (int e = 0; e < 4; ++e) { v0[e] = tanhf(v0[e]); v1[e] = tanhf(v1[e]); } }
          }
          u32x4 w; w.x = cvt_pk_bf16(v0[0], v0[1]); w.y = cvt_pk_bf16(v0[2], v0[3]); w.z = cvt_pk_bf16(v1[0], v1[1]); w.w = cvt_pk_bf16(v1[2], v1[3]);
          *(u32x4*)(rowp + bj * HALF) = w; } }
  }
};
struct EpiResid {
  static constexpr bool PERM = false;
  float* X;
  __device__ __forceinline__ void operator()(const f32x4 (&acc)[2][2][4][2], const Unit& u, int wr, int wc, int fr, int fq) const {
#pragma unroll
    for (int ai = 0; ai < 2; ++ai) {
      f32x4 xv[4][2][2];
#pragma unroll
      for (int m = 0; m < 4; ++m) { const int row = u.pm * BM + ai * HALF + wr * 64 + m * 16 + fr;
#pragma unroll
        for (int bj = 0; bj < 2; ++bj)
#pragma unroll
          for (int n = 0; n < 2; ++n) xv[m][bj][n] = *(const f32x4*)(X + (size_t)row * 1024 + u.pn * BM + bj * HALF + wc * 32 + n * 16 + 4 * fq); }
#pragma unroll
      for (int m = 0; m < 4; ++m) { const int row = u.pm * BM + ai * HALF + wr * 64 + m * 16 + fr;
#pragma unroll
        for (int bj = 0; bj < 2; ++bj)
#pragma unroll
          for (int n = 0; n < 2; ++n) *(f32x4*)(X + (size_t)row * 1024 + u.pn * BM + bj * HALF + wc * 32 + n * 16 + 4 * fq) = xv[m][bj][n] + acc[ai][bj][m][n]; }
    }
  }
};
__device__ __forceinline__ float dpp_ror1(float v) { return __builtin_bit_cast(float, __builtin_amdgcn_update_dpp(0, __builtin_bit_cast(int, v), 0x121, 0xf, 0xf, false)); }
__device__ __forceinline__ float dpp_ror2(float v) { return __builtin_bit_cast(float, __builtin_amdgcn_update_dpp(0, __builtin_bit_cast(int, v), 0x122, 0xf, 0xf, false)); }
struct EpiFfn {
  bf16_t* H; int fb; LAS unsigned char* ldsb;
  __device__ __forceinline__ void operator()(const f32x4 (&acc)[2][2][4][2], const Unit& u, int wr, int wc, int fr, int fq) const {
    LAS float* HB = (LAS float*)(ldsb + PT_OFF + 2048); const LAS ull* PTt = (const LAS ull*)(ldsb + PT_OFF);
    const float* cw = (const float*)(const __attribute__((address_space(1))) float*)PTt[fb + 2]; const float* cb = (const float*)(const __attribute__((address_space(1))) float*)PTt[fb + 3];
    if (fr >= 14) {
#pragma unroll
      for (int ai = 0; ai < 2; ++ai)
#pragma unroll
        for (int bj = 0; bj < 2; ++bj)
#pragma unroll
          for (int n = 0; n < 2; ++n) *(LAS f32x4*)(HB + ((ai * 2 + wr) * 2 + (fr - 14)) * 256 + bj * 128 + wc * 32 + 8 * fq + 4 * n) = acc[ai][bj][3][n];
    }
    asm volatile("s_waitcnt lgkmcnt(0)" ::: "memory"); __builtin_amdgcn_s_barrier(); asm volatile("" ::: "memory");
    const int c0 = u.pn * 128 + wc * 32 + 8 * fq;
#pragma unroll
    for (int n = 0; n < 2; ++n) {
      asm volatile("" ::: "memory");
      const int c = c0 + 4 * n;
      const f32x4 wg0 = *(const f32x4*)(cw + c), wg1 = *(const f32x4*)(cw + FF2 + c), wg2 = *(const f32x4*)(cw + 2 * FF2 + c), bg = *(const f32x4*)(cb + c);
      const f32x4 wu0 = *(const f32x4*)(cw + FF + c), wu1 = *(const f32x4*)(cw + FF2 + FF + c), wu2 = *(const f32x4*)(cw + 2 * FF2 + FF + c), bu = *(const f32x4*)(cb + FF + c);
#pragma unroll
      for (int ai = 0; ai < 2; ++ai) {
        asm volatile("" ::: "memory");
        f32x4 hg1 = (f32x4){0.f, 0.f, 0.f, 0.f}, hg2 = hg1, hu1 = hg1, hu2 = hg1;
        const int ps = (wr == 1) ? ai * 2 : (ai == 1 ? 1 : -1);
        if (ps >= 0 && fr < 2) { const LAS float* hb = HB + ps * 512 + wc * 32 + 8 * fq + 4 * n;
          const f32x4 g62 = *(const LAS f32x4*)(hb), g63 = *(const LAS f32x4*)(hb + 256), u62 = *(const LAS f32x4*)(hb + 128), u63 = *(const LAS f32x4*)(hb + 256 + 128);
          hg1 = g63; hu1 = u63; hg2 = (fr == 0) ? g62 : g63; hu2 = (fr == 0) ? u62 : u63; }
#pragma unroll
        for (int m = 0; m < 4; ++m) {
          const f32x4 xg = acc[ai][0][m][n], xu = acc[ai][1][m][n];
          float hh[4];
#pragma unroll
          for (int e = 0; e < 4; ++e) {
            const float tg1 = dpp_ror1(xg[e]), tg2 = dpp_ror2(xg[e]), tu1 = dpp_ror1(xu[e]), tu2 = dpp_ror2(xu[e]);
            float qg1, qg2, qu1, qu2;
            if (m > 0) { qg1 = dpp_ror1(acc[ai][0][m - 1][n][e]); qg2 = dpp_ror2(acc[ai][0][m - 1][n][e]); qu1 = dpp_ror1(acc[ai][1][m - 1][n][e]); qu2 = dpp_ror2(acc[ai][1][m - 1][n][e]); }
            else { qg1 = hg1[e]; qg2 = hg2[e]; qu1 = hu1[e]; qu2 = hu2[e]; }
            const float pg1 = (fr == 0) ? qg1 : tg1, pg2 = (fr < 2) ? qg2 : tg2, pu1 = (fr == 0) ? qu1 : tu1, pu2 = (fr < 2) ? qu2 : tu2;
            const float gv = wg0[e] * pg2 + wg1[e] * pg1 + wg2[e] * xg[e] + bg[e];
            const float uv = wu0[e] * pu2 + wu1[e] * pu1 + wu2[e] * xu[e] + bu[e];
            hh[e] = gv * __builtin_amdgcn_rcpf(1.f + __expf(-gv)) * uv;
          }
          const int rl = ai * HALF + wr * 64 + m * 16 + fr; const int gr = 254 * u.pm - 2 + rl;
          if (rl >= 2 && gr < 16384) { u32x2 w; w.x = cvt_pk_bf16(hh[0], hh[1]); w.y = cvt_pk_bf16(hh[2], hh[3]); *(u32x2*)(H + (size_t)gr * 2816 + c) = w; }
          asm volatile("" ::: "memory"); __builtin_amdgcn_sched_barrier(0);
        }
      }
    }
  }
};
struct EpiAny {
  int mode; void* P; int ldc, act, fb; LAS unsigned char* ldsb;
  bool perm_() const { return mode != 0; }
  __device__ __forceinline__ void operator()(const f32x4 (&acc)[2][2][4][2], const Unit& u, int wr, int wc, int fr, int fq) const {
    if (mode == 2) { EpiFfn ef{(bf16_t*)P, fb, ldsb}; ef(acc, u, wr, wc, fr, fq); }
    else if (mode == 1) { EpiBf16 eb{(bf16_t*)P, ldc, act}; eb(acc, u, wr, wc, fr, fq); }
    else { EpiResid er{(float*)P}; er(acc, u, wr, wc, fr, fq); }
  }
};
template <class Epi>
__device__ __forceinline__ void gemm_phase(LAS unsigned char* lds, const Gemm g, const StaticOrder& S, const Epi& E, int wid_s) {
  const int tid = opaque_tid_w(wid_s), wid = __builtin_amdgcn_readfirstlane(tid >> 6), lane = tid & 63, wr = wid >> 2, wc = wid & 3, fr = lane & 15, fq = lane >> 4;
  const int K = g.K, nt = K / BK, lda = g.lda;
  unsigned voffA[2], voffB[2];
#pragma unroll
  for (int i = 0; i < 2; ++i) { int R, C; stage_rc(tid * 16 + i * 8192, R, C); const int Rb = (E.mode != 0) ? ((R & ~31) + perm32(R & 31)) : R;
    voffA[i] = (unsigned)(R * lda + C) * 2u; voffB[i] = (unsigned)(Rb * K + C) * 2u; }
  const size_t kstep = (size_t)(BK * 2);
  const size_t hA = (size_t)HALF * lda * 2, tA = (size_t)g.mrows * lda * 2, hB = (size_t)HALF * K * 2, tB = 2 * hB;
  const unsigned ldsw = (unsigned)wid * 1024u;
  const int aoff = lds_byte(wr * 64 + fr, fq * 8), boff = lds_byte(wc * 32 + fr, fq * 8);
#define PG8_SA(b, h) (((b) * 2 + (h)) * HTB)
#define PG8_SB(b, h) ((4 + (b) * 2 + (h)) * HTB)
#define PG8_STAGE(bufoff, gbase, voff) do { _Pragma("unroll") for (int _i = 0; _i < 2; ++_i) \
    __builtin_amdgcn_global_load_lds((const unsigned*)((const char*)(gbase) + (voff)[_i]), (LAS unsigned*)(lds + (bufoff) + ldsw + _i * 8192), 16, 0, 0); } while (0)
#define PG8_LDA(dst, b, h) do { _Pragma("unroll") for (int m = 0; m < 4; ++m) _Pragma("unroll") for (int k = 0; k < 2; ++k) dst[m][k] = *(const LAS bf16x8*)(lds + PG8_SA(b, h) + aoff + m * 2048 + k * 1024); } while (0)
#define PG8_LDB(dst, b, h) do { _Pragma("unroll") for (int n = 0; n < 2; ++n) _Pragma("unroll") for (int k = 0; k < 2; ++k) dst[n][k] = *(const LAS bf16x8*)(lds + PG8_SB(b, h) + boff + n * 2048 + k * 1024); } while (0)
#define PG8_MMA(ai, bj, At, Bt) do { __builtin_amdgcn_s_setprio(1); _Pragma("unroll") for (int m = 0; m < 4; ++m) _Pragma("unroll") for (int n = 0; n < 2; ++n) _Pragma("unroll") for (int k = 0; k < 2; ++k) \
    acc[ai][bj][m][n] = __builtin_amdgcn_mfma_f32_16x16x32_bf16(Bt[n][k], At[m][k], acc[ai][bj][m][n], 0, 0, 0); __builtin_amdgcn_s_setprio(0); } while (0)
#define PG8_WAIT_V(n) asm volatile("s_waitcnt vmcnt(" #n ")" ::: "memory")
#define PG8_WAIT_L(n) asm volatile("s_waitcnt lgkmcnt(" #n ")" ::: "memory")
#define PG8_BAR __builtin_amdgcn_s_barrier()
#define PG8_SCHED __builtin_amdgcn_sched_barrier(0)
  Unit cur, nxt; int ui = 0;
  if (!S.next(0, cur)) return;
  f32x4 acc[2][2][4][2];
#pragma unroll
  for (int a = 0; a < 2; ++a)
#pragma unroll
    for (int b = 0; b < 2; ++b)
#pragma unroll
      for (int m = 0; m < 4; ++m)
#pragma unroll
        for (int n = 0; n < 2; ++n) acc[a][b][m][n] = (f32x4){0.f, 0.f, 0.f, 0.f};
  bf16x8 At[4][2], B0[2][2], B1[2][2];
  const char* cA = (const char*)g.A + (size_t)cur.pm * tA; const char* cB = (const char*)g.Bt + (size_t)cur.pn * tB;
  PG8_STAGE(PG8_SB(0, 0), cB, voffB); PG8_STAGE(PG8_SB(0, 1), cB + hB, voffB); PG8_STAGE(PG8_SA(0, 0), cA, voffA); PG8_STAGE(PG8_SA(0, 1), cA + hA, voffA);
  if (wr == 1) PG8_BAR;
  PG8_WAIT_V(2); PG8_BAR;
  PG8_STAGE(PG8_SB(1, 0), cB + kstep, voffB); PG8_STAGE(PG8_SA(1, 0), cA + kstep, voffA); PG8_STAGE(PG8_SB(1, 1), cB + hB + kstep, voffB);
  PG8_WAIT_V(6); PG8_BAR;
  for (;;) {
    const bool has_next = S.next(ui + 1, nxt);
    const char* nA = has_next ? (const char*)g.A + (size_t)nxt.pm * tA : cA; const char* nB = has_next ? (const char*)g.Bt + (size_t)nxt.pn * tB : cB;
    for (int t = 0; t < nt; t += 2) {
      const bool last = (t == nt - 2);
      const char* a1 = cA + (size_t)(t + 1) * kstep;
      const char* a2 = last ? nA : cA + (size_t)(t + 2) * kstep; const char* b2 = last ? nB : cB + (size_t)(t + 2) * kstep;
      const char* a3 = a2 + kstep; const char* b3 = b2 + kstep;
      PG8_LDB(B0, 0, 0); PG8_LDB(B1, 0, 1); PG8_SCHED; PG8_LDA(At, 0, 0); PG8_STAGE(PG8_SA(1, 1), a1 + hA, voffA);
      PG8_WAIT_V(8); PG8_WAIT_L(0); PG8_BAR; PG8_MMA(0, 0, At, B0); PG8_MMA(0, 1, At, B1); PG8_BAR; PG8_SCHED;
      PG8_LDA(At, 0, 1); PG8_STAGE(PG8_SB(0, 0), b2, voffB); PG8_STAGE(PG8_SB(0, 1), b2 + hB, voffB); PG8_STAGE(PG8_SA(0, 0), a2, voffA);
      PG8_WAIT_V(8); PG8_WAIT_L(0); PG8_BAR; PG8_MMA(1, 0, At, B0); PG8_MMA(1, 1, At, B1); PG8_BAR; PG8_SCHED;
      PG8_LDB(B0, 1, 0); PG8_LDB(B1, 1, 1); PG8_SCHED; PG8_LDA(At, 1, 0); PG8_STAGE(PG8_SA(0, 1), a2 + hA, voffA);
      PG8_WAIT_V(8); PG8_WAIT_L(0); PG8_BAR; PG8_MMA(0, 0, At, B0); PG8_MMA(0, 1, At, B1); PG8_BAR; PG8_SCHED;
      PG8_LDA(At, 1, 1); PG8_STAGE(PG8_SB(1, 0), b3, voffB); PG8_STAGE(PG8_SB(1, 1), b3 + hB, voffB); PG8_STAGE(PG8_SA(1, 0), a3, voffA);
      PG8_WAIT_V(8); PG8_WAIT_L(0); PG8_BAR; PG8_MMA(1, 0, At, B0); PG8_MMA(1, 1, At, B1); PG8_BAR; PG8_SCHED;
    }
    if (wr == 0) PG8_BAR;
    { const int l2 = opaque_tid_w(wid_s) & 63; E(acc, cur, wr, wc, l2 & 15, l2 >> 4); }
    if (!has_next) break;
#pragma unroll
    for (int a = 0; a < 2; ++a)
#pragma unroll
      for (int b = 0; b < 2; ++b)
#pragma unroll
        for (int m = 0; m < 4; ++m)
#pragma unroll
          for (int n = 0; n < 2; ++n) acc[a][b][m][n] = (f32x4){0.f, 0.f, 0.f, 0.f};
    cur = nxt; cA = nA; cB = nB; ++ui;
    if (wr == 1) PG8_BAR;
  }
  PG8_WAIT_V(0);
  PG8_BAR;
#undef PG8_SA
#undef PG8_SB
#undef PG8_STAGE
#undef PG8_LDA
#undef PG8_LDB
#undef PG8_MMA
#undef PG8_WAIT_V
#undef PG8_WAIT_L
#undef PG8_BAR
#undef PG8_SCHED
}
}

__device__ __forceinline__ void conv_item(const ConvJob& J, const float* W, const float* sc, bf16_t* out, LAS float* scr, int item, int lane) {
  const int nblk = J.NP / 32, cb = item / nblk, nb = item % nblk, c0 = 64 * cb, n0 = 32 * nb;
#pragma unroll 8
  for (int i = 0; i < 32; ++i) { const int cc = 2 * i + (lane >> 5); const int k = c0 + cc - J.k_off; const int n = n0 + (lane & 31);
    float v = 0.f;
    if (k >= 0 && k < J.K && n < J.N) { v = W[(size_t)k * J.N + n]; if (J.sc_mode == 1) v *= sc[k]; else if (J.sc_mode == 2) v *= (1.f - sc[k]); }
    scr[cc * 33 + (lane & 31)] = v; }
  asm volatile("s_waitcnt lgkmcnt(0)" ::: "memory");
  const int c = lane & 7;
#pragma unroll
  for (int j = 0; j < 4; ++j) { const int n = (lane >> 3) + 8 * j; const LAS float* s = scr + (8 * c) * 33 + n;
    u32x4 o; o.x = pk2(s[0 * 33], s[1 * 33]); o.y = pk2(s[2 * 33], s[3 * 33]); o.z = pk2(s[4 * 33], s[5 * 33]); o.w = pk2(s[6 * 33], s[7 * 33]);
    int nr = n0 + n; if (J.perm) { const int half = nr >= FF ? 1 : 0; const int cc = nr - half * FF; nr = (cc >> 7) * 256 + half * 128 + (cc & 127); }
    *(u32x4*)(out + (size_t)(J.row_off + nr) * J.ldo + J.col_base + c0 + 8 * c) = o; }
  asm volatile("s_waitcnt lgkmcnt(0)" ::: "memory");
}

__device__ __forceinline__ float wave_total_n(float v) {
  v += dpp_row_shr(v, 1); v += dpp_row_shr(v, 2); v += dpp_row_shr(v, 4); v += dpp_row_shr(v, 8);
  v += __builtin_bit_cast(float, __builtin_amdgcn_update_dpp(0, __builtin_bit_cast(int, v), 0x142, 0xa, 0xf, false));
  v += __builtin_bit_cast(float, __builtin_amdgcn_update_dpp(0, __builtin_bit_cast(int, v), 0x143, 0xc, 0xf, false));
  return __builtin_bit_cast(float, __builtin_amdgcn_readlane(__builtin_bit_cast(int, v), 63));
}
__device__ __forceinline__ void norm_rows(const float* src, float* cpy, const float* g, bf16_t* out, int mode, int gw, int ngw, int lane) {
  f32x4 gg[4];
#pragma unroll
  for (int j = 0; j < 4; ++j) gg[j] = ((const f32x4*)g)[lane + 64 * j];
  if (mode == 4) { if (gw == 0) { unsigned zz = 0u; asm volatile("" : "+v"(zz)); for (int j = 0; j < 4; ++j) ((u32x4*)(out - 2048))[lane + 64 * j] = (u32x4){zz, zz, zz, zz}; } mode = 0; }
  for (int m0 = gw; m0 < M; m0 += 2 * ngw) {
    const int m1 = m0 + ngw;
    const bool has1 = m1 < M;
    f32x4 v[2][4]; float ss0 = 0.f, ss1 = 0.f;
#pragma unroll
    for (int j = 0; j < 4; ++j) { v[0][j] = ((const f32x4*)(src + (size_t)m0 * D))[lane + 64 * j]; v[1][j] = has1 ? ((const f32x4*)(src + (size_t)m1 * D))[lane + 64 * j] : (f32x4){0.f, 0.f, 0.f, 0.f}; }
#pragma unroll
    for (int j = 0; j < 4; ++j) { ss0 += (v[0][j].x * v[0][j].x + v[0][j].y * v[0][j].y) + (v[0][j].z * v[0][j].z + v[0][j].w * v[0][j].w);
      ss1 += (v[1][j].x * v[1][j].x + v[1][j].y * v[1][j].y) + (v[1][j].z * v[1][j].z + v[1][j].w * v[1][j].w); }
    ss0 = wave_total_n(ss0); ss1 = wave_total_n(ss1);
#pragma unroll
    for (int rr = 0; rr < 2; ++rr) {
      if (rr == 1 && !has1) break;
      const int m = rr ? m1 : m0; const float rs = 1.0f / sqrtf((rr ? ss1 : ss0) * (1.f / D) + 1e-6f);
#pragma unroll
      for (int j = 0; j < 4; ++j) {
        const f32x4 y = v[rr][j] * rs * gg[j];
        if (mode == 3) { ((f32x4*)(cpy + (size_t)m * D))[lane + 64 * j] = y; }
        else {
          if (mode == 1) ((f32x4*)(cpy + (size_t)m * D))[lane + 64 * j] = v[rr][j];
          u32x2 w; w.x = pk2(y.x, y.y); w.y = pk2(y.z, y.w);
          if (mode == 2) {
            *(u32x2*)(out + (size_t)m * 2048 + 4 * (lane + 64 * j)) = w;
            if (m + 1 < M) *(u32x2*)(out + (size_t)(m + 1) * 2048 + 1024 + 4 * (lane + 64 * j)) = w;
            if (m == 0) { unsigned zz = 0u; asm volatile("" : "+v"(zz)); *(u32x2*)(out + 1024 + 4 * (lane + 64 * j)) = (u32x2){zz, zz}; }
          } else *(u32x2*)(out + (size_t)m * 1024 + 4 * (lane + 64 * j)) = w;
        }
      }
    }
  }
}

__device__ __forceinline__ void conv_load8(const bf16_t* U, const bf16_t* UH, int t, int half, int col, float (&o)[8]) {
  if (t < 0) { for (int e = 0; e < 8; ++e) o[e] = 0.f; return; }
  const bf16_t* p = (t >= half * 8192) ? U + (size_t)(t - half * 8192) * FF2 + col : UH + (size_t)(t - 8190) * FF2 + col;
  const u32x4 w = *(const u32x4*)p;
  o[0] = bflo(w.x); o[1] = bfhi(w.x); o[2] = bflo(w.y); o[3] = bfhi(w.y); o[4] = bflo(w.z); o[5] = bfhi(w.z); o[6] = bflo(w.w); o[7] = bfhi(w.w);
}
__device__ __forceinline__ void ffn_conv(unsigned char* ws, const float* cw, const float* cb, int half, int gtid, int ngt) {
  const bf16_t* U = (const bf16_t*)(ws + A_U); bf16_t* UH = (bf16_t*)(ws + WS_SMALL + SM_UH); bf16_t* H = (bf16_t*)(ws + A_H);
  constexpr int RUN = 16, NCG = FF / 8, NP = (8192 / RUN) * NCG;
  for (int p = gtid; p < NP; p += ngt) {
    const int run = p / NCG, cg8 = p % NCG, c = cg8 * 8; const int t0 = half * 8192 + run * RUN;
    float wg[3][8], wu[3][8], bg[8], bu[8];
#pragma unroll
    for (int j = 0; j < 3; ++j)
#pragma unroll
      for (int e = 0; e < 8; ++e) { wg[j][e] = cw[j * FF2 + c + e]; wu[j][e] = cw[j * FF2 + FF + c + e]; }
#pragma unroll
    for (int e = 0; e < 8; ++e) { bg[e] = cb[c + e]; bu[e] = cb[FF + c + e]; }
    float g2[8], g1[8], u2[8], u1[8], g0[8], u0[8];
    conv_load8(U, UH, t0 - 2, half, c, g2); conv_load8(U, UH, t0 - 1, half, c, g1);
    conv_load8(U, UH, t0 - 2, half, FF + c, u2); conv_load8(U, UH, t0 - 1, half, FF + c, u1);
    for (int i = 0; i < RUN; ++i) {
      const int t = t0 + i;
      conv_load8(U, UH, t, half, c, g0); conv_load8(U, UH, t, half, FF + c, u0);
      float o[8];
#pragma unroll
      for (int e = 0; e < 8; ++e) {
        const float gv = wg[0][e] * g2[e] + wg[1][e] * g1[e] + wg[2][e] * g0[e] + bg[e];
        const float uv = wu[0][e] * u2[e] + wu[1][e] * u1[e] + wu[2][e] * u0[e] + bu[e];
        o[e] = gv * sigm(gv) * uv; g2[e] = g1[e]; g1[e] = g0[e]; u2[e] = u1[e]; u1[e] = u0[e];
      }
      u32x4 w; w.x = pk2(o[0], o[1]); w.y = pk2(o[2], o[3]); w.z = pk2(o[4], o[5]); w.w = pk2(o[6], o[7]);
      *(u32x4*)(H + (size_t)t * FF + c) = w;
    }
  }
  if (half == 0) {
    for (int p = gtid; p < 2 * FF2 / 8; p += ngt) { const int r = p / (FF2 / 8), cc = (p % (FF2 / 8)) * 8;
      *(u32x4*)(UH + (size_t)r * FF2 + cc) = *(const u32x4*)(U + (size_t)(8190 + r) * FF2 + cc); }
  }
}

constexpr int CS = 132;
constexpr int C_CUM = 0, C_QD = 33792, C_KI = 51200, C_VT = 68608, C_PP = 105472, C_GATE = 114688;
constexpr int G_AL = C_GATE, G_SEG = C_GATE + 4096, G_MISC = C_GATE + 6144;
constexpr float QSCALE = 0.08838834764831845f;
#define GM(i) ((LAS float*)(lds + G_MISC + (i) * 256))
__device__ __forceinline__ void unpack8(const u32x4 w, float (&o)[8]) { o[0] = bflo(w.x); o[1] = bfhi(w.x); o[2] = bflo(w.y); o[3] = bfhi(w.y); o[4] = bflo(w.z); o[5] = bfhi(w.z); o[6] = bflo(w.w); o[7] = bfhi(w.w); }
__device__ __forceinline__ u32x4 pack8(const float (&o)[8]) { return (u32x4){pk2(o[0], o[1]), pk2(o[2], o[3]), pk2(o[4], o[5]), pk2(o[6], o[7])}; }

__device__ __forceinline__ void gla_cum(LAS unsigned char* lds, const bf16_t* P, int c, int h, const float* wau, const float* balpha, int tid) {
  LAS float* AL = (LAS float*)(lds + G_AL); LAS float* SEG = (LAS float*)(lds + G_SEG); LAS float* CUM = (LAS float*)(lds + C_CUM);
  if (tid < 128) { const int t = tid >> 1, hf = tid & 1; float o[8]; unpack8(*(const u32x4*)(P + (size_t)(c * 64 + t) * 3328 + 3072 + hf * 8), o);
#pragma unroll
    for (int e = 0; e < 8; ++e) AL[t * 16 + hf * 8 + e] = o[e]; }
  __syncthreads();
  const int d = tid & 127, tq = tid >> 7;
  float wa[16];
#pragma unroll
  for (int j = 0; j < 16; ++j) wa[j] = wau[j * 512 + h * 128 + d];
  const float b = balpha[h * 128 + d];
  float run = 0.f;
#pragma unroll 2
  for (int i = 0; i < 16; ++i) { const int t = tq * 16 + i; float z = b;
#pragma unroll
    for (int j = 0; j < 16; ++j) z += AL[t * 16 + j] * wa[j];
    run += logsig(z) * (1.f / 16.f); CUM[t * CS + d] = run; }
  SEG[tq * 128 + d] = run;
  __syncthreads();
  float off = 0.f;
  for (int q = 0; q < tq; ++q) off += SEG[q * 128 + d];
  for (int i = 0; i < 16; ++i) CUM[(tq * 16 + i) * CS + d] += off;
  __syncthreads();
}
__device__ __forceinline__ void ml_gates(LAS unsigned char* lds, const bf16_t* P, int c, int h, const float* bif, int tid) {
  if (tid < 64) { const size_t r = (size_t)(c * 64 + tid) * 3328;
    GM(1)[tid] = bf2f(P[r + 3072 + h]) + bif[h];
    GM(0)[tid] = logsig(bf2f(P[r + 3076 + h]) + bif[4 + h]); }
  __syncthreads();
  if (tid == 0) { float run = 0.f; for (int t = 0; t < 64; ++t) { run += GM(0)[t]; GM(0)[t] = run; } }
  __syncthreads();
}
__device__ __forceinline__ void stage_vt(LAS unsigned char* lds, const bf16_t* P, int c, int h, int wid, int lane) {
  LAS bf16_t* VT = (LAS bf16_t*)(lds + C_VT);
  u32x4 vv[4];
#pragma unroll
  for (int g = 0; g < 4; ++g) vv[g] = *(const u32x4*)(P + (size_t)(c * 64 + lane) * 3328 + 1024 + h * 256 + 8 * (4 * wid + g));
#pragma unroll
  for (int g = 0; g < 4; ++g) { const unsigned w[4] = {vv[g].x, vv[g].y, vv[g].z, vv[g].w}; const int v0 = 8 * (4 * wid + g);
#pragma unroll
    for (int e = 0; e < 4; ++e) { VT[(v0 + 2 * e) * 72 + lane] = (bf16_t)(w[e] & 0xffffu); VT[(v0 + 2 * e + 1) * 72 + lane] = (bf16_t)(w[e] >> 16); } }
}

template <bool IS_ML>
__device__ __forceinline__ void chunk_local(LAS unsigned char* lds, unsigned char* ws, const float* w1, const float* w2, int bid, int nb, int wid_s) {
  const int tid = opaque_tid_w(wid_s), wid = wid_s, lane = tid & 63;
  const bf16_t* P = (const bf16_t*)(ws + A_P); bf16_t* BS = (bf16_t*)(ws + A_BS);
  float* DT = (float*)(ws + WS_SMALL + SM_DTOT);
  LAS bf16_t* KT = (LAS bf16_t*)(lds + C_QD); LAS float* CUM = (LAS float*)(lds + C_CUM);
  LAS float* SCL = (LAS float*)(lds + G_MISC + 1280);
  for (int it = bid; it < 1024; it += nb) {
    const int c = it >> 2, h = it & 3;
    if (IS_ML) {
      ml_gates(lds, P, c, h, w1, tid);
      if (tid == 0) { const float bl = GM(0)[63]; float mx = -1e30f; for (int s = 0; s < 64; ++s) mx = fmaxf(mx, bl - GM(0)[s] + GM(1)[s]); SCL[0] = bl; SCL[1] = mx;
        ((float*)(ws + WS_SMALL + SM_BL))[c * 4 + h] = bl; ((float*)(ws + WS_SMALL + SM_ML))[c * 4 + h] = mx; }
      __syncthreads();
    } else gla_cum(lds, P, c, h, w1, w2, tid);
    {
      u32x4 kv[2];
#pragma unroll
      for (int g = 0; g < 2; ++g) kv[g] = *(const u32x4*)(P + (size_t)(c * 64 + lane) * 3328 + 512 + h * 128 + 8 * (2 * wid + g));
      stage_vt(lds, P, c, h, wid, lane);
      const float fml = IS_ML ? __expf(SCL[0] - GM(0)[lane] + GM(1)[lane] - SCL[1]) * QSCALE : 0.f;
#pragma unroll
      for (int g = 0; g < 2; ++g) { const int d0 = 8 * (2 * wid + g); float k8[8]; unpack8(kv[g], k8);
        float f8[8];
        if (IS_ML) { for (int e = 0; e < 8; ++e) f8[e] = fml; }
        else { const f32x4 ca = *(const LAS f32x4*)(CUM + lane * CS + d0), cb = *(const LAS f32x4*)(CUM + lane * CS + d0 + 4), la = *(const LAS f32x4*)(CUM + 63 * CS + d0), lb = *(const LAS f32x4*)(CUM + 63 * CS + d0 + 4);
          f8[0] = __expf(la.x - ca.x); f8[1] = __expf(la.y - ca.y); f8[2] = __expf(la.z - ca.z); f8[3] = __expf(la.w - ca.w);
          f8[4] = __expf(lb.x - cb.x); f8[5] = __expf(lb.y - cb.y); f8[6] = __expf(lb.z - cb.z); f8[7] = __expf(lb.w - cb.w);
          if (lane == 63) { *(f32x4*)(DT + (c * 4 + h) * 128 + d0) = la; *(f32x4*)(DT + (c * 4 + h) * 128 + d0 + 4) = lb; } }
#pragma unroll
        for (int e = 0; e < 8; ++e) { const float kw = k8[e] * f8[e]; KT[(d0 + e) * 72 + lane] = (bf16_t)f2bf(kw);
          if (IS_ML) { const float ns = wave_total_n(kw); if (lane == 0) DT[(c * 4 + h) * 128 + d0 + e] = ns; } }
      }
    }
    __syncthreads();
    f32x4 acc[2][8];
#pragma unroll
    for (int a = 0; a < 2; ++a)
#pragma unroll
      for (int b = 0; b < 8; ++b) acc[a][b] = (f32x4){0.f, 0.f, 0.f, 0.f};
    const int fr = lane & 15, kg = lane >> 4;
#pragma unroll
    for (int ks = 0; ks < 2; ++ks) {
      bf16x8 av[2];
#pragma unroll
      for (int a = 0; a < 2; ++a) av[a] = LDSV8(C_VT + (((wid * 2 + a) * 16 + fr) * 72 + ks * 32 + kg * 8) * 2);
#pragma unroll
      for (int b = 0; b < 8; ++b) { const bf16x8 bv = LDSV8(C_QD + ((b * 16 + fr) * 72 + ks * 32 + kg * 8) * 2);
#pragma unroll
        for (int a = 0; a < 2; ++a) acc[a][b] = mfma16(av[a], bv, acc[a][b]); }
    }
#pragma unroll
    for (int a = 0; a < 2; ++a)
#pragma unroll
      for (int b = 0; b < 8; ++b)
#pragma unroll
        for (int r = 0; r < 4; ++r) { const int v = (wid * 2 + a) * 16 + 4 * kg + r, d = b * 16 + fr;
          BS[((size_t)(c * 4 + h) * 256 + v) * 128 + d] = (bf16_t)f2bf(acc[a][b][r]); }
    __syncthreads();
  }
}

template <bool IS_ML>
__device__ __forceinline__ void chunk_scan(unsigned char* ws, int gtid, int ngt) {
  bf16_t* BS = (bf16_t*)(ws + A_BS);
  const float* DT = (const float*)(ws + WS_SMALL + SM_DTOT); float* NST = (float*)(ws + WS_SMALL + SM_NST);
  const float* BL = (const float*)(ws + WS_SMALL + SM_BL); const float* MLc = (const float*)(ws + WS_SMALL + SM_ML); float* MST = (float*)(ws + WS_SMALL + SM_MST);
  constexpr int CB = 16;
  for (int e = gtid; e < 131072; e += ngt) {
    const int h = e >> 15, v = (e >> 7) & 255, d = e & 127;
    float st = 0.f, m = 0.f, n = 0.f;
    for (int c0 = 0; c0 < 256; c0 += CB) {
      float bv[CB], x0[CB], x1[CB], x2[CB];
#pragma unroll
      for (int j = 0; j < CB; ++j) { const int c = c0 + j;
        bv[j] = bf2f(BS[((size_t)(c * 4 + h) * 256 + v) * 128 + d]);
        if (IS_ML) { x0[j] = BL[c * 4 + h]; x1[j] = MLc[c * 4 + h]; x2[j] = (v == 0) ? DT[(c * 4 + h) * 128 + d] : 0.f; }
        else { x0[j] = DT[(c * 4 + h) * 128 + d]; x1[j] = 0.f; x2[j] = 0.f; } }
#pragma unroll
      for (int j = 0; j < CB; ++j) { const int c = c0 + j;
        BS[((size_t)(c * 4 + h) * 256 + v) * 128 + d] = (bf16_t)f2bf(st);
        if (IS_ML) {
          const float bl = x0[j], ml = x1[j]; const float mn = fmaxf(bl + m, ml);
          const float cs = __expf(bl + m - mn), wsc = __expf(ml - mn);
          st = cs * st + wsc * bv[j];
          if (v == 0) { NST[(c * 4 + h) * 128 + d] = n; n = cs * n + wsc * x2[j]; if (d == 0) MST[c * 4 + h] = m; }
          m = mn;
        } else st = st * __expf(x0[j]) + bv[j];
      }
    }
  }
}

template <bool IS_ML>
__device__ __forceinline__ void chunk_out(LAS unsigned char* lds, unsigned char* ws, const float* w1, const float* w2, const float* onorm, int bid, int nb, int wid_s) {
  const int tid = opaque_tid_w(wid_s), wid = tid >> 6, lane = tid & 63, fr = lane & 15, kg = lane >> 4;
  const bf16_t* P = (const bf16_t*)(ws + A_P); const bf16_t* BS = (const bf16_t*)(ws + A_BS); bf16_t* AO = (bf16_t*)(ws + A0);
  LAS bf16_t* QD = (LAS bf16_t*)(lds + C_QD); LAS bf16_t* KI = (LAS bf16_t*)(lds + C_KI); LAS bf16_t* VT = (LAS bf16_t*)(lds + C_VT); LAS bf16_t* PP = (LAS bf16_t*)(lds + C_PP);
  LAS float* CUM = (LAS float*)(lds + C_CUM); LAS float* OO = (LAS float*)lds; LAS float* SCL = (LAS float*)(lds + G_MISC + 1280);
  for (int it = bid; it < 1024; it += nb) {
    const int c = it >> 2, h = it & 3;
    if (IS_ML) {
      ml_gates(lds, P, c, h, w1, tid);
      if (tid < 64) { const float mp = ((const float*)(ws + WS_SMALL + SM_MST))[c * 4 + h]; const float bt = GM(0)[tid]; const float inter = bt + mp;
        float mx = -1e30f; for (int s = 0; s <= tid; ++s) mx = fmaxf(mx, GM(1)[s] - GM(0)[s]);
        const float mt = fmaxf(inter, mx + bt); GM(2)[tid] = mt; GM(4)[tid] = __expf(inter - mt); GM(3)[tid] = 0.f; }
      __syncthreads();
    } else gla_cum(lds, P, c, h, w1, w2, tid);
    {
      u32x4 qv[2], kv[2];
#pragma unroll
      for (int g = 0; g < 2; ++g) { const bf16_t* rp = P + (size_t)(c * 64 + lane) * 3328 + h * 128 + 8 * (2 * wid + g); qv[g] = *(const u32x4*)rp; kv[g] = *(const u32x4*)(rp + 512); }
      stage_vt(lds, P, c, h, wid, lane);
#pragma unroll
      for (int g = 0; g < 2; ++g) { const int d0 = 8 * (2 * wid + g); float q8[8], k8[8]; unpack8(qv[g], q8); unpack8(kv[g], k8);
        if (IS_ML) { for (int e = 0; e < 8; ++e) k8[e] *= QSCALE; }
        else { const f32x4 ca = *(const LAS f32x4*)(CUM + lane * CS + d0), cb = *(const LAS f32x4*)(CUM + lane * CS + d0 + 4); const float cu[8] = {ca.x, ca.y, ca.z, ca.w, cb.x, cb.y, cb.z, cb.w};
#pragma unroll
          for (int e = 0; e < 8; ++e) { const float ex = __expf(cu[e]); q8[e] *= ex * QSCALE; k8[e] *= __builtin_amdgcn_rcpf(ex); } }
        *(LAS u32x4*)(lds + C_QD + (lane * 136 + d0) * 2) = pack8(q8); *(LAS u32x4*)(lds + C_KI + (lane * 136 + d0) * 2) = pack8(k8); }
    }
    __syncthreads();
    float dinter = 0.f;
    if (IS_ML) {
      const int t = tid >> 3, part = tid & 7; const float* NST = (const float*)(ws + WS_SMALL + SM_NST) + (c * 4 + h) * 128;
      float s = 0.f; for (int j = 0; j < 16; ++j) { const int d = part * 16 + j; s += bf2f(QD[t * 136 + d]) * NST[d]; }
      s += sx<1>(s); s += sx<2>(s); s += sx<4>(s); dinter = s;
    }
    { const int tt = wid >> 1;
#pragma unroll
      for (int q = 0; q < 2; ++q) { const int st = 2 * (wid & 1) + q; f32x4 sc = (f32x4){0.f, 0.f, 0.f, 0.f};
        if (st <= tt) {
#pragma unroll
          for (int ks = 0; ks < 4; ++ks) sc = mfma16(LDSV8(C_QD + ((tt * 16 + fr) * 136 + ks * 32 + kg * 8) * 2), LDSV8(C_KI + ((st * 16 + fr) * 136 + ks * 32 + kg * 8) * 2), sc);
        }
        const int s = st * 16 + fr;
#pragma unroll
        for (int r = 0; r < 4; ++r) { const int t = tt * 16 + 4 * kg + r; float v = (s <= t) ? sc[r] : 0.f;
          if (IS_ML) { v = (s <= t) ? v * __expf(GM(0)[t] - GM(0)[s] + GM(1)[s] - GM(2)[t]) : 0.f;
            float rs = v; rs += sx<1>(rs); rs += sx<2>(rs); rs += sx<4>(rs); rs += sx<8>(rs);
            if (fr == 0) atomicAdd((float*)&GM(3)[t], rs); }
          PP[t * 72 + s] = (bf16_t)f2bf(v); }
      }
    }
    __syncthreads();
    f32x4 acc[8], acc2[8];
    { const int tt = wid & 3, vb = (wid >> 2) * 8;
#pragma unroll
      for (int j = 0; j < 8; ++j) { acc[j] = (f32x4){0.f, 0.f, 0.f, 0.f}; acc2[j] = (f32x4){0.f, 0.f, 0.f, 0.f}; }
#pragma unroll
      for (int ks = 0; ks < 2; ++ks) { const bf16x8 a = LDSV8(C_PP + ((tt * 16 + fr) * 72 + ks * 32 + kg * 8) * 2);
#pragma unroll
        for (int j = 0; j < 8; ++j) acc[j] = mfma16(a, LDSV8(C_VT + (((vb + j) * 16 + fr) * 72 + ks * 32 + kg * 8) * 2), acc[j]); }
#pragma unroll 2
      for (int ks = 0; ks < 4; ++ks) { const bf16x8 a = LDSV8(C_QD + ((tt * 16 + fr) * 136 + ks * 32 + kg * 8) * 2);
#pragma unroll
        for (int j = 0; j < 8; ++j) { const bf16x8 bv = *(const bf16x8*)(BS + ((size_t)(c * 4 + h) * 256 + (vb + j) * 16 + fr) * 128 + ks * 32 + kg * 8);
          if (IS_ML) acc2[j] = mfma16(a, bv, acc2[j]); else acc[j] = mfma16(a, bv, acc[j]); } }
    }
    __syncthreads();
    { const int tt = wid & 3, vb = (wid >> 2) * 8;
#pragma unroll
      for (int r = 0; r < 4; ++r) { const int t = tt * 16 + 4 * kg + r;
        float sc = 1.f, inv = 1.f;
        if (IS_ML) { sc = GM(4)[t]; }
#pragma unroll
        for (int j = 0; j < 8; ++j) { float o = acc[j][r]; if (IS_ML) o += sc * acc2[j][r]; OO[t * 260 + (vb + j) * 16 + fr] = o * inv; } }
    }
    __syncthreads();
    { const int t = tid >> 3, part = tid & 7, v0 = part * 32;
      float dn = 1.f;
      if (IS_ML) { const float den = GM(3)[t] + GM(4)[t] * dinter; dn = 1.f / fmaxf(fabsf(den), __expf(-GM(2)[t])); }
      float ov[32]; float ss = 0.f;
#pragma unroll
      for (int i = 0; i < 8; ++i) { const f32x4 o4 = *(const LAS f32x4*)(OO + t * 260 + v0 + 4 * i); ov[4 * i] = o4.x * dn; ov[4 * i + 1] = o4.y * dn; ov[4 * i + 2] = o4.z * dn; ov[4 * i + 3] = o4.w * dn; }
#pragma unroll
      for (int i = 0; i < 32; ++i) ss += ov[i] * ov[i];
      ss += sx<1>(ss); ss += sx<2>(ss); ss += sx<4>(ss);
      const float rs = 1.0f / sqrtf(ss * (1.f / 256.f) + 1e-6f);
      const bf16_t* gp = P + (size_t)(c * 64 + t) * 3328 + 2048 + h * 256 + v0; bf16_t* op = AO + (size_t)(c * 64 + t) * 1024 + h * 256 + v0;
#pragma unroll
      for (int i = 0; i < 4; ++i) { float g8[8]; unpack8(*(const u32x4*)(gp + 8 * i), g8); const f32x4 n0 = *(const f32x4*)(onorm + h * 256 + v0 + 8 * i), n1 = *(const f32x4*)(onorm + h * 256 + v0 + 8 * i + 4);
        const float nn[8] = {n0.x, n0.y, n0.z, n0.w, n1.x, n1.y, n1.z, n1.w}; float o8[8];
#pragma unroll
        for (int e = 0; e < 8; ++e) { const float gz = g8[e]; const float gate = IS_ML ? sigm(gz) : gz * sigm(gz); o8[e] = ov[8 * i + e] * rs * nn[e] * gate; }
        *(u32x4*)(op + 8 * i) = pack8(o8); }
    }
    __syncthreads();
  }
}

constexpr int S_Q = 0, S_K = 18432, S_V = 27648, S_Z = 36864, S_P = 70144, S_CARRY = 88576, S_FLAG = 89088;
constexpr float SB_EXIT = -120.f;
__device__ __forceinline__ void sb_attn(LAS unsigned char* lds, unsigned char* ws, int bid, int nb, int wid_s) {
  const int tid = opaque_tid_w(wid_s), wid = tid >> 6, lane = tid & 63, fr = lane & 15, kg = lane >> 4;
  const bf16_t* QKV = (const bf16_t*)(ws + A_P); bf16_t* AO = (bf16_t*)(ws + A0);
  LAS bf16_t* QS = (LAS bf16_t*)(lds + S_Q); LAS bf16_t* KS = (LAS bf16_t*)(lds + S_K); LAS bf16_t* VT = (LAS bf16_t*)(lds + S_V);
  LAS float* Z = (LAS float*)(lds + S_Z); LAS bf16_t* PP = (LAS bf16_t*)(lds + S_P); LAS float* CARRY = (LAS float*)(lds + S_CARRY); LAS volatile int* FLAG = (LAS volatile int*)(lds + S_FLAG);
  for (int it = bid; it < 2048; it += nb) {
    const int h = it & 15, qb = it >> 4;
    { const int row = tid >> 2, part = tid & 3; const bf16_t* src = QKV + (size_t)(qb * 128 + row) * 3072 + h * 64 + part * 16;
      u32x4 a = *(const u32x4*)src, b = *(const u32x4*)(src + 8);
      unsigned w[8] = {a.x, a.y, a.z, a.w, b.x, b.y, b.z, b.w}; unsigned o[8];
#pragma unroll
      for (int e = 0; e < 8; ++e) o[e] = pk2(bflo(w[e]) * 0.125f, bfhi(w[e]) * 0.125f);
      *(LAS u32x4*)(lds + S_Q + (row * 72 + part * 16) * 2) = (u32x4){o[0], o[1], o[2], o[3]};
      *(LAS u32x4*)(lds + S_Q + (row * 72 + part * 16 + 8) * 2) = (u32x4){o[4], o[5], o[6], o[7]};
      if (tid < 128) CARRY[tid] = 0.f;
      if (tid < 2) FLAG[tid] = 0;
    }
    f32x4 acc[4];
#pragma unroll
    for (int j = 0; j < 4; ++j) acc[j] = (f32x4){0.f, 0.f, 0.f, 0.f};
    int iter = 0;
    u32x4 kwn, vwn;
    { const int row = tid >> 3, part = tid & 7; const bf16_t* src = QKV + (size_t)((2 * qb + 1) * 64 + row) * 3072 + 1024 + h * 64 + part * 8; kwn = *(const u32x4*)src; vwn = *(const u32x4*)(src + 1024); }
    for (int kb = 2 * qb + 1; kb >= 0; --kb, ++iter) {
      { const int row = tid >> 3, part = tid & 7;
        const u32x4 kw = kwn; const u32x4 vw = vwn;
        if (kb > 0) { const bf16_t* src = QKV + (size_t)((kb - 1) * 64 + row) * 3072 + 1024 + h * 64 + part * 8; kwn = *(const u32x4*)src; vwn = *(const u32x4*)(src + 1024); }
        *(LAS u32x4*)(lds + S_K + (row * 72 + part * 8) * 2) = kw;
        const unsigned vv[4] = {vw.x, vw.y, vw.z, vw.w};
#pragma unroll
        for (int e = 0; e < 4; ++e) { VT[(part * 8 + 2 * e) * 72 + row] = (bf16_t)(vv[e] & 0xffffu); VT[(part * 8 + 2 * e + 1) * 72 + row] = (bf16_t)(vv[e] >> 16); }
      }
      __syncthreads();
      if (tid == 0) FLAG[(iter + 1) & 1] = 0;
#pragma unroll
      for (int kt = 0; kt < 4; ++kt) { f32x4 z = (f32x4){0.f, 0.f, 0.f, 0.f};
#pragma unroll
        for (int ks = 0; ks < 2; ++ks) z = mfma16(LDSV8(S_Q + ((wid * 16 + fr) * 72 + ks * 32 + kg * 8) * 2), LDSV8(S_K + ((kt * 16 + fr) * 72 + ks * 32 + kg * 8) * 2), z);
#pragma unroll
        for (int r = 0; r < 4; ++r) Z[(wid * 16 + 4 * kg + r) * 65 + kt * 16 + fr] = z[r]; }
      __syncthreads();
      { const int row = tid >> 2, seg = tid & 3; const int tq = qb * 128 + row; const int s0 = kb * 64 + seg * 16;
        float lbv[16], lkv[16]; float segsum = 0.f;
#pragma unroll
        for (int j = 0; j < 16; ++j) { const float z = Z[row * 65 + seg * 16 + j]; const float lb = logsig(z); const bool valid = (s0 + j) < tq;
          lbv[j] = valid ? lb : -1e30f; lkv[j] = valid ? lb - z : 0.f; segsum += lkv[j]; }
        const float v0 = quad_bcast<0>(segsum), v1 = quad_bcast<1>(segsum), v2 = quad_bcast<2>(segsum), v3 = quad_bcast<3>(segsum);
        const float right = (seg < 1 ? v1 : 0.f) + (seg < 2 ? v2 : 0.f) + (seg < 3 ? v3 : 0.f);
        const float cin = CARRY[row];
        float run = cin + right;
#pragma unroll
        for (int j = 15; j >= 0; --j) { const float w = __expf(lbv[j] + run); run += lkv[j]; PP[row * 72 + seg * 16 + j] = (bf16_t)f2bf(w); }
        const float cnew = cin + v0 + v1 + v2 + v3;
        if (seg == 0) { CARRY[row] = cnew; if (cnew > SB_EXIT) FLAG[iter & 1] = 1; }
      }
      __syncthreads();
#pragma unroll
      for (int ks = 0; ks < 2; ++ks) { const bf16x8 a = LDSV8(S_P + ((wid * 16 + fr) * 72 + ks * 32 + kg * 8) * 2);
#pragma unroll
        for (int j = 0; j < 4; ++j) acc[j] = mfma16(a, LDSV8(S_V + ((j * 16 + fr) * 72 + ks * 32 + kg * 8) * 2), acc[j]); }
      const int cont = FLAG[iter & 1];
      if (!cont) break;
      __syncthreads();
    }
#pragma unroll
    for (int j = 0; j < 4; ++j)
#pragma unroll
      for (int r = 0; r < 4; ++r) AO[(size_t)(qb * 128 + wid * 16 + 4 * kg + r) * 1024 + h * 64 + j * 16 + fr] = (bf16_t)f2bf(acc[j][r]);
    __syncthreads();
  }
}

constexpr int RK_L = 128, RK_NC = M / RK_L, RK_STEP = 1536;
constexpr unsigned A_RB = A_Y, A_RP = A_Y + 32 * MiB;
typedef float f32x2 __attribute__((ext_vector_type(2)));
template <int NB> struct RRaw { unsigned r[NB], k[NB], v[NB], w[NB], a[NB]; };
__device__ __forceinline__ float wave_total(float v) { const float s = wave_scan63(v); return __builtin_bit_cast(float, __builtin_amdgcn_readlane(__builtin_bit_cast(int, s), 63)); }
template <int NB> __device__ __forceinline__ void rk_issue(RRaw<NB>& R, const unsigned char* ws, int ch, int t0) {
  const bf16_t* P1 = (const bf16_t*)(ws + A_P1); const bf16_t* P2 = (const bf16_t*)(ws + A0);
#pragma unroll
  for (int q = 0; q < NB; ++q) { const size_t t = (size_t)(t0 + q);
    R.r[q] = P1[t * 3328 + ch]; R.k[q] = P1[t * 3328 + 1024 + ch]; R.v[q] = P1[t * 3328 + 2048 + ch];
    R.w[q] = P2[t * 2048 + ch]; R.a[q] = P2[t * 2048 + 1024 + ch]; }
}
template <bool WSC, int NB>
__device__ __forceinline__ void rk_prep8(const RRaw<NB>& R, LAS unsigned char* wl, float w0c, float a0c, float kkc, float kac, float rkc, float* SC, int t0, int h, int lane) {
#pragma unroll
  for (int q = 0; q < NB; ++q) {
    const float r = bf2f(R.r[q]), kr = bf2f(R.k[q]), v = bf2f(R.v[q]);
    const float wp = bf2f(R.w[q]) + w0c, ap = bf2f(R.a[q]) + a0c;
    const float decay = __expf(-0.6065306597126334f * __builtin_amdgcn_rcpf(1.f + __expf(-wp)));
    const float a = __builtin_amdgcn_rcpf(1.f + __expf(-ap));
    const float kkv = kr * kkc; const float kk = kkv * __builtin_amdgcn_rsqf(fmaxf(wave_total(kkv * kkv), 1e-24f));
    const float kmod = kr * (1.f + (a - 1.f) * kac);
    LAS float* p = (LAS float*)(wl + q * RK_STEP) + lane;
    p[0] = decay; p[64] = -kk; p[128] = kk * a; p[192] = kmod; p[256] = r; p[320] = v;
    if (WSC) { const float scv = wave_total(r * kmod * rkc); if (lane == 0) SC[(size_t)(t0 + q) * 16 + h] = scv; }
  }
}
#define RK_V4(off) (*(const LAS f32x4*)(p + (off)))
template <int PASS>
__device__ __forceinline__ void rk_chunk(LAS unsigned char* lds, unsigned char* ws, const float* w0, const float* a0, const float* k_k, const float* k_a, const float* r_k, int item, int wid, int lane) {
  const int h = item >> 7, c = item & 127, ch = h * 64 + lane, tb = c * RK_L;
  LAS unsigned char* wl = lds + wid * 16384;
  const float w0c = w0[ch], a0c = a0[ch], kkc = k_k[ch], kac = k_a[ch], rkc = r_k[ch];
  float* SC = (float*)(ws + WS_SMALL + SM_SC); bf16_t* Y = (bf16_t*)(ws + A_RP);
  float* Bg = (float*)(ws + A_RB) + ((size_t)(h * RK_NC + c) * 64 + lane) * 64;
  float* Pg = (float*)(ws + A_RP) + ((size_t)(h * RK_NC + c) * 64 + lane) * 64;
  f32x2 SB[32], SP[32];
  float zf = 0.f; asm volatile("" : "+v"(zf));
#pragma unroll
  for (int q = 0; q < 32; ++q) { SB[q] = (f32x2){zf, zf}; SP[q] = (f32x2){(2 * q == lane) ? 1.f : 0.f, (2 * q + 1 == lane) ? 1.f : 0.f}; }
  if (PASS == 3 && c > 0) { const float* Sg = Bg - 4096;
#pragma unroll
    for (int q = 0; q < 16; ++q) { const f32x4 v = *(const f32x4*)(Sg + 4 * q); SB[2 * q] = (f32x2){v.x, v.y}; SB[2 * q + 1] = (f32x2){v.z, v.w}; } }
  constexpr int NB = (PASS == 1) ? 2 : 4;
  RRaw<NB> RA;
  rk_issue<NB>(RA, ws, ch, tb);
  for (int blk = 0; blk < RK_L / NB; ++blk) {
    rk_prep8<PASS == 3, NB>(RA, wl, w0c, a0c, kkc, kac, rkc, SC, tb + blk * NB, h, lane);
    if (blk + 1 < RK_L / NB) rk_issue<NB>(RA, ws, ch, tb + (blk + 1) * NB);
#pragma unroll 1
    for (int s = 0; s < NB; ++s) {
      const LAS float* p = (const LAS float*)(wl + s * RK_STEP);
      f32x2 y0, y1;
      if constexpr (PASS == 1) {
      f32x2 a0v = (f32x2){zf, zf}, a1v = a0v, b0v = a0v, b1v = a0v;
      f32x4 NK[4], W[2], KA[2], KX[2];
      NK[0] = RK_V4(64); NK[1] = RK_V4(68); NK[2] = RK_V4(72);
#pragma unroll
      for (int q = 0; q < 16; ++q) {
        if (q + 3 < 16) NK[(q + 3) & 3] = RK_V4(64 + 4 * (q + 3));
        if (q == 15) { W[0] = RK_V4(0); KA[0] = RK_V4(128); KX[0] = RK_V4(192); }
        const f32x4 nk = NK[q & 3]; const f32x2 lo = (f32x2){nk.x, nk.y}, hi = (f32x2){nk.z, nk.w};
        a0v += SB[2 * q] * lo; a1v += SB[2 * q + 1] * hi; b0v += SP[2 * q] * lo; b1v += SP[2 * q + 1] * hi;
        asm volatile("" ::: "memory");
      }
      const float sa = (a0v.x + a0v.y) + (a1v.x + a1v.y), sp = (b0v.x + b0v.y) + (b1v.x + b1v.y);
      const float vv = p[320 + lane];
      const f32x2 sa2 = (f32x2){sa, sa}, sp2 = (f32x2){sp, sp}, v2 = (f32x2){vv, vv};
      y0 = (f32x2){zf, zf}; y1 = y0;
#pragma unroll
      for (int q = 0; q < 16; ++q) {
        if (q + 1 < 16) { W[(q + 1) & 1] = RK_V4(4 * (q + 1)); KA[(q + 1) & 1] = RK_V4(128 + 4 * (q + 1)); KX[(q + 1) & 1] = RK_V4(192 + 4 * (q + 1)); }
        const f32x4 w4 = W[q & 1], ka4 = KA[q & 1], kx4 = KX[q & 1];
        const f32x2 wl2 = (f32x2){w4.x, w4.y}, wh2 = (f32x2){w4.z, w4.w}, kal = (f32x2){ka4.x, ka4.y}, kah = (f32x2){ka4.z, ka4.w}, kxl = (f32x2){kx4.x, kx4.y}, kxh = (f32x2){kx4.z, kx4.w};
        SB[2 * q] = SB[2 * q] * wl2 + sa2 * kal + v2 * kxl; SB[2 * q + 1] = SB[2 * q + 1] * wh2 + sa2 * kah + v2 * kxh;
        SP[2 * q] = SP[2 * q] * wl2 + sp2 * kal; SP[2 * q + 1] = SP[2 * q + 1] * wh2 + sp2 * kah;
        asm volatile("" ::: "memory");
      }
      } else {
      f32x2 a0v = (f32x2){zf, zf}, a1v = a0v, b0v = a0v, b1v = a0v;
      f32x4 NK[2][4];
#pragma unroll
      for (int j = 0; j < 4; ++j) NK[0][j] = RK_V4(64 + 4 * j);
      f32x4 W[2][2], KA[2][2], KX[2][2], RR[2][2];
#pragma unroll
      for (int g = 0; g < 4; ++g) {
        if (g + 1 < 4) {
#pragma unroll
          for (int j = 0; j < 4; ++j) NK[(g + 1) & 1][j] = RK_V4(64 + 4 * (4 * (g + 1) + j));
        } else {
#pragma unroll
          for (int j = 0; j < 2; ++j) { W[0][j] = RK_V4(4 * j); KA[0][j] = RK_V4(128 + 4 * j); KX[0][j] = RK_V4(192 + 4 * j); if (PASS == 3) RR[0][j] = RK_V4(256 + 4 * j); }
        }
#pragma unroll
        for (int j = 0; j < 4; ++j) { const int q = 4 * g + j; const f32x4 nk = NK[g & 1][j]; const f32x2 lo = (f32x2){nk.x, nk.y}, hi = (f32x2){nk.z, nk.w};
          a0v += SB[2 * q] * lo; a1v += SB[2 * q + 1] * hi;
          if (PASS == 1) { b0v += SP[2 * q] * lo; b1v += SP[2 * q + 1] * hi; } }
        asm volatile("" ::: "memory");
      }
      const float sa = (a0v.x + a0v.y) + (a1v.x + a1v.y), sp = (b0v.x + b0v.y) + (b1v.x + b1v.y);
      const float vv = p[320 + lane];
      const f32x2 sa2 = (f32x2){sa, sa}, sp2 = (f32x2){sp, sp}, v2 = (f32x2){vv, vv};
      y0 = (f32x2){zf, zf}; y1 = y0;
#pragma unroll
      for (int g = 0; g < 8; ++g) {
        if (g + 1 < 8) {
#pragma unroll
          for (int j = 0; j < 2; ++j) { const int qn = 2 * (g + 1) + j; W[(g + 1) & 1][j] = RK_V4(4 * qn); KA[(g + 1) & 1][j] = RK_V4(128 + 4 * qn); KX[(g + 1) & 1][j] = RK_V4(192 + 4 * qn); if (PASS == 3) RR[(g + 1) & 1][j] = RK_V4(256 + 4 * qn); }
        }
#pragma unroll
        for (int j = 0; j < 2; ++j) { const int q = 2 * g + j; const f32x4 w4 = W[g & 1][j], ka4 = KA[g & 1][j], kx4 = KX[g & 1][j];
          const f32x2 wl2 = (f32x2){w4.x, w4.y}, wh2 = (f32x2){w4.z, w4.w}, kal = (f32x2){ka4.x, ka4.y}, kah = (f32x2){ka4.z, ka4.w}, kxl = (f32x2){kx4.x, kx4.y}, kxh = (f32x2){kx4.z, kx4.w};
          SB[2 * q] = SB[2 * q] * wl2 + sa2 * kal + v2 * kxl; SB[2 * q + 1] = SB[2 * q + 1] * wh2 + sa2 * kah + v2 * kxh;
          if (PASS == 1) { SP[2 * q] = SP[2 * q] * wl2 + sp2 * kal; SP[2 * q + 1] = SP[2 * q + 1] * wh2 + sp2 * kah; }
          if (PASS == 3) { const f32x4 r4 = RR[g & 1][j]; y0 += SB[2 * q] * (f32x2){r4.x, r4.y}; y1 += SB[2 * q + 1] * (f32x2){r4.z, r4.w}; } }
        asm volatile("" ::: "memory");
      }
      }
      if (PASS == 3) Y[(size_t)(tb + blk * NB + s) * 1024 + ch] = (bf16_t)f2bf((y0.x + y0.y) + (y1.x + y1.y));
    }
  }
  if (PASS == 1) {
#pragma unroll
    for (int q = 0; q < 16; ++q) { *(f32x4*)(Bg + 4 * q) = (f32x4){SB[2 * q].x, SB[2 * q].y, SB[2 * q + 1].x, SB[2 * q + 1].y};
      *(f32x4*)(Pg + 4 * q) = (f32x4){SP[2 * q].x, SP[2 * q].y, SP[2 * q + 1].x, SP[2 * q + 1].y}; }
  }
}
__device__ __forceinline__ void rk_scan(LAS unsigned char* lds, unsigned char* ws, int bid, int wid_s) {
  if (bid >= 64) return;
  const int tid = opaque_tid_w(wid_s), wid = wid_s, lane = tid & 63, h = bid >> 2, i0 = (bid & 3) * 16, i = lane >> 2, q = lane & 3;
  const float* Pg = (const float*)(ws + A_RP) + (size_t)h * RK_NC * 4096; float* Bg = (float*)(ws + A_RB) + (size_t)h * RK_NC * 4096;
  LAS float* PL = (LAS float*)lds; LAS float* SX = (LAS float*)(lds + 32768);
  f32x2 S[8];
  float zf = 0.f; asm volatile("" : "+v"(zf));
#pragma unroll
  for (int j = 0; j < 8; ++j) S[j] = (f32x2){zf, zf};
  f32x4 p0 = *(const f32x4*)(Pg + tid * 8), p1 = *(const f32x4*)(Pg + tid * 8 + 4);
  *(LAS f32x4*)(PL + tid * 8) = p0; *(LAS f32x4*)(PL + tid * 8 + 4) = p1;
  const size_t brow = (size_t)(i0 + i) * 64 + 8 * wid;
  f32x4 bn0 = *(const f32x4*)(Bg + brow), bn1 = *(const f32x4*)(Bg + brow + 4);
  asm volatile("s_waitcnt vmcnt(0) lgkmcnt(0)" ::: "memory"); __builtin_amdgcn_s_barrier(); asm volatile("" ::: "memory");
  for (int c = 0; c < RK_NC; ++c) {
    const LAS float* pl = PL + (c & 1) * 4096 + 8 * wid + q * 16 * 64;
    const f32x4 b0 = bn0, b1 = bn1;
    if (c + 1 < RK_NC) { p0 = *(const f32x4*)(Pg + (size_t)(c + 1) * 4096 + tid * 8); p1 = *(const f32x4*)(Pg + (size_t)(c + 1) * 4096 + tid * 8 + 4);
      bn0 = *(const f32x4*)(Bg + (size_t)(c + 1) * 4096 + brow); bn1 = *(const f32x4*)(Bg + (size_t)(c + 1) * 4096 + brow + 4); }
    f32x2 o0 = (f32x2){zf, zf}, o1 = o0, o2 = o0, o3 = o0;
    f32x4 PA[2][4], PB[2][4];
#pragma unroll
    for (int j = 0; j < 4; ++j) { PA[0][j] = *(const LAS f32x4*)(pl + j * 64); PB[0][j] = *(const LAS f32x4*)(pl + j * 64 + 4); }
#pragma unroll
    for (int g = 0; g < 4; ++g) {
      if (g + 1 < 4) {
#pragma unroll
        for (int j = 0; j < 4; ++j) { PA[(g + 1) & 1][j] = *(const LAS f32x4*)(pl + (4 * (g + 1) + j) * 64); PB[(g + 1) & 1][j] = *(const LAS f32x4*)(pl + (4 * (g + 1) + j) * 64 + 4); }
      }
#pragma unroll
      for (int j = 0; j < 4; ++j) { const int k = 4 * g + j; const f32x4 pa = PA[g & 1][j], pb = PB[g & 1][j];
        const float s = (k & 1) ? S[k >> 1].y : S[k >> 1].x; const f32x2 s2 = (f32x2){s, s};
        o0 += s2 * (f32x2){pa.x, pa.y}; o1 += s2 * (f32x2){pa.z, pa.w}; o2 += s2 * (f32x2){pb.x, pb.y}; o3 += s2 * (f32x2){pb.z, pb.w}; }
      asm volatile("" ::: "memory");
    }
    float ov[8] = {o0.x, o0.y, o1.x, o1.y, o2.x, o2.y, o3.x, o3.y};
#pragma unroll
    for (int j = 0; j < 8; ++j) { float v = ov[j];
      v += __builtin_bit_cast(float, __builtin_amdgcn_update_dpp(0, __builtin_bit_cast(int, v), 0xB1, 0xf, 0xf, false));
      v += __builtin_bit_cast(float, __builtin_amdgcn_update_dpp(0, __builtin_bit_cast(int, v), 0x4E, 0xf, 0xf, false));
      ov[j] = v; }
    const f32x4 r0 = (f32x4){ov[0] + b0.x, ov[1] + b0.y, ov[2] + b0.z, ov[3] + b0.w}, r1 = (f32x4){ov[4] + b1.x, ov[5] + b1.y, ov[6] + b1.z, ov[7] + b1.w};
    if (q == 0) { *(LAS f32x4*)(SX + i * 68 + 8 * wid) = r0; *(LAS f32x4*)(SX + i * 68 + 8 * wid + 4) = r1;
      *(f32x4*)(Bg + (size_t)c * 4096 + brow) = r0; *(f32x4*)(Bg + (size_t)c * 4096 + brow + 4) = r1; }
    asm volatile("s_waitcnt lgkmcnt(0)" ::: "memory"); __builtin_amdgcn_s_barrier(); asm volatile("" ::: "memory");
#pragma unroll
    for (int j = 0; j < 4; ++j) { const f32x4 v = *(const LAS f32x4*)(SX + i * 68 + q * 16 + 4 * j); S[2 * j] = (f32x2){v.x, v.y}; S[2 * j + 1] = (f32x2){v.z, v.w}; }
    if (c + 1 < RK_NC) { LAS float* pn = PL + ((c + 1) & 1) * 4096; *(LAS f32x4*)(pn + tid * 8) = p0; *(LAS f32x4*)(pn + tid * 8 + 4) = p1; }
    asm volatile("s_waitcnt lgkmcnt(0)" ::: "memory"); __builtin_amdgcn_s_barrier(); asm volatile("" ::: "memory");
  }
}
__device__ __forceinline__ void rwkv_post(unsigned char* ws, const float* gng, const float* gnb, int gw, int ngw, int lane) {
  const bf16_t* Y = (const bf16_t*)(ws + A_RP); const bf16_t* P1 = (const bf16_t*)(ws + A_P1); const bf16_t* G = (const bf16_t*)(ws + A0);
  const float* SC = (const float*)(ws + WS_SMALL + SM_SC); bf16_t* AO = (bf16_t*)(ws + A_RA);
  const int c0 = lane * 16;
  float gg[16], gb_[16];
#pragma unroll
  for (int j = 0; j < 4; ++j) { const f32x4 a = *(const f32x4*)(gng + c0 + 4 * j), b = *(const f32x4*)(gnb + c0 + 4 * j);
    gg[4 * j] = a.x; gg[4 * j + 1] = a.y; gg[4 * j + 2] = a.z; gg[4 * j + 3] = a.w; gb_[4 * j] = b.x; gb_[4 * j + 1] = b.y; gb_[4 * j + 2] = b.z; gb_[4 * j + 3] = b.w; }
  for (int t0 = gw; t0 < M; t0 += 2 * ngw) {
    const int t1 = t0 + ngw; const bool has1 = t1 < M; const int tt[2] = {t0, has1 ? t1 : t0};
    u32x4 ya[2], yb[2], va[2], vb[2], ga[2], gb[2]; float scv[2];
#pragma unroll
    for (int r = 0; r < 2; ++r) { const size_t t = (size_t)tt[r];
      ya[r] = *(const u32x4*)(Y + t * 1024 + c0); yb[r] = *(const u32x4*)(Y + t * 1024 + c0 + 8);
      va[r] = *(const u32x4*)(P1 + t * 3328 + 2048 + c0); vb[r] = *(const u32x4*)(P1 + t * 3328 + 2048 + c0 + 8);
      ga[r] = *(const u32x4*)(G + t * 1024 + c0); gb[r] = *(const u32x4*)(G + t * 1024 + c0 + 8);
      scv[r] = SC[t * 16 + (lane >> 2)]; }
#pragma unroll
    for (int r = 0; r < 2; ++r) {
      if (r == 1 && !has1) break;
      float y[16]; float s = 0.f;
      const unsigned yw[8] = {ya[r].x, ya[r].y, ya[r].z, ya[r].w, yb[r].x, yb[r].y, yb[r].z, yb[r].w};
#pragma unroll
      for (int e = 0; e < 8; ++e) { y[2 * e] = bflo(yw[e]); y[2 * e + 1] = bfhi(yw[e]); s += y[2 * e] + y[2 * e + 1]; }
      s += sx<1>(s); s += sx<2>(s);
      const float mean = s * (1.f / 64.f); float q = 0.f;
#pragma unroll
      for (int j = 0; j < 16; ++j) { y[j] -= mean; q += y[j] * y[j]; }
      q += sx<1>(q); q += sx<2>(q);
      const float rs = 1.0f / sqrtf(q * (1.f / 64.f) + 64e-5f);
      const unsigned vw[8] = {va[r].x, va[r].y, va[r].z, va[r].w, vb[r].x, vb[r].y, vb[r].z, vb[r].w}; const unsigned gwv[8] = {ga[r].x, ga[r].y, ga[r].z, ga[r].w, gb[r].x, gb[r].y, gb[r].z, gb[r].w};
      unsigned o[8];
#pragma unroll
      for (int e = 0; e < 8; ++e) {
        const float o0 = (y[2 * e] * rs * gg[2 * e] + gb_[2 * e] + scv[r] * bflo(vw[e])) * bflo(gwv[e]);
        const float o1 = (y[2 * e + 1] * rs * gg[2 * e + 1] + gb_[2 * e + 1] + scv[r] * bfhi(vw[e])) * bfhi(gwv[e]);
        o[e] = pk2(o0, o1); }
      *(u32x4*)(AO + (size_t)tt[r] * 1024 + c0) = (u32x4){o[0], o[1], o[2], o[3]};
      *(u32x4*)(AO + (size_t)tt[r] * 1024 + c0 + 8) = (u32x4){o[4], o[5], o[6], o[7]};
    }
  }
}


#define XB_TMO      128
#define XB_XCNT(j)  (256  + 64 * (j))
#define XB_XSUB(j)  (1280 + 64 * (j))
#define XB_XGEN(j)  (2304 + 64 * (j))
#define XB_TOP      3328
#define XB_TOPGEN   3392
#define XCD_BAR_WORDS 3456
#define XB_SPIN_CAP (1u << 22)
__device__ __forceinline__ unsigned xb_ld(unsigned* p)              { return __hip_atomic_load(p, __ATOMIC_RELAXED, __HIP_MEMORY_SCOPE_AGENT); }
__device__ __forceinline__ unsigned xb_add(unsigned* p, unsigned v) { return __hip_atomic_fetch_add(p, v, __ATOMIC_RELAXED, __HIP_MEMORY_SCOPE_AGENT); }
__device__ __forceinline__ unsigned xb_xcc_id() { return (unsigned)__builtin_amdgcn_s_getreg((3 << 11) | 20) & 0xFu; }
#define XB_SPIN(cond, bar) do { unsigned _sp = 0; while (cond) { __builtin_amdgcn_s_sleep(1); \
    if ((++_sp & 255u) == 0u) { if (xb_ld(&(bar)[XB_TMO])) break; if (_sp > XB_SPIN_CAP) { atomicAdd(&(bar)[XB_TMO], 1u); break; } } } } while (0)
struct XcdBarrier { unsigned* bar; unsigned x; volatile LAS unsigned* st; };
__device__ __forceinline__ XcdBarrier xcd_barrier_post(unsigned* bar, volatile LAS unsigned* st) {
    XcdBarrier b; b.bar = bar; b.x = xb_xcc_id(); b.st = st;
    if (threadIdx.x == 0) (void)xb_add(&bar[XB_XCNT(b.x)], 1u);
    return b;
}
__device__ __forceinline__ void xcd_barrier_complete(unsigned* bar, unsigned x, unsigned& nloc, unsigned& nx) {
    const unsigned G = gridDim.x * gridDim.y * gridDim.z;
    unsigned sum, cnt, mine, sp = 0u;
    for (;;) {
        sum = 0u; cnt = 0u; mine = 0u;
#pragma unroll
        for (unsigned j = 0; j < 16; ++j) { const unsigned c = xb_ld(&bar[XB_XCNT(j)]); sum += c; cnt += (c > 0u) ? 1u : 0u; mine = (j == x) ? c : mine; }
        if (sum == G) break;
        __builtin_amdgcn_s_sleep(1);
        if ((++sp & 255u) == 0u) { if (xb_ld(&bar[XB_TMO])) break; if (sp > XB_SPIN_CAP) { atomicAdd(&bar[XB_TMO], 1u); break; } }
    }
    nloc = mine > 0u ? mine : 1u; nx = cnt > 0u ? cnt : 1u;
}
__device__ __forceinline__ void xcd_barrier(const XcdBarrier& b, int wid_s) {
    asm volatile("s_waitcnt vmcnt(0)" ::: "memory");
    __syncthreads();
    if (opaque_tid_w(wid_s) == 0) {
        unsigned* bar = b.bar;
        __builtin_amdgcn_s_waitcnt(0);
        unsigned nloc = b.st[0], nx = b.st[1];
        if (nloc == 0u) { xcd_barrier_complete(bar, b.x, nloc, nx); b.st[0] = nloc; b.st[1] = nx; }
        const unsigned old = xb_add(&bar[XB_XSUB(b.x)], 1u);
        const unsigned gen = old / nloc;
        if (old + 1u == (gen + 1u) * nloc) {
            __builtin_amdgcn_fence(__ATOMIC_RELEASE, "agent");
            asm volatile("s_waitcnt vmcnt(0)" ::: "memory");
            const unsigned og = xb_add(&bar[XB_TOP], 1u);
            const unsigned tg = og / nx;
            if (og + 1u == (tg + 1u) * nx) xb_add(&bar[XB_TOPGEN], 1u);
            else XB_SPIN(xb_ld(&bar[XB_TOPGEN]) == tg, bar);
            __builtin_amdgcn_fence(__ATOMIC_ACQUIRE, "agent");
            xb_add(&bar[XB_XGEN(b.x)], 1u);
            asm volatile("s_waitcnt vmcnt(0)" ::: "memory");
        } else {
            XB_SPIN(xb_ld(&bar[XB_XGEN(b.x)]) == gen, bar);
            __builtin_amdgcn_fence(__ATOMIC_ACQUIRE, "agent");
            asm volatile("s_waitcnt vmcnt(0)" ::: "memory");
        }
    }
    __syncthreads();
}

struct KArgs { const float* in[53]; float* out; unsigned char* ws; };
#define INP(i) ((const float*)(const __attribute__((address_space(1))) float*)PT[(i)])

__global__ void __launch_bounds__(512, 2) mega_fwd(KArgs args) {
  extern __shared__ __attribute__((aligned(16))) unsigned char lds_raw[];
  LAS unsigned char* lds = (LAS unsigned char*)lds_raw;
  LAS ull* PT = (LAS ull*)(lds + PT_OFF);
  const int wid_s = __builtin_amdgcn_readfirstlane((int)threadIdx.x >> 6);
  if (threadIdx.x == 0) {
#pragma unroll
    for (int i = 0; i < 53; ++i) PT[i] = (ull)args.in[i];
  }
  if (threadIdx.x < 2) ((LAS unsigned*)(lds + PT_OFF + 1024))[threadIdx.x] = 0u;
  unsigned* barw = (unsigned*)(args.ws + WS_SMALL + SM_BAR);
  if (blockIdx.x == 0) for (int i = threadIdx.x; i < XCD_BAR_WORDS; i += 512) __hip_atomic_store(barw + i, 0u, __ATOMIC_RELAXED, __HIP_MEMORY_SCOPE_AGENT);
  __syncthreads();
  cg::grid_group grid = cg::this_grid();
  grid.sync();
  (void)xcd_barrier_post(barw, (volatile LAS unsigned*)(lds + PT_OFF + 1024));
  for (int pq = 0; pq < 2 * NPH; ++pq) {
    const int ph = pq >> 1;
    const PhaseDesc d = PROG[ph];
    if ((pq & 1) && !((REPMASK >> d.kind) & 1)) continue;
    __attribute__((address_space(1))) unsigned char* wsg = (__attribute__((address_space(1))) unsigned char*)args.ws; __attribute__((address_space(1))) float* Xg = (__attribute__((address_space(1))) float*)args.out;
    asm volatile("" : "+s"(wsg), "+s"(Xg));
    unsigned char* ws = (unsigned char*)wsg; float* X = (float*)Xg;
    { unsigned lb = 0; asm volatile("" : "+s"(lb)); lds = (LAS unsigned char*)lds_raw + lb; PT = (LAS ull*)(lds + PT_OFF); }
    int bid = blockIdx.x, G = gridDim.x; asm volatile("" : "+s"(bid), "+s"(G));
    const int wave = wid_s;
#define TIDS const int tid = opaque_tid_w(wid_s), lane = tid & 63, gw = bid * 8 + wave, ngw = G * 8, gtid = bid * 512 + tid, ngt = G * 512; (void)lane; (void)gw; (void)ngw; (void)gtid; (void)ngt
    switch (d.kind) {
      case K_PREP: { TIDS;
        if (d.lda == 1) norm_rows(INP(0), X, INP(d.K), (bf16_t*)(ws + d.a), 1, gw, ngw, lane);
        else norm_rows(X, nullptr, INP(d.K), (bf16_t*)(ws + d.a), d.lda, gw, ngw, lane);
      } break;
      case K_GEMM:
      case K_GEMMR: {
        const int mode = (d.kind == K_GEMMR) ? 0 : (d.act == 2 ? 2 : 1);
        pg8::Gemm g{(const bf16_t*)(ws + d.a), (const bf16_t*)(ws + d.b), d.Mr, d.N, d.K, d.lda, mode == 2 ? 254 : 256}; pg8::StaticOrder S; S.init(d.Mr, d.N, G, bid);
        void* outp = (mode == 0) ? (void*)X : (mode == 2 ? (void*)(ws + A_H) : (void*)(ws + d.c));
        pg8::EpiAny E{mode, outp, d.ldc, d.act, d.x1, lds};
        pg8::gemm_phase<pg8::EpiAny>(lds, g, S, E, wid_s);
      } break;
      case K_CLOCAL: if (d.x0) chunk_local<true>(lds, ws, INP(44), nullptr, bid, G, wid_s); else chunk_local<false>(lds, ws, INP(3), INP(4), bid, G, wid_s); break;
      case K_CSCAN: { TIDS; if (d.x0) chunk_scan<true>(ws, gtid, ngt); else chunk_scan<false>(ws, gtid, ngt); } break;
      case K_COUT: if (d.x0) chunk_out<true>(lds, ws, INP(44), nullptr, INP(45), bid, G, wid_s); else chunk_out<false>(lds, ws, INP(3), INP(4), INP(5), bid, G, wid_s); break;
      case K_RP1: { TIDS; for (int it = bid * 8 + wave; it < 2048; it += G * 8) rk_chunk<1>(lds, ws, INP(15), INP(18), INP(23), INP(24), INP(25), it, wave, lane); } break;
      case K_RSCAN: rk_scan(lds, ws, bid, wid_s); break;
      case K_RREC: { TIDS; for (int it = bid * 8 + wave; it < 2048; it += G * 8) rk_chunk<3>(lds, ws, INP(15), INP(18), INP(23), INP(24), INP(25), it, wave, lane); } break;
      case K_RPOST: { TIDS; rwkv_post(ws, INP(26), INP(27), gw, ngw, lane); } break;
      case K_SB: sb_attn(lds, ws, bid, G, wid_s); break;
      case K_FINAL: { TIDS; norm_rows(X, X, INP(d.K), nullptr, 3, gw, ngw, lane); } break;
      default: break;
    }
    {
      const int j0 = (d.kind == K_PREP) ? d.x0 : d.sj0, j1 = (d.kind == K_PREP) ? d.x1 : d.sj1;
      if (j1 > j0) {
        __syncthreads();
        const int lane2 = opaque_tid_w(wid_s) & 63;
        const bool sideg = (d.kind == K_GEMM) && G > 150;
        const int sw = sideg ? (bid - 150) * 8 + wave : bid * 8 + wave, nsw = sideg ? (G - 150) * 8 : G * 8;
        if (sw >= 0 && nsw > 0) {
          LAS float* scr = (LAS float*)(lds + wave * 16384);
          int base = 0;
          for (int j = j0; j < j1; ++j) { const ConvJob J = JOBS[j]; const int items = (J.KP / 64) * (J.NP / 32);
            const float* W = INP(J.in_idx) + J.in_off; const float* sc = INP(13) + J.sc_off; bf16_t* out = (bf16_t*)(ws + J.out_off);
            int it = sw - base; if (it < 0) it += nsw;
            for (; it < items; it += nsw) conv_item(J, W, sc, out, scr, it, lane2);
            base = (base + items) % nsw; }
        }
      }
    }
    { XcdBarrier xbar; xbar.bar = (unsigned*)(ws + WS_SMALL + SM_BAR); xbar.x = xb_xcc_id(); xbar.st = (volatile LAS unsigned*)(lds + PT_OFF + 1024);
      for (int xs = 0; xs < XSYNC; ++xs) xcd_barrier(xbar, wid_s);
      xcd_barrier(xbar, wid_s); }
  }
}

extern "C" void kernel_launch(void* const* d_in, const int* in_sizes, int n_in, void* d_out, int out_size, void* d_ws, size_t ws_size, hipStream_t stream) {
  static int grid = 0;
  if (grid == 0) {
    if (n_in != 53 || out_size != M * D || ws_size < WS_NEED) { fprintf(stderr, "kernel_launch: unexpected shapes n_in %d out %d ws %zu\n", n_in, out_size, ws_size); grid = -1; return; }
    int dev = 0, cus = 0, per_cu = 0;
    hipGetDevice(&dev); hipDeviceGetAttribute(&cus, hipDeviceAttributeMultiprocessorCount, dev);
    hipFuncSetAttribute((const void*)mega_fwd, hipFuncAttributeMaxDynamicSharedMemorySize, LDS_BYTES);
    hipOccupancyMaxActiveBlocksPerMultiprocessor(&per_cu, (const void*)mega_fwd, 512, LDS_BYTES);
    (void)hipGetLastError();
    if (per_cu < 1) per_cu = 1;
    grid = cus;
  }
  if (grid < 0) return;
  KArgs a{};
  for (int i = 0; i < 53; ++i) a.in[i] = (const float*)d_in[i];
  a.out = (float*)d_out; a.ws = (unsigned char*)d_ws;
  void* params[] = {&a};
  hipError_t e = hipLaunchCooperativeKernel((const void*)mega_fwd, dim3(grid), dim3(512), params, LDS_BYTES, stream);
  if (e != hipSuccess) fprintf(stderr, "cooperative launch failed: %s (grid %d)\n", hipGetErrorString(e), grid);
}
```

```cpp
#include <hip/hip_runtime.h>
#include <hip/hip_cooperative_groups.h>
#include <cstdio>
#include <cstdint>
namespace cg = cooperative_groups;

#define LAS __attribute__((address_space(3)))
typedef unsigned short bf16_t;
typedef short bf16x8 __attribute__((ext_vector_type(8)));
typedef float f32x4 __attribute__((ext_vector_type(4)));
typedef unsigned u32x4 __attribute__((ext_vector_type(4)));
typedef unsigned u32x2 __attribute__((ext_vector_type(2)));
typedef unsigned long long ull;

#ifndef EN_GLA
#define EN_GLA 1
#endif
#ifndef EN_RWKV
#define EN_RWKV 1
#endif
#ifndef EN_SB
#define EN_SB 1
#endif
#ifndef EN_ML
#define EN_ML 1
#endif
#ifndef EN_FFN
#define EN_FFN 1
#endif
#define REPMASK 0
#define XSYNC 0

constexpr int M = 16384, D = 1024, FF = 2816, FF2 = 5632;
constexpr unsigned MiB = 1u << 20;
constexpr unsigned WS_SMALL = 0;
constexpr unsigned SM_DTOT = 0;
constexpr unsigned SM_NST = 512 * 1024;
constexpr unsigned SM_BL = 1024 * 1024;
constexpr unsigned SM_ML = SM_BL + 4096;
constexpr unsigned SM_MST = SM_ML + 4096;
constexpr unsigned SM_UH = SM_MST + 4096;
constexpr unsigned SM_SC = 2 * MiB;
constexpr unsigned SM_BAR = 3 * MiB;
constexpr unsigned WS_W = 4 * MiB;
constexpr unsigned WS_ACT = 22 * MiB;
constexpr unsigned A0 = WS_ACT;
constexpr unsigned A_U = WS_ACT + 32 * MiB;
constexpr unsigned A_H = WS_ACT + 120 * MiB;
constexpr unsigned A_P = WS_ACT + 32 * MiB;
constexpr unsigned A_BS = WS_ACT + 136 * MiB;
constexpr unsigned A_P1 = WS_ACT + 64 * MiB;
constexpr unsigned A_Y = WS_ACT + 168 * MiB;
constexpr unsigned A_RA = WS_ACT + 32 * MiB;
constexpr size_t WS_NEED = 256ull * MiB;
constexpr unsigned W_GLA_IN = WS_W, W_GLA_OUT = WS_W + 3328u * 1024 * 2;
constexpr unsigned W_UP = WS_W, W_DOWN = WS_W + 5632u * 1024 * 2;
constexpr unsigned W_R1 = WS_W, W_R2A = W_R1 + 3328u * 2048 * 2, W_R2G = W_R2A + 2048u * 256 * 2, W_ROUT = W_R2G + 1024u * 256 * 2;
constexpr unsigned W_QKV = WS_ACT + 208 * MiB, W_SBOUT = W_QKV + 3072u * 1024 * 2;
constexpr unsigned WF_A = WS_ACT + 208 * MiB, WF_B = WS_ACT + 216 * MiB + 512 * 1024;
constexpr unsigned DOWN_OFF = 5632u * 1024 * 2;
static_assert(W_ROUT + 2u * MiB <= WS_ACT && W_DOWN + 1024u * 2816 * 2 <= WS_ACT, "weights region");
constexpr int RING_BYTES = 131072, PT_OFF = RING_BYTES, LDS_BYTES = 147456;

struct ConvJob { int in_idx, in_off, K, N, NP, KP, k_off, col_base, ldo, row_off, sc_off, sc_mode; unsigned out_off; int perm; };
#define MU(j) ((j) * 1024)
__constant__ ConvJob JOBS[] = {
    {2, 0, 1024, 3088, 3328, 1024, 0, 0, 1024, 0, 0, 0, W_GLA_IN},
    {6, 0, 1024, 1024, 1024, 1024, 0, 0, 1024, 0, 0, 0, W_GLA_OUT},
    {14, 0,       1024, 1024, 1024, 1024, 0, 0,    2048, 0,    MU(0), 2, W_R1},
    {14, 0,       1024, 1024, 1024, 1024, 0, 1024, 2048, 0,    MU(0), 1, W_R1},
    {14, 1048576, 1024, 1024, 1024, 1024, 0, 0,    2048, 1024, MU(2), 2, W_R1},
    {14, 1048576, 1024, 1024, 1024, 1024, 0, 1024, 2048, 1024, MU(2), 1, W_R1},
    {14, 2097152, 1024, 1024, 1024, 1024, 0, 0,    2048, 2048, MU(3), 2, W_R1},
    {14, 2097152, 1024, 1024, 1024, 1024, 0, 1024, 2048, 2048, MU(3), 1, W_R1},
    {16, 0, 1024, 64, 64, 1024, 0, 0,    2048, 3072, MU(1), 2, W_R1},
    {16, 0, 1024, 64, 64, 1024, 0, 1024, 2048, 3072, MU(1), 1, W_R1},
    {19, 0, 1024, 64, 64, 1024, 0, 0,    2048, 3136, MU(4), 2, W_R1},
    {19, 0, 1024, 64, 64, 1024, 0, 1024, 2048, 3136, MU(4), 1, W_R1},
    {21, 0, 1024, 128, 128, 1024, 0, 0,    2048, 3200, MU(5), 2, W_R1},
    {21, 0, 1024, 128, 128, 1024, 0, 1024, 2048, 3200, MU(5), 1, W_R1},
    {17, 0, 64, 1024, 1024, 256, 0, 0, 256, 0, 0, 0, W_R2A},
    {20, 0, 64, 1024, 1024, 256, 64, 0, 256, 1024, 0, 0, W_R2A},
    {22, 0, 128, 1024, 1024, 256, 128, 0, 256, 0, 0, 0, W_R2G},
    {28, 0, 1024, 1024, 1024, 1024, 0, 0, 1024, 0, 0, 0, W_ROUT},
    {35, 0, 1024, 3072, 3072, 1024, 0, 0, 1024, 0, 0, 0, W_QKV},
    {36, 0, 1024, 1024, 1024, 1024, 0, 0, 1024, 0, 0, 0, W_SBOUT},
    {43, 0, 1024, 3080, 3328, 1024, 0, 0, 1024, 0, 0, 0, W_GLA_IN},
    {46, 0, 1024, 1024, 1024, 1024, 0, 0, 1024, 0, 0, 0, W_GLA_OUT},
    {8, 0, 1024, 5632, 5632, 1024, 0, 0, 1024, 0, 0, 0, WF_A, 1},   {11, 0, 2816, 1024, 1024, 2816, 0, 0, 2816, 0, 0, 0, WF_A + DOWN_OFF},
    {30, 0, 1024, 5632, 5632, 1024, 0, 0, 1024, 0, 0, 0, W_UP, 1},  {33, 0, 2816, 1024, 1024, 2816, 0, 0, 2816, 0, 0, 0, W_DOWN},
    {38, 0, 1024, 5632, 5632, 1024, 0, 0, 1024, 0, 0, 0, WF_B, 1},  {41, 0, 2816, 1024, 1024, 2816, 0, 0, 2816, 0, 0, 0, WF_B + DOWN_OFF},
    {48, 0, 1024, 5632, 5632, 1024, 0, 0, 1024, 0, 0, 0, WF_A, 1},  {51, 0, 2816, 1024, 1024, 2816, 0, 0, 2816, 0, 0, 0, WF_A + DOWN_OFF},
};

enum { K_PREP = 0, K_GEMM, K_GEMMR, K_CLOCAL, K_CSCAN, K_COUT, K_CONV, K_RREC, K_RPOST, K_SB, K_FINAL, K_RP1, K_RSCAN, K_NOP };
struct PhaseDesc { int kind; unsigned a, b, c; int lda, K, Mr, N, ldc, act, x0, x1, sj0, sj1; };
#define FFN_PHASES(fb, wf, pj0, pj1, sj0_, sj1_) \
  {K_PREP, A0 + 4096u, 0, 0, 4, fb, 0, 0, 0, 0, pj0, pj1, 0, 0}, \
  {EN_FFN ? K_GEMM : K_NOP, A0, wf, 0, 1024, 1024, 16640, 5632, 0, 2, 0, fb, sj0_, sj1_}, \
  {EN_FFN ? K_GEMMR : K_NOP, A_H, (wf) + DOWN_OFF, 0, 2816, 2816, 16384, 1024, 0, 0, 0, 0, 0, 0}
__constant__ PhaseDesc PROG[] = {
  {K_PREP, A0, 0, 0, 1, 1, 0, 0, 0, 0, 0, 2},
  {EN_GLA ? K_GEMM : K_NOP, A0, W_GLA_IN, A_P, 1024, 1024, 16384, 3328, 3328, 0, 0, 0},
  {EN_GLA ? K_CLOCAL : K_NOP, 0, 0, 0, 0, 0, 0, 0, 0, 0, 0, 0},
  {EN_GLA ? K_CSCAN : K_NOP, 0, 0, 0, 0, 0, 0, 0, 0, 0, 0, 0},
  {EN_GLA ? K_COUT : K_NOP, 0, 0, 0, 0, 0, 0, 0, 0, 0, 0, 0, 22, 24},
  {EN_GLA ? K_GEMMR : K_NOP, A0, W_GLA_OUT, 0, 1024, 1024, 16384, 1024, 0, 0, 0, 0},
  FFN_PHASES(7, WF_A, 0, 0, 2, 18),
  {K_PREP, A0, 0, 0, 2, 12, 0, 0, 0, 0, 0, 0, 0, 0},
  {EN_RWKV ? K_GEMM : K_NOP, A0, W_R1, A_P1, 2048, 2048, 16384, 3328, 3328, 1, 0, 0},
  {EN_RWKV ? K_GEMM : K_NOP, A_P1 + 3072u * 2, W_R2A, A0, 3328, 256, 16384, 2048, 2048, 0, 0, 0},
  {EN_RWKV ? K_RP1 : K_NOP, 0, 0, 0, 0, 0, 0, 0, 0, 0, 0, 0},
  {EN_RWKV ? K_RSCAN : K_NOP, 0, 0, 0, 0, 0, 0, 0, 0, 0, 0, 0},
  {EN_RWKV ? K_RREC : K_NOP, 0, 0, 0, 0, 0, 0, 0, 0, 0, 0, 0},
  {EN_RWKV ? K_GEMM : K_NOP, A_P1 + 3072u * 2, W_R2G, A0, 3328, 256, 16384, 1024, 1024, 0, 0, 0},
  {EN_RWKV ? K_RPOST : K_NOP, 0, 0, 0, 0, 0, 0, 0, 0, 0, 0, 0},
  {EN_RWKV ? K_GEMMR : K_NOP, A_RA, W_ROUT, 0, 1024, 1024, 16384, 1024, 0, 0, 0, 0},
  FFN_PHASES(29, W_UP, 24, 26, 18, 20),
  {K_PREP, A0, 0, 0, 0, 34, 0, 0, 0, 0, 0, 0, 0, 0},
  {EN_SB ? K_GEMM : K_NOP, A0, W_QKV, A_P, 1024, 1024, 16384, 3072, 3072, 0, 0, 0},
  {EN_SB ? K_SB : K_NOP, 0, 0, 0, 0, 0, 0, 0, 0, 0, 0, 0, 26, 28},
  {EN_SB ? K_GEMMR : K_NOP, A0, W_SBOUT, 0, 1024, 1024, 16384, 1024, 0, 0, 0, 0},
  FFN_PHASES(37, WF_B, 0, 0, 20, 22),
  {K_PREP, A0, 0, 0, 0, 42, 0, 0, 0, 0, 0, 0, 0, 0},
  {EN_ML ? K_GEMM : K_NOP, A0, W_GLA_IN, A_P, 1024, 1024, 16384, 3328, 3328, 0, 0, 0},
  {EN_ML ? K_CLOCAL : K_NOP, 0, 0, 0, 0, 0, 0, 0, 0, 0, 1, 0},
  {EN_ML ? K_CSCAN : K_NOP, 0, 0, 0, 0, 0, 0, 0, 0, 0, 1, 0},
  {EN_ML ? K_COUT : K_NOP, 0, 0, 0, 0, 0, 0, 0, 0, 0, 1, 0, 28, 30},
  {EN_ML ? K_GEMMR : K_NOP, A0, W_GLA_OUT, 0, 1024, 1024, 16384, 1024, 0, 0, 0, 0},
  FFN_PHASES(47, WF_A, 0, 0, 0, 0),
  {K_FINAL, 0, 0, 0, 0, 52, 0, 0, 0, 0, 0, 0},
};
constexpr int NPH = sizeof(PROG) / sizeof(PhaseDesc);

__device__ __forceinline__ int opaque_tid_w(int wid_s) { unsigned z = 0u; asm volatile("" : "+v"(z)); int t = (wid_s << 6) | (int)__builtin_amdgcn_mbcnt_hi(~0u, __builtin_amdgcn_mbcnt_lo(~0u, z)); return t; }
__device__ __forceinline__ unsigned f2bf(float f) { unsigned u = __builtin_bit_cast(unsigned, f); return (u + 0x7fffu + ((u >> 16) & 1u)) >> 16; }
__device__ __forceinline__ float bf2f(unsigned b) { return __builtin_bit_cast(float, b << 16); }
__device__ __forceinline__ unsigned pk2(float lo, float hi) { return f2bf(lo) | (f2bf(hi) << 16); }
__device__ __forceinline__ float bflo(unsigned w) { return __builtin_bit_cast(float, w << 16); }
__device__ __forceinline__ float bfhi(unsigned w) { return __builtin_bit_cast(float, w & 0xffff0000u); }
template <int MASK> __device__ __forceinline__ float sx(float v) { return __builtin_bit_cast(float, __builtin_amdgcn_ds_swizzle(__builtin_bit_cast(int, v), (MASK << 10) | 0x1f)); }
template <int Q> __device__ __forceinline__ float quad_bcast(float v) { return __builtin_bit_cast(float, __builtin_amdgcn_update_dpp(0, __builtin_bit_cast(int, v), Q * 0x55, 0xf, 0xf, false)); }
__device__ __forceinline__ float wave_sum(float v) {
#pragma unroll
  for (int o = 1; o < 64; o <<= 1) v += __shfl_xor(v, o);
  return v;
}
__device__ __forceinline__ float logsig(float z) { return fminf(z, 0.f) - __logf(1.f + __expf(-fabsf(z))); }
__device__ __forceinline__ float sigm(float z) { return 1.f / (1.f + __expf(-z)); }
__device__ __forceinline__ float dpp_row_shr(float v, int n) {
  const int iv = __builtin_bit_cast(int, v); int r;
  switch (n) { case 1: r = __builtin_amdgcn_update_dpp(0, iv, 0x111, 0xf, 0xf, true); break; case 2: r = __builtin_amdgcn_update_dpp(0, iv, 0x112, 0xf, 0xf, true); break;
               case 4: r = __builtin_amdgcn_update_dpp(0, iv, 0x114, 0xf, 0xf, true); break; default: r = __builtin_amdgcn_update_dpp(0, iv, 0x118, 0xf, 0xf, true); break; }
  return __builtin_bit_cast(float, r);
}
__device__ __forceinline__ float wave_scan63(float v) {
  v += dpp_row_shr(v, 1); v += dpp_row_shr(v, 2); v += dpp_row_shr(v, 4); v += dpp_row_shr(v, 8);
  v += __builtin_bit_cast(float, __builtin_amdgcn_update_dpp(0, __builtin_bit_cast(int, v), 0x142, 0xa, 0xf, false));
  v += __builtin_bit_cast(float, __builtin_amdgcn_update_dpp(0, __builtin_bit_cast(int, v), 0x143, 0xc, 0xf, false));
  return v;
}
__device__ __forceinline__ f32x4 mfma16(bf16x8 a, bf16x8 b, f32x4 c) { return __builtin_amdgcn_mfma_f32_16x16x32_bf16(a, b, c, 0, 0, 0); }
#define LDSV8(off) (*(const LAS bf16x8*)(lds + (off)))

namespace pg8 {
constexpr int BM = 256, BK = 64, HALF = 128, HTB = HALF * BK * 2, NXCD = 8, WGM = 8;
__device__ __forceinline__ int lds_byte(int r, int c) { const int st = (r >> 4) * 2 + (c >> 5), rr = r & 15, cc = c & 31, ob = rr * 64 + cc * 2; return st * 1024 + (ob ^ (((ob >> 9) & 1) << 5)); }
__device__ __forceinline__ void stage_rc(int b, int& R, int& C) { const int st = b / 1024, sb = b % 1024, swz = sb ^ (((sb >> 9) & 1) << 5); R = (st >> 1) * 16 + swz / 64; C = (st & 1) * 32 + (swz % 64) / 2; }
__device__ __forceinline__ int perm32(int rho) { const int n = rho >> 4, i = rho & 15; return 8 * (i >> 2) + 4 * n + (i & 3); }
struct Unit { int pm, pn; };
struct Gemm { const bf16_t* A; const bf16_t* Bt; int M, N, K, lda, mrows; };
struct StaticOrder {
  int nM, nN, nwg, G, c;
  __device__ void init(int M_, int N_, int G_, int c_) { nM = M_ / BM; nN = N_ / BM; nwg = nM * nN; G = G_; c = c_; }
  __device__ bool next(int i, Unit& u) const {
    const long L = (long)i * G + c; if (L >= nwg) return false;
    int wgid = (int)L; { const int q = nwg / NXCD, r = nwg % NXCD, xcd = wgid % NXCD, off = wgid / NXCD; wgid = (xcd < r ? xcd * (q + 1) : r * (q + 1) + (xcd - r) * q) + off; }
    const int nig = WGM * nN, gid = wgid / nig, fm = gid * WGM, gsz = (nM - fm) < WGM ? (nM - fm) : WGM;
    u.pm = fm + ((wgid % nig) % gsz); u.pn = (wgid % nig) / gsz; return true;
  }
};
__device__ __forceinline__ unsigned cvt_pk_bf16(float lo, float hi) { unsigned r; asm volatile("v_cvt_pk_bf16_f32 %0, %1, %2" : "=v"(r) : "v"(lo), "v"(hi)); return r; }

struct EpiBf16 {
  static constexpr bool PERM = true;
  bf16_t* O; int ldc; int act;
  __device__ __forceinline__ void operator()(const f32x4 (&acc)[2][2][4][2], const Unit& u, int wr, int wc, int fr, int fq) const {
    const int row0 = u.pm * BM + wr * 64 + fr; const int col0 = u.pn * BM + wc * 32 + 8 * fq;
    const bool sp = (act == 1) && (u.pn == 12);
#pragma unroll
    for (int ai = 0; ai < 2; ++ai)
#pragma unroll
      for (int m = 0; m < 4; ++m) { bf16_t* rowp = O + (size_t)(row0 + ai * HALF + m * 16) * ldc + col0;
#pragma unroll
        for (int bj = 0; bj < 2; ++bj) { f32x4 v0 = acc[ai][bj][m][0], v1 = acc[ai][bj][m][1];
          if (sp) {
            if (bj == 1) { for (int e = 0; e < 4; ++e) { v0[e] = sigm(v0[e]); v1[e] = sigm(v1[e]); } }
            else if (wc < 2) { for (int e = 0; e < 4; ++e) { v0[e] = tanhf(v0[e]); v1[e] = tanhf(v1[e]); } }
          }
          u32x4 w; w.x = cvt_pk_bf16(v0[0], v0[1]); w.y = cvt_pk_bf16(v0[2], v0[3]); w.z = cvt_pk_bf16(v1[0], v1[1]); w.w = cvt_pk_bf16(v1[2], v1[3]);
          *(u32x4*)(rowp + bj * HALF) = w; } }
  }
};
struct EpiResid {
  static constexpr bool PERM = false;
  float* X;
  __device__ __forceinline__ void operator()(const f32x4 (&acc)[2][2][4][2], const Unit& u, int wr, int wc, int fr, int fq) const {
#pragma unroll
    for (int ai = 0; ai < 2; ++ai) {
      f32x4 xv[4][2][2];
#pragma unroll
      for (int m = 0; m < 4; ++m) { const int row = u.pm * BM + ai * HALF + wr * 64 + m * 16 + fr;
#pragma unroll
        for (int bj = 0; bj < 2; ++bj)
#pragma unroll
          for (int n = 0; n < 2; ++n) xv[m][bj][n] = *(const f32x4*)(X + (size_t)row * 1024 + u.pn * BM + bj * HALF + wc * 32 + n * 16 + 4 * fq); }
#pragma unroll
      for (int m = 0; m < 4; ++m) { const int row = u.pm * BM + ai * HALF + wr * 64 + m * 16 + fr;
#pragma unroll
        for (int bj = 0; bj < 2; ++bj)
#pragma unroll
          for (int n = 0; n < 2; ++n) *(f32x4*)(X + (size_t)row * 1024 + u.pn * BM + bj * HALF + wc * 32 + n * 16 + 4 * fq) = xv[m][bj][n] + acc[ai][bj][m][n]; }
    }
  }
};
__device__ __forceinline__ float dpp_ror1(float v) { return __builtin_bit_cast(float, __builtin_amdgcn_update_dpp(0, __builtin_bit_cast(int, v), 0x121, 0xf, 0xf, false)); }
__device__ __forceinline__ float dpp_ror2(float v) { return __builtin_bit_cast(float, __builtin_amdgcn_update_dpp(0, __builtin_bit_cast(int, v), 0x122, 0xf, 0xf, false)); }
struct EpiFfn {
  bf16_t* H; int fb; LAS unsigned char* ldsb;
  __device__ __forceinline__ void operator()(const f32x4 (&acc)[2][2][4][2], const Unit& u, int wr, int wc, int fr, int fq) const {
    LAS float* HB = (LAS float*)(ldsb + PT_OFF + 2048); const LAS ull* PTt = (const LAS ull*)(ldsb + PT_OFF);
    const float* cw = (const float*)(const __attribute__((address_space(1))) float*)PTt[fb + 2]; const float* cb = (const float*)(const __attribute__((address_space(1))) float*)PTt[fb + 3];
    if (fr >= 14) {
#pragma unroll
      for (int ai = 0; ai < 2; ++ai)
#pragma unroll
        for (int bj = 0; bj < 2; ++bj)
#pragma unroll
          for (int n = 0; n < 2; ++n) *(LAS f32x4*)(HB + ((ai * 2 + wr) * 2 + (fr - 14)) * 256 + bj * 128 + wc * 32 + 8 * fq + 4 * n) = acc[ai][bj][3][n];
    }
    asm volatile("s_waitcnt lgkmcnt(0)" ::: "memory"); __builtin_amdgcn_s_barrier(); asm volatile("" ::: "memory");
    const int c0 = u.pn * 128 + wc * 32 + 8 * fq;
#pragma unroll
    for (int n = 0; n < 2; ++n) {
      asm volatile("" ::: "memory");
      const int c = c0 + 4 * n;
      const f32x4 wg0 = *(const f32x4*)(cw + c), wg1 = *(const f32x4*)(cw + FF2 + c), wg2 = *(const f32x4*)(cw + 2 * FF2 + c), bg = *(const f32x4*)(cb + c);
      const f32x4 wu0 = *(const f32x4*)(cw + FF + c), wu1 = *(const f32x4*)(cw + FF2 + FF + c), wu2 = *(const f32x4*)(cw + 2 * FF2 + FF + c), bu = *(const f32x4*)(cb + FF + c);
#pragma unroll
      for (int ai = 0; ai < 2; ++ai) {
        asm volatile("" ::: "memory");
        f32x4 hg1 = (f32x4){0.f, 0.f, 0.f, 0.f}, hg2 = hg1, hu1 = hg1, hu2 = hg1;
        const int ps = (wr == 1) ? ai * 2 : (ai == 1 ? 1 : -1);
        if (ps >= 0 && fr < 2) { const LAS float* hb = HB + ps * 512 + wc * 32 + 8 * fq + 4 * n;
          const f32x4 g62 = *(const LAS f32x4*)(hb), g63 = *(const LAS f32x4*)(hb + 256), u62 = *(const LAS f32x4*)(hb + 128), u63 = *(const LAS f32x4*)(hb + 256 + 128);
          hg1 = g63; hu1 = u63; hg2 = (fr == 0) ? g62 : g63; hu2 = (fr == 0) ? u62 : u63; }
#pragma unroll
        for (int m = 0; m < 4; ++m) {
          const f32x4 xg = acc[ai][0][m][n], xu = acc[ai][1][m][n];
          float hh[4];
#pragma unroll
          for (int e = 0; e < 4; ++e) {
            const float tg1 = dpp_ror1(xg[e]), tg2 = dpp_ror2(xg[e]), tu1 = dpp_ror1(xu[e]), tu2 = dpp_ror2(xu[e]);
            float qg1, qg2, qu1, qu2;
            if (m > 0) { qg1 = dpp_ror1(acc[ai][0][m - 1][n][e]); qg2 = dpp_ror2(acc[ai][0][m - 1][n][e]); qu1 = dpp_ror1(acc[ai][1][m - 1][n][e]); qu2 = dpp_ror2(acc[ai][1][m - 1][n][e]); }
            else { qg1 = hg1[e]; qg2 = hg2[e]; qu1 = hu1[e]; qu2 = hu2[e]; }
            const float pg1 = (fr == 0) ? qg1 : tg1, pg2 = (fr < 2) ? qg2 : tg2, pu1 = (fr == 0) ? qu1 : tu1, pu2 = (fr < 2) ? qu2 : tu2;
            const float gv = wg0[e] * pg2 + wg1[e] * pg1 + wg2[e] * xg[e] + bg[e];
            const float uv = wu0[e] * pu2 + wu1[e] * pu1 + wu2[e] * xu[e] + bu[e];
            hh[e] = gv * __builtin_amdgcn_rcpf(1.f + __expf(-gv)) * uv;
          }
          const int rl = ai * HALF + wr * 64 + m * 16 + fr; const int gr = 254 * u.pm - 2 + rl;
          if (rl >= 2 && gr < 16384) { u32x2 w; w.x = cvt_pk_bf16(hh[0], hh[1]); w.y = cvt_pk_bf16(hh[2], hh[3]); *(u32x2*)(H + (size_t)gr * 2816 + c) = w; }
          asm volatile("" ::: "memory"); __builtin_amdgcn_sched_barrier(0);
        }
      }
    }
  }
};
struct EpiAny {
  int mode; void* P; int ldc, act, fb; LAS unsigned char* ldsb;
  bool perm_() const { return mode != 0; }
  __device__ __forceinline__ void operator()(const f32x4 (&acc)[2][2][4][2], const Unit& u, int wr, int wc, int fr, int fq) const {
    if (mode == 2) { EpiFfn ef{(bf16_t*)P, fb, ldsb}; ef(acc, u, wr, wc, fr, fq); }
    else if (mode == 1) { EpiBf16 eb{(bf16_t*)P, ldc, act}; eb(acc, u, wr, wc, fr, fq); }
    else { EpiResid er{(float*)P}; er(acc, u, wr, wc, fr, fq); }
  }
};
template <class Epi>
__device__ __forceinline__ void gemm_phase(LAS unsigned char* lds, const Gemm g, const StaticOrder& S, const Epi& E, int wid_s) {
  const int tid = opaque_tid_w(wid_s), wid = __builtin_amdgcn_readfirstlane(tid >> 6), lane = tid & 63, wr = wid >> 2, wc = wid & 3, fr = lane & 15, fq = lane >> 4;
  const int K = g.K, nt = K / BK, lda = g.lda;
  unsigned voffA[2], voffB[2];
#pragma unroll
  for (int i = 0; i < 2; ++i) { int R, C; stage_rc(tid * 16 + i * 8192, R, C); const int Rb = (E.mode != 0) ? ((R & ~31) + perm32(R & 31)) : R;
    voffA[i] = (unsigned)(R * lda + C) * 2u; voffB[i] = (unsigned)(Rb * K + C) * 2u; }
  const size_t kstep = (size_t)(BK * 2);
  const size_t hA = (size_t)HALF * lda * 2, tA = (size_t)g.mrows * lda * 2, hB = (size_t)HALF * K * 2, tB = 2 * hB;
  const unsigned ldsw = (unsigned)wid * 1024u;
  const int aoff = lds_byte(wr * 64 + fr, fq * 8), boff = lds_byte(wc * 32 + fr, fq * 8);
#define PG8_SA(b, h) (((b) * 2 + (h)) * HTB)
#define PG8_SB(b, h) ((4 + (b) * 2 + (h)) * HTB)
#define PG8_STAGE(bufoff, gbase, voff) do { _Pragma("unroll") for (int _i = 0; _i < 2; ++_i) \
    __builtin_amdgcn_global_load_lds((const unsigned*)((const char*)(gbase) + (voff)[_i]), (LAS unsigned*)(lds + (bufoff) + ldsw + _i * 8192), 16, 0, 0); } while (0)
#define PG8_LDA(dst, b, h) do { _Pragma("unroll") for (int m = 0; m < 4; ++m) _Pragma("unroll") for (int k = 0; k < 2; ++k) dst[m][k] = *(const LAS bf16x8*)(lds + PG8_SA(b, h) + aoff + m * 2048 + k * 1024); } while (0)
#define PG8_LDB(dst, b, h) do { _Pragma("unroll") for (int n = 0; n < 2; ++n) _Pragma("unroll") for (int k = 0; k < 2; ++k) dst[n][k] = *(const LAS bf16x8*)(lds + PG8_SB(b, h) + boff + n * 2048 + k * 1024); } while (0)
#define PG8_MMA(ai, bj, At, Bt) do { __builtin_amdgcn_s_setprio(1); _Pragma("unroll") for (int m = 0; m < 4; ++m) _Pragma("unroll") for (int n = 0; n < 2; ++n) _Pragma("unroll") for (int k = 0; k < 2; ++k) \
    acc[ai][bj][m][n] = __builtin_amdgcn_mfma_f32_16x16x32_bf16(Bt[n][k], At[m][k], acc[ai][bj][m][n], 0, 0, 0); __builtin_amdgcn_s_setprio(0); } while (0)
#define PG8_WAIT_V(n) asm volatile("s_waitcnt vmcnt(" #n ")" ::: "memory")
#define PG8_WAIT_L(n) asm volatile("s_waitcnt lgkmcnt(" #n ")" ::: "memory")
#define PG8_BAR __builtin_amdgcn_s_barrier()
#define PG8_SCHED __builtin_amdgcn_sched_barrier(0)
  Unit cur, nxt; int ui = 0;
  if (!S.next(0, cur)) return;
  f32x4 acc[2][2][4][2];
#pragma unroll
  for (int a = 0; a < 2; ++a)
#pragma unroll
    for (int b = 0; b < 2; ++b)
#pragma unroll
      for (int m = 0; m < 4; ++m)
#pragma unroll
        for (int n = 0; n < 2; ++n) acc[a][b][m][n] = (f32x4){0.f, 0.f, 0.f, 0.f};
  bf16x8 At[4][2], B0[2][2], B1[2][2];
  const char* cA = (const char*)g.A + (size_t)cur.pm * tA; const char* cB = (const char*)g.Bt + (size_t)cur.pn * tB;
  PG8_STAGE(PG8_SB(0, 0), cB, voffB); PG8_STAGE(PG8_SB(0, 1), cB + hB, voffB); PG8_STAGE(PG8_SA(0, 0), cA, voffA); PG8_STAGE(PG8_SA(0, 1), cA + hA, voffA);
  if (wr == 1) PG8_BAR;
  PG8_WAIT_V(2); PG8_BAR;
  PG8_STAGE(PG8_SB(1, 0), cB + kstep, voffB); PG8_STAGE(PG8_SA(1, 0), cA + kstep, voffA); PG8_STAGE(PG8_SB(1, 1), cB + hB + kstep, voffB);
  PG8_WAIT_V(6); PG8_BAR;
  for (;;) {
    const bool has_next = S.next(ui + 1, nxt);
    const char* nA = has_next ? (const char*)g.A + (size_t)nxt.pm * tA : cA; const char* nB = has_next ? (const char*)g.Bt + (size_t)nxt.pn * tB : cB;
    for (int t = 0; t < nt; t += 2) {
      const bool last = (t == nt - 2);
      const char* a1 = cA + (size_t)(t + 1) * kstep;
      const char* a2 = last ? nA : cA + (size_t)(t + 2) * kstep; const char* b2 = last ? nB : cB + (size_t)(t + 2) * kstep;
      const char* a3 = a2 + kstep; const char* b3 = b2 + kstep;
      PG8_LDB(B0, 0, 0); PG8_LDB(B1, 0, 1); PG8_SCHED; PG8_LDA(At, 0, 0); PG8_STAGE(PG8_SA(1, 1), a1 + hA, voffA);
      PG8_WAIT_V(8); PG8_WAIT_L(0); PG8_BAR; PG8_MMA(0, 0, At, B0); PG8_MMA(0, 1, At, B1); PG8_BAR; PG8_SCHED;
      PG8_LDA(At, 0, 1); PG8_STAGE(PG8_SB(0, 0), b2, voffB); PG8_STAGE(PG8_SB(0, 1), b2 + hB, voffB); PG8_STAGE(PG8_SA(0, 0), a2, voffA);
      PG8_WAIT_V(8); PG8_WAIT_L(0); PG8_BAR; PG8_MMA(1, 0, At, B0); PG8_MMA(1, 1, At, B1); PG8_BAR; PG8_SCHED;
      PG8_LDB(B0, 1, 0); PG8_LDB(B1, 1, 1); PG8_SCHED; PG8_LDA(At, 1, 0); PG8_STAGE(PG8_SA(0, 1), a2 + hA, voffA);
      PG8_WAIT_V(8); PG8_WAIT_L(0); PG8_BAR; PG8_MMA(0, 0, At, B0); PG8_MMA(0, 1, At, B1); PG8_BAR; PG8_SCHED;
      PG8_LDA(At, 1, 1); PG8_STAGE(PG8_SB(1, 0), b3, voffB); PG8_STAGE(PG8_SB(1, 1), b3 + hB, voffB); PG8_STAGE(PG8_SA(1, 0), a3, voffA);
      PG8_WAIT_V(8); PG8_WAIT_L(0); PG8_BAR; PG8_MMA(1, 0, At, B0); PG8_MMA(1, 1, At, B1); PG8_BAR; PG8_SCHED;
    }
    if (wr == 0) PG8_BAR;
    { const int l2 = opaque_tid_w(wid_s) & 63; E(acc, cur, wr, wc, l2 & 15, l2 >> 4); }
    if (!has_next) break;
#pragma unroll
    for (int a = 0; a < 2; ++a)
#pragma unroll
      for (int b = 0; b < 2; ++b)
#pragma unroll
        for (int m = 0; m < 4; ++m)
#pragma unroll
          for (int n = 0; n < 2; ++n) acc[a][b][m][n] = (f32x4){0.f, 0.f, 0.f, 0.f};
    cur = nxt; cA = nA; cB = nB; ++ui;
    if (wr == 1) PG8_BAR;
  }
  PG8_WAIT_V(0);
  PG8_BAR;
#undef PG8_SA
#undef PG8_SB
#undef PG8_STAGE
#undef PG8_LDA
#undef PG8_LDB
#undef PG8_MMA
#undef PG8_WAIT_V
#undef PG8_WAIT_L
#undef PG8_BAR
#undef PG8_SCHED
}
}

__device__ __forceinline__ void conv_item(const ConvJob& J, const float* W, const float* sc, bf16_t* out, LAS float* scr, int item, int lane) {
  const int nblk = J.NP / 32, cb = item / nblk, nb = item % nblk, c0 = 64 * cb, n0 = 32 * nb;
#pragma unroll 8
  for (int i = 0; i < 32; ++i) { const int cc = 2 * i + (lane >> 5); const int k = c0 + cc - J.k_off; const int n = n0 + (lane & 31);
    float v = 0.f;
    if (k >= 0 && k < J.K && n < J.N) { v = W[(size_t)k * J.N + n]; if (J.sc_mode == 1) v *= sc[k]; else if (J.sc_mode == 2) v *= (1.f - sc[k]); }
    scr[cc * 33 + (lane & 31)] = v; }
  asm volatile("s_waitcnt lgkmcnt(0)" ::: "memory");
  const int c = lane & 7;
#pragma unroll
  for (int j = 0; j < 4; ++j) { const int n = (lane >> 3) + 8 * j; const LAS float* s = scr + (8 * c) * 33 + n;
    u32x4 o; o.x = pk2(s[0 * 33], s[1 * 33]); o.y = pk2(s[2 * 33], s[3 * 33]); o.z = pk2(s[4 * 33], s[5 * 33]); o.w = pk2(s[6 * 33], s[7 * 33]);
    int nr = n0 + n; if (J.perm) { const int half = nr >= FF ? 1 : 0; const int cc = nr - half * FF; nr = (cc >> 7) * 256 + half * 128 + (cc & 127); }
    *(u32x4*)(out + (size_t)(J.row_off + nr) * J.ldo + J.col_base + c0 + 8 * c) = o; }
  asm volatile("s_waitcnt lgkmcnt(0)" ::: "memory");
}

__device__ __forceinline__ float wave_total_n(float v) {
  v += dpp_row_shr(v, 1); v += dpp_row_shr(v, 2); v += dpp_row_shr(v, 4); v += dpp_row_shr(v, 8);
  v += __builtin_bit_cast(float, __builtin_amdgcn_update_dpp(0, __builtin_bit_cast(int, v), 0x142, 0xa, 0xf, false));
  v += __builtin_bit_cast(float, __builtin_amdgcn_update_dpp(0, __builtin_bit_cast(int, v), 0x143, 0xc, 0xf, false));
  return __builtin_bit_cast(float, __builtin_amdgcn_readlane(__builtin_bit_cast(int, v), 63));
}
__device__ __forceinline__ void norm_rows(const float* src, float* cpy, const float* g, bf16_t* out, int mode, int gw, int ngw, int lane) {
  f32x4 gg[4];
#pragma unroll
  for (int j = 0; j < 4; ++j) gg[j] = ((const f32x4*)g)[lane + 64 * j];
  if (mode == 4) { if (gw == 0) { unsigned zz = 0u; asm volatile("" : "+v"(zz)); for (int j = 0; j < 4; ++j) ((u32x4*)(out - 2048))[lane + 64 * j] = (u32x4){zz, zz, zz, zz}; } mode = 0; }
  f32x4 vn[2][4];
  if (gw < M) {
#pragma unroll
    for (int j = 0; j < 4; ++j) { vn[0][j] = ((const f32x4*)(src + (size_t)gw * D))[lane + 64 * j]; vn[1][j] = (gw + ngw < M) ? ((const f32x4*)(src + (size_t)(gw + ngw) * D))[lane + 64 * j] : (f32x4){0.f, 0.f, 0.f, 0.f}; }
  }
  for (int m0 = gw; m0 < M; m0 += 2 * ngw) {
    const int m1 = m0 + ngw;
    const bool has1 = m1 < M;
    f32x4 v[2][4]; float ss0 = 0.f, ss1 = 0.f;
#pragma unroll
    for (int j = 0; j < 4; ++j) { v[0][j] = vn[0][j]; v[1][j] = vn[1][j]; }
    { const int n0 = m0 + 2 * ngw, n1 = n0 + ngw;
      if (n0 < M) {
#pragma unroll
        for (int j = 0; j < 4; ++j) { vn[0][j] = ((const f32x4*)(src + (size_t)n0 * D))[lane + 64 * j]; vn[1][j] = (n1 < M) ? ((const f32x4*)(src + (size_t)n1 * D))[lane + 64 * j] : (f32x4){0.f, 0.f, 0.f, 0.f}; }
      } }
#pragma unroll
    for (int j = 0; j < 4; ++j) { ss0 += (v[0][j].x * v[0][j].x + v[0][j].y * v[0][j].y) + (v[0][j].z * v[0][j].z + v[0][j].w * v[0][j].w);
      ss1 += (v[1][j].x * v[1][j].x + v[1][j].y * v[1][j].y) + (v[1][j].z * v[1][j].z + v[1][j].w * v[1][j].w); }
    ss0 = wave_total_n(ss0); ss1 = wave_total_n(ss1);
#pragma unroll
    for (int rr = 0; rr < 2; ++rr) {
      if (rr == 1 && !has1) break;
      const int m = rr ? m1 : m0; const float rs = 1.0f / sqrtf((rr ? ss1 : ss0) * (1.f / D) + 1e-6f);
#pragma unroll
      for (int j = 0; j < 4; ++j) {
        const f32x4 y = v[rr][j] * rs * gg[j];
        if (mode == 3) { ((f32x4*)(cpy + (size_t)m * D))[lane + 64 * j] = y; }
        else {
          if (mode == 1) ((f32x4*)(cpy + (size_t)m * D))[lane + 64 * j] = v[rr][j];
          u32x2 w; w.x = pk2(y.x, y.y); w.y = pk2(y.z, y.w);
          if (mode == 2) {
            *(u32x2*)(out + (size_t)m * 2048 + 4 * (lane + 64 * j)) = w;
            if (m + 1 < M) *(u32x2*)(out + (size_t)(m + 1) * 2048 + 1024 + 4 * (lane + 64 * j)) = w;
            if (m == 0) { unsigned zz = 0u; asm volatile("" : "+v"(zz)); *(u32x2*)(out + 1024 + 4 * (lane + 64 * j)) = (u32x2){zz, zz}; }
          } else *(u32x2*)(out + (size_t)m * 1024 + 4 * (lane + 64 * j)) = w;
        }
      }
    }
  }
}

__device__ __forceinline__ void conv_load8(const bf16_t* U, const bf16_t* UH, int t, int half, int col, float (&o)[8]) {
  if (t < 0) { for (int e = 0; e < 8; ++e) o[e] = 0.f; return; }
  const bf16_t* p = (t >= half * 8192) ? U + (size_t)(t - half * 8192) * FF2 + col : UH + (size_t)(t - 8190) * FF2 + col;
  const u32x4 w = *(const u32x4*)p;
  o[0] = bflo(w.x); o[1] = bfhi(w.x); o[2] = bflo(w.y); o[3] = bfhi(w.y); o[4] = bflo(w.z); o[5] = bfhi(w.z); o[6] = bflo(w.w); o[7] = bfhi(w.w);
}
__device__ __forceinline__ void ffn_conv(unsigned char* ws, const float* cw, const float* cb, int half, int gtid, int ngt) {
  const bf16_t* U = (const bf16_t*)(ws + A_U); bf16_t* UH = (bf16_t*)(ws + WS_SMALL + SM_UH); bf16_t* H = (bf16_t*)(ws + A_H);
  constexpr int RUN = 16, NCG = FF / 8, NP = (8192 / RUN) * NCG;
  for (int p = gtid; p < NP; p += ngt) {
    const int run = p / NCG, cg8 = p % NCG, c = cg8 * 8; const int t0 = half * 8192 + run * RUN;
    float wg[3][8], wu[3][8], bg[8], bu[8];
#pragma unroll
    for (int j = 0; j < 3; ++j)
#pragma unroll
      for (int e = 0; e < 8; ++e) { wg[j][e] = cw[j * FF2 + c + e]; wu[j][e] = cw[j * FF2 + FF + c + e]; }
#pragma unroll
    for (int e = 0; e < 8; ++e) { bg[e] = cb[c + e]; bu[e] = cb[FF + c + e]; }
    float g2[8], g1[8], u2[8], u1[8], g0[8], u0[8];
    conv_load8(U, UH, t0 - 2, half, c, g2); conv_load8(U, UH, t0 - 1, half, c, g1);
    conv_load8(U, UH, t0 - 2, half, FF + c, u2); conv_load8(U, UH, t0 - 1, half, FF + c, u1);
    for (int i = 0; i < RUN; ++i) {
      const int t = t0 + i;
      conv_load8(U, UH, t, half, c, g0); conv_load8(U, UH, t, half, FF + c, u0);
      float o[8];
#pragma unroll
      for (int e = 0; e < 8; ++e) {
        const float gv = wg[0][e] * g2[e] + wg[1][e] * g1[e] + wg[2][e] * g0[e] + bg[e];
        const float uv = wu[0][e] * u2[e] + wu[1][e] * u1[e] + wu[2][e] * u0[e] + bu[e];
        o[e] = gv * sigm(gv) * uv; g2[e] = g1[e]; g1[e] = g0[e]; u2[e] = u1[e]; u1[e] = u0[e];
      }
      u32x4 w; w.x = pk2(o[0], o[1]); w.y = pk2(o[2], o[3]); w.z = pk2(o[4], o[5]); w.w = pk2(o[6], o[7]);
      *(u32x4*)(H + (size_t)t * FF + c) = w;
    }
  }
  if (half == 0) {
    for (int p = gtid; p < 2 * FF2 / 8; p += ngt) { const int r = p / (FF2 / 8), cc = (p % (FF2 / 8)) * 8;
      *(u32x4*)(UH + (size_t)r * FF2 + cc) = *(const u32x4*)(U + (size_t)(8190 + r) * FF2 + cc); }
  }
}

constexpr int CS = 132;
constexpr int C_CUM = 0, C_QD = 33792, C_KI = 51200, C_VT = 68608, C_PP = 105472, C_GATE = 114688;
constexpr int G_AL = C_GATE, G_SEG = C_GATE + 4096, G_MISC = C_GATE + 6144;
constexpr float QSCALE = 0.08838834764831845f;
#define GM(i) ((LAS float*)(lds + G_MISC + (i) * 256))
__device__ __forceinline__ void unpack8(const u32x4 w, float (&o)[8]) { o[0] = bflo(w.x); o[1] = bfhi(w.x); o[2] = bflo(w.y); o[3] = bfhi(w.y); o[4] = bflo(w.z); o[5] = bfhi(w.z); o[6] = bflo(w.w); o[7] = bfhi(w.w); }
__device__ __forceinline__ u32x4 pack8(const float (&o)[8]) { return (u32x4){pk2(o[0], o[1]), pk2(o[2], o[3]), pk2(o[4], o[5]), pk2(o[6], o[7])}; }

__device__ __forceinline__ void gla_cum(LAS unsigned char* lds, const bf16_t* P, int c, int h, const float* wau, const float* balpha, int tid) {
  LAS float* AL = (LAS float*)(lds + G_AL); LAS float* SEG = (LAS float*)(lds + G_SEG); LAS float* CUM = (LAS float*)(lds + C_CUM);
  if (tid < 128) { const int t = tid >> 1, hf = tid & 1; float o[8]; unpack8(*(const u32x4*)(P + (size_t)(c * 64 + t) * 3328 + 3072 + hf * 8), o);
#pragma unroll
    for (int e = 0; e < 8; ++e) AL[t * 16 + hf * 8 + e] = o[e]; }
  __syncthreads();
  const int d = tid & 127, tq = tid >> 7;
  float wa[16];
#pragma unroll
  for (int j = 0; j < 16; ++j) wa[j] = wau[j * 512 + h * 128 + d];
  const float b = balpha[h * 128 + d];
  float run = 0.f;
#pragma unroll 2
  for (int i = 0; i < 16; ++i) { const int t = tq * 16 + i; float z = b;
#pragma unroll
    for (int j = 0; j < 16; ++j) z += AL[t * 16 + j] * wa[j];
    run += logsig(z) * (1.f / 16.f); CUM[t * CS + d] = run; }
  SEG[tq * 128 + d] = run;
  __syncthreads();
  float off = 0.f;
  for (int q = 0; q < tq; ++q) off += SEG[q * 128 + d];
  for (int i = 0; i < 16; ++i) CUM[(tq * 16 + i) * CS + d] += off;
  __syncthreads();
}
__device__ __forceinline__ void ml_gates(LAS unsigned char* lds, const bf16_t* P, int c, int h, const float* bif, int tid) {
  if (tid < 64) { const size_t r = (size_t)(c * 64 + tid) * 3328;
    GM(1)[tid] = bf2f(P[r + 3072 + h]) + bif[h];
    GM(0)[tid] = logsig(bf2f(P[r + 3076 + h]) + bif[4 + h]); }
  __syncthreads();
  if (tid == 0) { float run = 0.f; for (int t = 0; t < 64; ++t) { run += GM(0)[t]; GM(0)[t] = run; } }
  __syncthreads();
}
__device__ __forceinline__ void stage_vt(LAS unsigned char* lds, const bf16_t* P, int c, int h, int wid, int lane) {
  LAS bf16_t* VT = (LAS bf16_t*)(lds + C_VT);
  u32x4 vv[4];
#pragma unroll
  for (int g = 0; g < 4; ++g) vv[g] = *(const u32x4*)(P + (size_t)(c * 64 + lane) * 3328 + 1024 + h * 256 + 8 * (4 * wid + g));
#pragma unroll
  for (int g = 0; g < 4; ++g) { const unsigned w[4] = {vv[g].x, vv[g].y, vv[g].z, vv[g].w}; const int v0 = 8 * (4 * wid + g);
#pragma unroll
    for (int e = 0; e < 4; ++e) { VT[(v0 + 2 * e) * 72 + lane] = (bf16_t)(w[e] & 0xffffu); VT[(v0 + 2 * e + 1) * 72 + lane] = (bf16_t)(w[e] >> 16); } }
}

template <bool IS_ML>
__device__ __forceinline__ void chunk_local(LAS unsigned char* lds, unsigned char* ws, const float* w1, const float* w2, int bid, int nb, int wid_s) {
  const int tid = opaque_tid_w(wid_s), wid = wid_s, lane = tid & 63;
  const bf16_t* P = (const bf16_t*)(ws + A_P); bf16_t* BS = (bf16_t*)(ws + A_BS);
  float* DT = (float*)(ws + WS_SMALL + SM_DTOT);
  LAS bf16_t* KT = (LAS bf16_t*)(lds + C_QD); LAS float* CUM = (LAS float*)(lds + C_CUM);
  LAS float* SCL = (LAS float*)(lds + G_MISC + 1280);
  for (int it = bid; it < 1024; it += nb) {
    const int c = it >> 2, h = it & 3;
    if (IS_ML) {
      ml_gates(lds, P, c, h, w1, tid);
      if (tid == 0) { const float bl = GM(0)[63]; float mx = -1e30f; for (int s = 0; s < 64; ++s) mx = fmaxf(mx, bl - GM(0)[s] + GM(1)[s]); SCL[0] = bl; SCL[1] = mx;
        ((float*)(ws + WS_SMALL + SM_BL))[c * 4 + h] = bl; ((float*)(ws + WS_SMALL + SM_ML))[c * 4 + h] = mx; }
      __syncthreads();
    } else gla_cum(lds, P, c, h, w1, w2, tid);
    {
      u32x4 kv[2];
#pragma unroll
      for (int g = 0; g < 2; ++g) kv[g] = *(const u32x4*)(P + (size_t)(c * 64 + lane) * 3328 + 512 + h * 128 + 8 * (2 * wid + g));
      stage_vt(lds, P, c, h, wid, lane);
      const float fml = IS_ML ? __expf(SCL[0] - GM(0)[lane] + GM(1)[lane] - SCL[1]) * QSCALE : 0.f;
#pragma unroll
      for (int g = 0; g < 2; ++g) { const int d0 = 8 * (2 * wid + g); float k8[8]; unpack8(kv[g], k8);
        float f8[8];
        if (IS_ML) { for (int e = 0; e < 8; ++e) f8[e] = fml; }
        else { const f32x4 ca = *(const LAS f32x4*)(CUM + lane * CS + d0), cb = *(const LAS f32x4*)(CUM + lane * CS + d0 + 4), la = *(const LAS f32x4*)(CUM + 63 * CS + d0), lb = *(const LAS f32x4*)(CUM + 63 * CS + d0 + 4);
          f8[0] = __expf(la.x - ca.x); f8[1] = __expf(la.y - ca.y); f8[2] = __expf(la.z - ca.z); f8[3] = __expf(la.w - ca.w);
          f8[4] = __expf(lb.x - cb.x); f8[5] = __expf(lb.y - cb.y); f8[6] = __expf(lb.z - cb.z); f8[7] = __expf(lb.w - cb.w);
          if (lane == 63) { *(f32x4*)(DT + (c * 4 + h) * 128 + d0) = la; *(f32x4*)(DT + (c * 4 + h) * 128 + d0 + 4) = lb; } }
#pragma unroll
        for (int e = 0; e < 8; ++e) { const float kw = k8[e] * f8[e]; KT[(d0 + e) * 72 + lane] = (bf16_t)f2bf(kw);
          if (IS_ML) { const float ns = wave_total_n(kw); if (lane == 0) DT[(c * 4 + h) * 128 + d0 + e] = ns; } }
      }
    }
    __syncthreads();
    f32x4 acc[2][8];
#pragma unroll
    for (int a = 0; a < 2; ++a)
#pragma unroll
      for (int b = 0; b < 8; ++b) acc[a][b] = (f32x4){0.f, 0.f, 0.f, 0.f};
    const int fr = lane & 15, kg = lane >> 4;
#pragma unroll
    for (int ks = 0; ks < 2; ++ks) {
      bf16x8 av[2];
#pragma unroll
      for (int a = 0; a < 2; ++a) av[a] = LDSV8(C_VT + (((wid * 2 + a) * 16 + fr) * 72 + ks * 32 + kg * 8) * 2);
#pragma unroll
      for (int b = 0; b < 8; ++b) { const bf16x8 bv = LDSV8(C_QD + ((b * 16 + fr) * 72 + ks * 32 + kg * 8) * 2);
#pragma unroll
        for (int a = 0; a < 2; ++a) acc[a][b] = mfma16(av[a], bv, acc[a][b]); }
    }
#pragma unroll
    for (int a = 0; a < 2; ++a)
#pragma unroll
      for (int b = 0; b < 8; ++b)
#pragma unroll
        for (int r = 0; r < 4; ++r) { const int v = (wid * 2 + a) * 16 + 4 * kg + r, d = b * 16 + fr;
          BS[((size_t)(c * 4 + h) * 256 + v) * 128 + d] = (bf16_t)f2bf(acc[a][b][r]); }
    __syncthreads();
  }
}

template <bool IS_ML>
__device__ __forceinline__ void chunk_scan(unsigned char* ws, int gtid, int ngt) {
  bf16_t* BS = (bf16_t*)(ws + A_BS);
  const float* DT = (const float*)(ws + WS_SMALL + SM_DTOT); float* NST = (float*)(ws + WS_SMALL + SM_NST);
  const float* BL = (const float*)(ws + WS_SMALL + SM_BL); const float* MLc = (const float*)(ws + WS_SMALL + SM_ML); float* MST = (float*)(ws + WS_SMALL + SM_MST);
  constexpr int CB = 16;
  for (int e = gtid; e < 131072; e += ngt) {
    const int h = e >> 15, v = (e >> 7) & 255, d = e & 127;
    float st = 0.f, m = 0.f, n = 0.f;
    for (int c0 = 0; c0 < 256; c0 += CB) {
      float bv[CB], x0[CB], x1[CB], x2[CB];
#pragma unroll
      for (int j = 0; j < CB; ++j) { const int c = c0 + j;
        bv[j] = bf2f(BS[((size_t)(c * 4 + h) * 256 + v) * 128 + d]);
        if (IS_ML) { x0[j] = BL[c * 4 + h]; x1[j] = MLc[c * 4 + h]; x2[j] = (v == 0) ? DT[(c * 4 + h) * 128 + d] : 0.f; }
        else { x0[j] = DT[(c * 4 + h) * 128 + d]; x1[j] = 0.f; x2[j] = 0.f; } }
#pragma unroll
      for (int j = 0; j < CB; ++j) { const int c = c0 + j;
        BS[((size_t)(c * 4 + h) * 256 + v) * 128 + d] = (bf16_t)f2bf(st);
        if (IS_ML) {
          const float bl = x0[j], ml = x1[j]; const float mn = fmaxf(bl + m, ml);
          const float cs = __expf(bl + m - mn), wsc = __expf(ml - mn);
          st = cs * st + wsc * bv[j];
          if (v == 0) { NST[(c * 4 + h) * 128 + d] = n; n = cs * n + wsc * x2[j]; if (d == 0) MST[c * 4 + h] = m; }
          m = mn;
        } else st = st * __expf(x0[j]) + bv[j];
      }
    }
  }
}

template <bool IS_ML>
__device__ __forceinline__ void chunk_out(LAS unsigned char* lds, unsigned char* ws, const float* w1, const float* w2, const float* onorm, int bid, int nb, int wid_s) {
  const int tid = opaque_tid_w(wid_s), wid = tid >> 6, lane = tid & 63, fr = lane & 15, kg = lane >> 4;
  const bf16_t* P = (const bf16_t*)(ws + A_P); const bf16_t* BS = (const bf16_t*)(ws + A_BS); bf16_t* AO = (bf16_t*)(ws + A0);
  LAS bf16_t* QD = (LAS bf16_t*)(lds + C_QD); LAS bf16_t* KI = (LAS bf16_t*)(lds + C_KI); LAS bf16_t* VT = (LAS bf16_t*)(lds + C_VT); LAS bf16_t* PP = (LAS bf16_t*)(lds + C_PP);
  LAS float* CUM = (LAS float*)(lds + C_CUM); LAS float* OO = (LAS float*)lds; LAS float* SCL = (LAS float*)(lds + G_MISC + 1280);
  for (int it = bid; it < 1024; it += nb) {
    const int c = it >> 2, h = it & 3;
    if (IS_ML) {
      ml_gates(lds, P, c, h, w1, tid);
      if (tid < 64) { const float mp = ((const float*)(ws + WS_SMALL + SM_MST))[c * 4 + h]; const float bt = GM(0)[tid]; const float inter = bt + mp;
        float mx = -1e30f; for (int s = 0; s <= tid; ++s) mx = fmaxf(mx, GM(1)[s] - GM(0)[s]);
        const float mt = fmaxf(inter, mx + bt); GM(2)[tid] = mt; GM(4)[tid] = __expf(inter - mt); GM(3)[tid] = 0.f; }
      __syncthreads();
    } else gla_cum(lds, P, c, h, w1, w2, tid);
    {
      u32x4 qv[2], kv[2];
#pragma unroll
      for (int g = 0; g < 2; ++g) { const bf16_t* rp = P + (size_t)(c * 64 + lane) * 3328 + h * 128 + 8 * (2 * wid + g); qv[g] = *(const u32x4*)rp; kv[g] = *(const u32x4*)(rp + 512); }
      stage_vt(lds, P, c, h, wid, lane);
#pragma unroll
      for (int g = 0; g < 2; ++g) { const int d0 = 8 * (2 * wid + g); float q8[8], k8[8]; unpack8(qv[g], q8); unpack8(kv[g], k8);
        if (IS_ML) { for (int e = 0; e < 8; ++e) k8[e] *= QSCALE; }
        else { const f32x4 ca = *(const LAS f32x4*)(CUM + lane * CS + d0), cb = *(const LAS f32x4*)(CUM + lane * CS + d0 + 4); const float cu[8] = {ca.x, ca.y, ca.z, ca.w, cb.x, cb.y, cb.z, cb.w};
#pragma unroll
          for (int e = 0; e < 8; ++e) { const float ex = __expf(cu[e]); q8[e] *= ex * QSCALE; k8[e] *= __builtin_amdgcn_rcpf(ex); } }
        *(LAS u32x4*)(lds + C_QD + (lane * 136 + d0) * 2) = pack8(q8); *(LAS u32x4*)(lds + C_KI + (lane * 136 + d0) * 2) = pack8(k8); }
    }
    __syncthreads();
    float dinter = 0.f;
    if (IS_ML) {
      const int t = tid >> 3, part = tid & 7; const float* NST = (const float*)(ws + WS_SMALL + SM_NST) + (c * 4 + h) * 128;
      float s = 0.f; for (int j = 0; j < 16; ++j) { const int d = part * 16 + j; s += bf2f(QD[t * 136 + d]) * NST[d]; }
      s += sx<1>(s); s += sx<2>(s); s += sx<4>(s); dinter = s;
    }
    { const int tt = wid >> 1;
#pragma unroll
      for (int q = 0; q < 2; ++q) { const int st = 2 * (wid & 1) + q; f32x4 sc = (f32x4){0.f, 0.f, 0.f, 0.f};
        if (st <= tt) {
#pragma unroll
          for (int ks = 0; ks < 4; ++ks) sc = mfma16(LDSV8(C_QD + ((tt * 16 + fr) * 136 + ks * 32 + kg * 8) * 2), LDSV8(C_KI + ((st * 16 + fr) * 136 + ks * 32 + kg * 8) * 2), sc);
        }
        const int s = st * 16 + fr;
#pragma unroll
        for (int r = 0; r < 4; ++r) { const int t = tt * 16 + 4 * kg + r; float v = (s <= t) ? sc[r] : 0.f;
          if (IS_ML) { v = (s <= t) ? v * __expf(GM(0)[t] - GM(0)[s] + GM(1)[s] - GM(2)[t]) : 0.f;
            float rs = v; rs += sx<1>(rs); rs += sx<2>(rs); rs += sx<4>(rs); rs += sx<8>(rs);
            if (fr == 0) atomicAdd((float*)&GM(3)[t], rs); }
          PP[t * 72 + s] = (bf16_t)f2bf(v); }
      }
    }
    __syncthreads();
    f32x4 acc[8], acc2[8];
    { const int tt = wid & 3, vb = (wid >> 2) * 8;
#pragma unroll
      for (int j = 0; j < 8; ++j) { acc[j] = (f32x4){0.f, 0.f, 0.f, 0.f}; acc2[j] = (f32x4){0.f, 0.f, 0.f, 0.f}; }
#pragma unroll
      for (int ks = 0; ks < 2; ++ks) { const bf16x8 a = LDSV8(C_PP + ((tt * 16 + fr) * 72 + ks * 32 + kg * 8) * 2);
#pragma unroll
        for (int j = 0; j < 8; ++j) acc[j] = mfma16(a, LDSV8(C_VT + (((vb + j) * 16 + fr) * 72 + ks * 32 + kg * 8) * 2), acc[j]); }
#pragma unroll 2
      for (int ks = 0; ks < 4; ++ks) { const bf16x8 a = LDSV8(C_QD + ((tt * 16 + fr) * 136 + ks * 32 + kg * 8) * 2);
#pragma unroll
        for (int j = 0; j < 8; ++j) { const bf16x8 bv = *(const bf16x8*)(BS + ((size_t)(c * 4 + h) * 256 + (vb + j) * 16 + fr) * 128 + ks * 32 + kg * 8);
          if (IS_ML) acc2[j] = mfma16(a, bv, acc2[j]); else acc[j] = mfma16(a, bv, acc[j]); } }
    }
    __syncthreads();
    { const int tt = wid & 3, vb = (wid >> 2) * 8;
#pragma unroll
      for (int r = 0; r < 4; ++r) { const int t = tt * 16 + 4 * kg + r;
        float sc = 1.f, inv = 1.f;
        if (IS_ML) { sc = GM(4)[t]; }
#pragma unroll
        for (int j = 0; j < 8; ++j) { float o = acc[j][r]; if (IS_ML) o += sc * acc2[j][r]; OO[t * 260 + (vb + j) * 16 + fr] = o * inv; } }
    }
    __syncthreads();
    { const int t = tid >> 3, part = tid & 7, v0 = part * 32;
      float dn = 1.f;
      if (IS_ML) { const float den = GM(3)[t] + GM(4)[t] * dinter; dn = 1.f / fmaxf(fabsf(den), __expf(-GM(2)[t])); }
      float ov[32]; float ss = 0.f;
#pragma unroll
      for (int i = 0; i < 8; ++i) { const f32x4 o4 = *(const LAS f32x4*)(OO + t * 260 + v0 + 4 * i); ov[4 * i] = o4.x * dn; ov[4 * i + 1] = o4.y * dn; ov[4 * i + 2] = o4.z * dn; ov[4 * i + 3] = o4.w * dn; }
#pragma unroll
      for (int i = 0; i < 32; ++i) ss += ov[i] * ov[i];
      ss += sx<1>(ss); ss += sx<2>(ss); ss += sx<4>(ss);
      const float rs = 1.0f / sqrtf(ss * (1.f / 256.f) + 1e-6f);
      const bf16_t* gp = P + (size_t)(c * 64 + t) * 3328 + 2048 + h * 256 + v0; bf16_t* op = AO + (size_t)(c * 64 + t) * 1024 + h * 256 + v0;
#pragma unroll
      for (int i = 0; i < 4; ++i) { float g8[8]; unpack8(*(const u32x4*)(gp + 8 * i), g8); const f32x4 n0 = *(const f32x4*)(onorm + h * 256 + v0 + 8 * i), n1 = *(const f32x4*)(onorm + h * 256 + v0 + 8 * i + 4);
        const float nn[8] = {n0.x, n0.y, n0.z, n0.w, n1.x, n1.y, n1.z, n1.w}; float o8[8];
#pragma unroll
        for (int e = 0; e < 8; ++e) { const float gz = g8[e]; const float gate = IS_ML ? sigm(gz) : gz * sigm(gz); o8[e] = ov[8 * i + e] * rs * nn[e] * gate; }
        *(u32x4*)(op + 8 * i) = pack8(o8); }
    }
    __syncthreads();
  }
}

constexpr int S_Q = 0, S_K = 18432, S_V = 27648, S_Z = 36864, S_P = 70144, S_CARRY = 88576, S_FLAG = 89088;
constexpr float SB_EXIT = -120.f;
__device__ __forceinline__ void sb_attn(LAS unsigned char* lds, unsigned char* ws, int bid, int nb, int wid_s) {
  const int tid = opaque_tid_w(wid_s), wid = tid >> 6, lane = tid & 63, fr = lane & 15, kg = lane >> 4;
  const bf16_t* QKV = (const bf16_t*)(ws + A_P); bf16_t* AO = (bf16_t*)(ws + A0);
  LAS bf16_t* QS = (LAS bf16_t*)(lds + S_Q); LAS bf16_t* KS = (LAS bf16_t*)(lds + S_K); LAS bf16_t* VT = (LAS bf16_t*)(lds + S_V);
  LAS float* Z = (LAS float*)(lds + S_Z); LAS bf16_t* PP = (LAS bf16_t*)(lds + S_P); LAS float* CARRY = (LAS float*)(lds + S_CARRY); LAS volatile int* FLAG = (LAS volatile int*)(lds + S_FLAG);
  for (int it = bid; it < 2048; it += nb) {
    const int h = it & 15, qb = it >> 4;
    { const int row = tid >> 2, part = tid & 3; const bf16_t* src = QKV + (size_t)(qb * 128 + row) * 3072 + h * 64 + part * 16;
      u32x4 a = *(const u32x4*)src, b = *(const u32x4*)(src + 8);
      unsigned w[8] = {a.x, a.y, a.z, a.w, b.x, b.y, b.z, b.w}; unsigned o[8];
#pragma unroll
      for (int e = 0; e < 8; ++e) o[e] = pk2(bflo(w[e]) * 0.125f, bfhi(w[e]) * 0.125f);
      *(LAS u32x4*)(lds + S_Q + (row * 72 + part * 16) * 2) = (u32x4){o[0], o[1], o[2], o[3]};
      *(LAS u32x4*)(lds + S_Q + (row * 72 + part * 16 + 8) * 2) = (u32x4){o[4], o[5], o[6], o[7]};
      if (tid < 128) CARRY[tid] = 0.f;
      if (tid < 2) FLAG[tid] = 0;
    }
    f32x4 acc[4];
#pragma unroll
    for (int j = 0; j < 4; ++j) acc[j] = (f32x4){0.f, 0.f, 0.f, 0.f};
    int iter = 0;
    u32x4 kwn, vwn;
    { const int row = tid >> 3, part = tid & 7; const bf16_t* src = QKV + (size_t)((2 * qb + 1) * 64 + row) * 3072 + 1024 + h * 64 + part * 8; kwn = *(const u32x4*)src; vwn = *(const u32x4*)(src + 1024); }
    for (int kb = 2 * qb + 1; kb >= 0; --kb, ++iter) {
      { const int row = tid >> 3, part = tid & 7;
        const u32x4 kw = kwn; const u32x4 vw = vwn;
        if (kb > 0) { const bf16_t* src = QKV + (size_t)((kb - 1) * 64 + row) * 3072 + 1024 + h * 64 + part * 8; kwn = *(const u32x4*)src; vwn = *(const u32x4*)(src + 1024); }
        *(LAS u32x4*)(lds + S_K + (row * 72 + part * 8) * 2) = kw;
        const unsigned vv[4] = {vw.x, vw.y, vw.z, vw.w};
#pragma unroll
        for (int e = 0; e < 4; ++e) { VT[(part * 8 + 2 * e) * 72 + row] = (bf16_t)(vv[e] & 0xffffu); VT[(part * 8 + 2 * e + 1) * 72 + row] = (bf16_t)(vv[e] >> 16); }
      }
      __syncthreads();
      if (tid == 0) FLAG[(iter + 1) & 1] = 0;
#pragma unroll
      for (int kt = 0; kt < 4; ++kt) { f32x4 z = (f32x4){0.f, 0.f, 0.f, 0.f};
#pragma unroll
        for (int ks = 0; ks < 2; ++ks) z = mfma16(LDSV8(S_Q + ((wid * 16 + fr) * 72 + ks * 32 + kg * 8) * 2), LDSV8(S_K + ((kt * 16 + fr) * 72 + ks * 32 + kg * 8) * 2), z);
#pragma unroll
        for (int r = 0; r < 4; ++r) Z[(wid * 16 + 4 * kg + r) * 65 + kt * 16 + fr] = z[r]; }
      __syncthreads();
      { const int row = tid >> 2, seg = tid & 3; const int tq = qb * 128 + row; const int s0 = kb * 64 + seg * 16;
        float lbv[16], lkv[16]; float segsum = 0.f;
#pragma unroll
        for (int j = 0; j < 16; ++j) { const float z = Z[row * 65 + seg * 16 + j]; const float lb = logsig(z); const bool valid = (s0 + j) < tq;
          lbv[j] = valid ? lb : -1e30f; lkv[j] = valid ? lb - z : 0.f; segsum += lkv[j]; }
        const float v0 = quad_bcast<0>(segsum), v1 = quad_bcast<1>(segsum), v2 = quad_bcast<2>(segsum), v3 = quad_bcast<3>(segsum);
        const float right = (seg < 1 ? v1 : 0.f) + (seg < 2 ? v2 : 0.f) + (seg < 3 ? v3 : 0.f);
        const float cin = CARRY[row];
        float run = cin + right;
#pragma unroll
        for (int j = 15; j >= 0; --j) { const float w = __expf(lbv[j] + run); run += lkv[j]; PP[row * 72 + seg * 16 + j] = (bf16_t)f2bf(w); }
        const float cnew = cin + v0 + v1 + v2 + v3;
        if (seg == 0) { CARRY[row] = cnew; if (cnew > SB_EXIT) FLAG[iter & 1] = 1; }
      }
      __syncthreads();
#pragma unroll
      for (int ks = 0; ks < 2; ++ks) { const bf16x8 a = LDSV8(S_P + ((wid * 16 + fr) * 72 + ks * 32 + kg * 8) * 2);
#pragma unroll
        for (int j = 0; j < 4; ++j) acc[j] = mfma16(a, LDSV8(S_V + ((j * 16 + fr) * 72 + ks * 32 + kg * 8) * 2), acc[j]); }
      const int cont = FLAG[iter & 1];
      if (!cont) break;
      __syncthreads();
    }
#pragma unroll
    for (int j = 0; j < 4; ++j)
#pragma unroll
      for (int r = 0; r < 4; ++r) AO[(size_t)(qb * 128 + wid * 16 + 4 * kg + r) * 1024 + h * 64 + j * 16 + fr] = (bf16_t)f2bf(acc[j][r]);
    __syncthreads();
  }
}

constexpr int RK_L = 128, RK_NC = M / RK_L, RK_STEP = 1536;
constexpr unsigned A_RB = A_Y, A_RP = A_Y + 32 * MiB;
typedef float f32x2 __attribute__((ext_vector_type(2)));
template <int NB> struct RRaw { unsigned r[NB], k[NB], v[NB], w[NB], a[NB]; };
__device__ __forceinline__ float wave_total(float v) { const float s = wave_scan63(v); return __builtin_bit_cast(float, __builtin_amdgcn_readlane(__builtin_bit_cast(int, s), 63)); }
template <int NB> __device__ __forceinline__ void rk_issue(RRaw<NB>& R, const unsigned char* ws, int ch, int t0) {
  const bf16_t* P1 = (const bf16_t*)(ws + A_P1); const bf16_t* P2 = (const bf16_t*)(ws + A0);
#pragma unroll
  for (int q = 0; q < NB; ++q) { const size_t t = (size_t)(t0 + q);
    R.r[q] = P1[t * 3328 + ch]; R.k[q] = P1[t * 3328 + 1024 + ch]; R.v[q] = P1[t * 3328 + 2048 + ch];
    R.w[q] = P2[t * 2048 + ch]; R.a[q] = P2[t * 2048 + 1024 + ch]; }
}
template <bool WSC, int NB>
__device__ __forceinline__ void rk_prep8(const RRaw<NB>& R, LAS unsigned char* wl, float w0c, float a0c, float kkc, float kac, float rkc, float* SC, int t0, int h, int lane) {
#pragma unroll
  for (int q = 0; q < NB; ++q) {
    const float r = bf2f(R.r[q]), kr = bf2f(R.k[q]), v = bf2f(R.v[q]);
    const float wp = bf2f(R.w[q]) + w0c, ap = bf2f(R.a[q]) + a0c;
    const float decay = __expf(-0.6065306597126334f * __builtin_amdgcn_rcpf(1.f + __expf(-wp)));
    const float a = __builtin_amdgcn_rcpf(1.f + __expf(-ap));
    const float kkv = kr * kkc; const float kk = kkv * __builtin_amdgcn_rsqf(fmaxf(wave_total(kkv * kkv), 1e-24f));
    const float kmod = kr * (1.f + (a - 1.f) * kac);
    LAS float* p = (LAS float*)(wl + q * RK_STEP) + lane;
    p[0] = decay; p[64] = -kk; p[128] = kk * a; p[192] = kmod; p[256] = r; p[320] = v;
    if (WSC) { const float scv = wave_total(r * kmod * rkc); if (lane == 0) SC[(size_t)(t0 + q) * 16 + h] = scv; }
  }
}
#define RK_V4(off) (*(const LAS f32x4*)(p + (off)))
template <int PASS>
__device__ __forceinline__ void rk_chunk(LAS unsigned char* lds, unsigned char* ws, const float* w0, const float* a0, const float* k_k, const float* k_a, const float* r_k, int item, int wid, int lane) {
  const int h = item >> 7, c = item & 127, ch = h * 64 + lane, tb = c * RK_L;
  LAS unsigned char* wl = lds + wid * 16384;
  const float w0c = w0[ch], a0c = a0[ch], kkc = k_k[ch], kac = k_a[ch], rkc = r_k[ch];
  float* SC = (float*)(ws + WS_SMALL + SM_SC); bf16_t* Y = (bf16_t*)(ws + A_RP);
  float* Bg = (float*)(ws + A_RB) + ((size_t)(h * RK_NC + c) * 64 + lane) * 64;
  float* Pg = (float*)(ws + A_RP) + ((size_t)(h * RK_NC + c) * 64 + lane) * 64;
  f32x2 SB[32], SP[32];
  float zf = 0.f; asm volatile("" : "+v"(zf));
#pragma unroll
  for (int q = 0; q < 32; ++q) { SB[q] = (f32x2){zf, zf}; SP[q] = (f32x2){(2 * q == lane) ? 1.f : 0.f, (2 * q + 1 == lane) ? 1.f : 0.f}; }
  if (PASS == 3 && c > 0) { const float* Sg = Bg - 4096;
#pragma unroll
    for (int q = 0; q < 16; ++q) { const f32x4 v = *(const f32x4*)(Sg + 4 * q); SB[2 * q] = (f32x2){v.x, v.y}; SB[2 * q + 1] = (f32x2){v.z, v.w}; } }
  constexpr int NB = (PASS == 1) ? 2 : 4;
  RRaw<NB> RA;
  rk_issue<NB>(RA, ws, ch, tb);
  for (int blk = 0; blk < RK_L / NB; ++blk) {
    rk_prep8<PASS == 3, NB>(RA, wl, w0c, a0c, kkc, kac, rkc, SC, tb + blk * NB, h, lane);
    if (blk + 1 < RK_L / NB) rk_issue<NB>(RA, ws, ch, tb + (blk + 1) * NB);
#pragma unroll 1
    for (int s = 0; s < NB; ++s) {
      const LAS float* p = (const LAS float*)(wl + s * RK_STEP);
      f32x2 y0, y1;
      if constexpr (PASS == 1) {
      f32x2 a0v = (f32x2){zf, zf}, a1v = a0v, b0v = a0v, b1v = a0v;
      f32x4 NK[4], W[2], KA[2], KX[2];
      NK[0] = RK_V4(64); NK[1] = RK_V4(68); NK[2] = RK_V4(72);
#pragma unroll
      for (int q = 0; q < 16; ++q) {
        if (q + 3 < 16) NK[(q + 3) & 3] = RK_V4(64 + 4 * (q + 3));
        if (q == 15) { W[0] = RK_V4(0); KA[0] = RK_V4(128); KX[0] = RK_V4(192); }
        const f32x4 nk = NK[q & 3]; const f32x2 lo = (f32x2){nk.x, nk.y}, hi = (f32x2){nk.z, nk.w};
        a0v += SB[2 * q] * lo; a1v += SB[2 * q + 1] * hi; b0v += SP[2 * q] * lo; b1v += SP[2 * q + 1] * hi;
        asm volatile("" ::: "memory");
      }
      const float sa = (a0v.x + a0v.y) + (a1v.x + a1v.y), sp = (b0v.x + b0v.y) + (b1v.x + b1v.y);
      const float vv = p[320 + lane];
      const f32x2 sa2 = (f32x2){sa, sa}, sp2 = (f32x2){sp, sp}, v2 = (f32x2){vv, vv};
      y0 = (f32x2){zf, zf}; y1 = y0;
#pragma unroll
      for (int q = 0; q < 16; ++q) {
        if (q + 1 < 16) { W[(q + 1) & 1] = RK_V4(4 * (q + 1)); KA[(q + 1) & 1] = RK_V4(128 + 4 * (q + 1)); KX[(q + 1) & 1] = RK_V4(192 + 4 * (q + 1)); }
        const f32x4 w4 = W[q & 1], ka4 = KA[q & 1], kx4 = KX[q & 1];
        const f32x2 wl2 = (f32x2){w4.x, w4.y}, wh2 = (f32x2){w4.z, w4.w}, kal = (f32x2){ka4.x, ka4.y}, kah = (f32x2){ka4.z, ka4.w}, kxl = (f32x2){kx4.x, kx4.y}, kxh = (f32x2){kx4.z, kx4.w};
        SB[2 * q] = SB[2 * q] * wl2 + sa2 * kal + v2 * kxl; SB[2 * q + 1] = SB[2 * q + 1] * wh2 + sa2 * kah + v2 * kxh;
        SP[2 * q] = SP[2 * q] * wl2 + sp2 * kal; SP[2 * q + 1] = SP[2 * q + 1] * wh2 + sp2 * kah;
        asm volatile("" ::: "memory");
      }
      } else {
      f32x2 a0v = (f32x2){zf, zf}, a1v = a0v, b0v = a0v, b1v = a0v;
      f32x4 NK[2][4];
#pragma unroll
      for (int j = 0; j < 4; ++j) NK[0][j] = RK_V4(64 + 4 * j);
      f32x4 W[2][2], KA[2][2], KX[2][2], RR[2][2];
#pragma unroll
      for (int g = 0; g < 4; ++g) {
        if (g + 1 < 4) {
#pragma unroll
          for (int j = 0; j < 4; ++j) NK[(g + 1) & 1][j] = RK_V4(64 + 4 * (4 * (g + 1) + j));
        } else {
#pragma unroll
          for (int j = 0; j < 2; ++j) { W[0][j] = RK_V4(4 * j); KA[0][j] = RK_V4(128 + 4 * j); KX[0][j] = RK_V4(192 + 4 * j); if (PASS == 3) RR[0][j] = RK_V4(256 + 4 * j); }
        }
#pragma unroll
        for (int j = 0; j < 4; ++j) { const int q = 4 * g + j; const f32x4 nk = NK[g & 1][j]; const f32x2 lo = (f32x2){nk.x, nk.y}, hi = (f32x2){nk.z, nk.w};
          a0v += SB[2 * q] * lo; a1v += SB[2 * q + 1] * hi;
          if (PASS == 1) { b0v += SP[2 * q] * lo; b1v += SP[2 * q + 1] * hi; } }
        asm volatile("" ::: "memory");
      }
      const float sa = (a0v.x + a0v.y) + (a1v.x + a1v.y), sp = (b0v.x + b0v.y) + (b1v.x + b1v.y);
      const float vv = p[320 + lane];
      const f32x2 sa2 = (f32x2){sa, sa}, sp2 = (f32x2){sp, sp}, v2 = (f32x2){vv, vv};
      y0 = (f32x2){zf, zf}; y1 = y0;
#pragma unroll
      for (int g = 0; g < 8; ++g) {
        if (g + 1 < 8) {
#pragma unroll
          for (int j = 0; j < 2; ++j) { const int qn = 2 * (g + 1) + j; W[(g + 1) & 1][j] = RK_V4(4 * qn); KA[(g + 1) & 1][j] = RK_V4(128 + 4 * qn); KX[(g + 1) & 1][j] = RK_V4(192 + 4 * qn); if (PASS == 3) RR[(g + 1) & 1][j] = RK_V4(256 + 4 * qn); }
        }
#pragma unroll
        for (int j = 0; j < 2; ++j) { const int q = 2 * g + j; const f32x4 w4 = W[g & 1][j], ka4 = KA[g & 1][j], kx4 = KX[g & 1][j];
          const f32x2 wl2 = (f32x2){w4.x, w4.y}, wh2 = (f32x2){w4.z, w4.w}, kal = (f32x2){ka4.x, ka4.y}, kah = (f32x2){ka4.z, ka4.w}, kxl = (f32x2){kx4.x, kx4.y}, kxh = (f32x2){kx4.z, kx4.w};
          SB[2 * q] = SB[2 * q] * wl2 + sa2 * kal + v2 * kxl; SB[2 * q + 1] = SB[2 * q + 1] * wh2 + sa2 * kah + v2 * kxh;
          if (PASS == 1) { SP[2 * q] = SP[2 * q] * wl2 + sp2 * kal; SP[2 * q + 1] = SP[2 * q + 1] * wh2 + sp2 * kah; }
          if (PASS == 3) { const f32x4 r4 = RR[g & 1][j]; y0 += SB[2 * q] * (f32x2){r4.x, r4.y}; y1 += SB[2 * q + 1] * (f32x2){r4.z, r4.w}; } }
        asm volatile("" ::: "memory");
      }
      }
      if (PASS == 3) Y[(size_t)(tb + blk * NB + s) * 1024 + ch] = (bf16_t)f2bf((y0.x + y0.y) + (y1.x + y1.y));
    }
  }
  if (PASS == 1) {
#pragma unroll
    for (int q = 0; q < 16; ++q) { *(f32x4*)(Bg + 4 * q) = (f32x4){SB[2 * q].x, SB[2 * q].y, SB[2 * q + 1].x, SB[2 * q + 1].y};
      *(f32x4*)(Pg + 4 * q) = (f32x4){SP[2 * q].x, SP[2 * q].y, SP[2 * q + 1].x, SP[2 * q + 1].y}; }
  }
}
__device__ __forceinline__ void rk_scan(LAS unsigned char* lds, unsigned char* ws, int bid, int wid_s) {
  if (bid >= 64) return;
  const int tid = opaque_tid_w(wid_s), wid = wid_s, lane = tid & 63, h = bid >> 2, i0 = (bid & 3) * 16, i = lane >> 2, q = lane & 3;
  const float* Pg = (const float*)(ws + A_RP) + (size_t)h * RK_NC * 4096; float* Bg = (float*)(ws + A_RB) + (size_t)h * RK_NC * 4096;
  LAS float* PL = (LAS float*)lds; LAS float* SX = (LAS float*)(lds + 32768);
  f32x2 S[8];
  float zf = 0.f; asm volatile("" : "+v"(zf));
#pragma unroll
  for (int j = 0; j < 8; ++j) S[j] = (f32x2){zf, zf};
  f32x4 p0 = *(const f32x4*)(Pg + tid * 8), p1 = *(const f32x4*)(Pg + tid * 8 + 4);
  *(LAS f32x4*)(PL + tid * 8) = p0; *(LAS f32x4*)(PL + tid * 8 + 4) = p1;
  const size_t brow = (size_t)(i0 + i) * 64 + 8 * wid;
  f32x4 bn0 = *(const f32x4*)(Bg + brow), bn1 = *(const f32x4*)(Bg + brow + 4);
  asm volatile("s_waitcnt vmcnt(0) lgkmcnt(0)" ::: "memory"); __builtin_amdgcn_s_barrier(); asm volatile("" ::: "memory");
  for (int c = 0; c < RK_NC; ++c) {
    const LAS float* pl = PL + (c & 1) * 4096 + 8 * wid + q * 16 * 64;
    const f32x4 b0 = bn0, b1 = bn1;
    if (c + 1 < RK_NC) { p0 = *(const f32x4*)(Pg + (size_t)(c + 1) * 4096 + tid * 8); p1 = *(const f32x4*)(Pg + (size_t)(c + 1) * 4096 + tid * 8 + 4);
      bn0 = *(const f32x4*)(Bg + (size_t)(c + 1) * 4096 + brow); bn1 = *(const f32x4*)(Bg + (size_t)(c + 1) * 4096 + brow + 4); }
    f32x2 o0 = (f32x2){zf, zf}, o1 = o0, o2 = o0, o3 = o0;
    f32x4 PA[2][4], PB[2][4];
#pragma unroll
    for (int j = 0; j < 4; ++j) { PA[0][j] = *(const LAS f32x4*)(pl + j * 64); PB[0][j] = *(const LAS f32x4*)(pl + j * 64 + 4); }
#pragma unroll
    for (int g = 0; g < 4; ++g) {
      if (g + 1 < 4) {
#pragma unroll
        for (int j = 0; j < 4; ++j) { PA[(g + 1) & 1][j] = *(const LAS f32x4*)(pl + (4 * (g + 1) + j) * 64); PB[(g + 1) & 1][j] = *(const LAS f32x4*)(pl + (4 * (g + 1) + j) * 64 + 4); }
      }
#pragma unroll
      for (int j = 0; j < 4; ++j) { const int k = 4 * g + j; const f32x4 pa = PA[g & 1][j], pb = PB[g & 1][j];
        const float s = (k & 1) ? S[k >> 1].y : S[k >> 1].x; const f32x2 s2 = (f32x2){s, s};
        o0 += s2 * (f32x2){pa.x, pa.y}; o1 += s2 * (f32x2){pa.z, pa.w}; o2 += s2 * (f32x2){pb.x, pb.y}; o3 += s2 * (f32x2){pb.z, pb.w}; }
      asm volatile("" ::: "memory");
    }
    float ov[8] = {o0.x, o0.y, o1.x, o1.y, o2.x, o2.y, o3.x, o3.y};
#pragma unroll
    for (int j = 0; j < 8; ++j) { float v = ov[j];
      v += __builtin_bit_cast(float, __builtin_amdgcn_update_dpp(0, __builtin_bit_cast(int, v), 0xB1, 0xf, 0xf, false));
      v += __builtin_bit_cast(float, __builtin_amdgcn_update_dpp(0, __builtin_bit_cast(int, v), 0x4E, 0xf, 0xf, false));
      ov[j] = v; }
    const f32x4 r0 = (f32x4){ov[0] + b0.x, ov[1] + b0.y, ov[2] + b0.z, ov[3] + b0.w}, r1 = (f32x4){ov[4] + b1.x, ov[5] + b1.y, ov[6] + b1.z, ov[7] + b1.w};
    if (q == 0) { *(LAS f32x4*)(SX + i * 68 + 8 * wid) = r0; *(LAS f32x4*)(SX + i * 68 + 8 * wid + 4) = r1;
      *(f32x4*)(Bg + (size_t)c * 4096 + brow) = r0; *(f32x4*)(Bg + (size_t)c * 4096 + brow + 4) = r1; }
    asm volatile("s_waitcnt lgkmcnt(0)" ::: "memory"); __builtin_amdgcn_s_barrier(); asm volatile("" ::: "memory");
#pragma unroll
    for (int j = 0; j < 4; ++j) { const f32x4 v = *(const LAS f32x4*)(SX + i * 68 + q * 16 + 4 * j); S[2 * j] = (f32x2){v.x, v.y}; S[2 * j + 1] = (f32x2){v.z, v.w}; }
    if (c + 1 < RK_NC) { LAS float* pn = PL + ((c + 1) & 1) * 4096; *(LAS f32x4*)(pn + tid * 8) = p0; *(LAS f32x4*)(pn + tid * 8 + 4) = p1; }
    asm volatile("s_waitcnt lgkmcnt(0)" ::: "memory"); __builtin_amdgcn_s_barrier(); asm volatile("" ::: "memory");
  }
}
__device__ __forceinline__ void rwkv_post(unsigned char* ws, const float* gng, const float* gnb, int gw, int ngw, int lane) {
  const bf16_t* Y = (const bf16_t*)(ws + A_RP); const bf16_t* P1 = (const bf16_t*)(ws + A_P1); const bf16_t* G = (const bf16_t*)(ws + A0);
  const float* SC = (const float*)(ws + WS_SMALL + SM_SC); bf16_t* AO = (bf16_t*)(ws + A_RA);
  const int c0 = lane * 16;
  float gg[16], gb_[16];
#pragma unroll
  for (int j = 0; j < 4; ++j) { const f32x4 a = *(const f32x4*)(gng + c0 + 4 * j), b = *(const f32x4*)(gnb + c0 + 4 * j);
    gg[4 * j] = a.x; gg[4 * j + 1] = a.y; gg[4 * j + 2] = a.z; gg[4 * j + 3] = a.w; gb_[4 * j] = b.x; gb_[4 * j + 1] = b.y; gb_[4 * j + 2] = b.z; gb_[4 * j + 3] = b.w; }
  for (int t0 = gw; t0 < M; t0 += 2 * ngw) {
    const int t1 = t0 + ngw; const bool has1 = t1 < M; const int tt[2] = {t0, has1 ? t1 : t0};
    u32x4 ya[2], yb[2], va[2], vb[2], ga[2], gb[2]; float scv[2];
#pragma unroll
    for (int r = 0; r < 2; ++r) { const size_t t = (size_t)tt[r];
      ya[r] = *(const u32x4*)(Y + t * 1024 + c0); yb[r] = *(const u32x4*)(Y + t * 1024 + c0 + 8);
      va[r] = *(const u32x4*)(P1 + t * 3328 + 2048 + c0); vb[r] = *(const u32x4*)(P1 + t * 3328 + 2048 + c0 + 8);
      ga[r] = *(const u32x4*)(G + t * 1024 + c0); gb[r] = *(const u32x4*)(G + t * 1024 + c0 + 8);
      scv[r] = SC[t * 16 + (lane >> 2)]; }
#pragma unroll
    for (int r = 0; r < 2; ++r) {
      if (r == 1 && !has1) break;
      float y[16]; float s = 0.f;
      const unsigned yw[8] = {ya[r].x, ya[r].y, ya[r].z, ya[r].w, yb[r].x, yb[r].y, yb[r].z, yb[r].w};
#pragma unroll
      for (int e = 0; e < 8; ++e) { y[2 * e] = bflo(yw[e]); y[2 * e + 1] = bfhi(yw[e]); s += y[2 * e] + y[2 * e + 1]; }
      s += sx<1>(s); s += sx<2>(s);
      const float mean = s * (1.f / 64.f); float q = 0.f;
#pragma unroll
      for (int j = 0; j < 16; ++j) { y[j] -= mean; q += y[j] * y[j]; }
      q += sx<1>(q); q += sx<2>(q);
      const float rs = 1.0f / sqrtf(q * (1.f / 64.f) + 64e-5f);
      const unsigned vw[8] = {va[r].x, va[r].y, va[r].z, va[r].w, vb[r].x, vb[r].y, vb[r].z, vb[r].w}; const unsigned gwv[8] = {ga[r].x, ga[r].y, ga[r].z, ga[r].w, gb[r].x, gb[r].y, gb[r].z, gb[r].w};
      unsigned o[8];
#pragma unroll
      for (int e = 0; e < 8; ++e) {
        const float o0 = (y[2 * e] * rs * gg[2 * e] + gb_[2 * e] + scv[r] * bflo(vw[e])) * bflo(gwv[e]);
        const float o1 = (y[2 * e + 1] * rs * gg[2 * e + 1] + gb_[2 * e + 1] + scv[r] * bfhi(vw[e])) * bfhi(gwv[e]);
        o[e] = pk2(o0, o1); }
      *(u32x4*)(AO + (size_t)tt[r] * 1024 + c0) = (u32x4){o[0], o[1], o[2], o[3]};
      *(u32x4*)(AO + (size_t)tt[r] * 1024 + c0 + 8) = (u32x4){o[4], o[5], o[6], o[7]};
    }
  }
}


#define XB_TMO      128
#define XB_XCNT(j)  (256  + 64 * (j))
#define XB_XSUB(j)  (1280 + 64 * (j))
#define XB_XGEN(j)  (2304 + 64 * (j))
#define XB_TOP      3328
#define XB_TOPGEN   3392
#define XCD_BAR_WORDS 3456
#define XB_SPIN_CAP (1u << 22)
__device__ __forceinline__ unsigned xb_ld(unsigned* p)              { return __hip_atomic_load(p, __ATOMIC_RELAXED, __HIP_MEMORY_SCOPE_AGENT); }
__device__ __forceinline__ unsigned xb_add(unsigned* p, unsigned v) { return __hip_atomic_fetch_add(p, v, __ATOMIC_RELAXED, __HIP_MEMORY_SCOPE_AGENT); }
__device__ __forceinline__ unsigned xb_xcc_id() { return (unsigned)__builtin_amdgcn_s_getreg((3 << 11) | 20) & 0xFu; }
#define XB_SPIN(cond, bar) do { unsigned _sp = 0; while (cond) { __builtin_amdgcn_s_sleep(1); \
    if ((++_sp & 255u) == 0u) { if (xb_ld(&(bar)[XB_TMO])) break; if (_sp > XB_SPIN_CAP) { atomicAdd(&(bar)[XB_TMO], 1u); break; } } } } while (0)
struct XcdBarrier { unsigned* bar; unsigned x; volatile LAS unsigned* st; };
__device__ __forceinline__ XcdBarrier xcd_barrier_post(unsigned* bar, volatile LAS unsigned* st) {
    XcdBarrier b; b.bar = bar; b.x = xb_xcc_id(); b.st = st;
    if (threadIdx.x == 0) (void)xb_add(&bar[XB_XCNT(b.x)], 1u);
    return b;
}
__device__ __forceinline__ void xcd_barrier_complete(unsigned* bar, unsigned x, unsigned& nloc, unsigned& nx) {
    const unsigned G = gridDim.x * gridDim.y * gridDim.z;
    unsigned sum, cnt, mine, sp = 0u;
    for (;;) {
        sum = 0u; cnt = 0u; mine = 0u;
#pragma unroll
        for (unsigned j = 0; j < 16; ++j) { const unsigned c = xb_ld(&bar[XB_XCNT(j)]); sum += c; cnt += (c > 0u) ? 1u : 0u; mine = (j == x) ? c : mine; }
        if (sum == G) break;
        __builtin_amdgcn_s_sleep(1);
        if ((++sp & 255u) == 0u) { if (xb_ld(&bar[XB_TMO])) break; if (sp > XB_SPIN_CAP) { atomicAdd(&bar[XB_TMO], 1u); break; } }
    }
    nloc = mine > 0u ? mine : 1u; nx = cnt > 0u ? cnt : 1u;
}
__device__ __forceinline__ void xcd_barrier(const XcdBarrier& b, int wid_s) {
    asm volatile("s_waitcnt vmcnt(0)" ::: "memory");
    __syncthreads();
    if (opaque_tid_w(wid_s) == 0) {
        unsigned* bar = b.bar;
        __builtin_amdgcn_s_waitcnt(0);
        unsigned nloc = b.st[0], nx = b.st[1];
        if (nloc == 0u) { xcd_barrier_complete(bar, b.x, nloc, nx); b.st[0] = nloc; b.st[1] = nx; }
        const unsigned old = xb_add(&bar[XB_XSUB(b.x)], 1u);
        const unsigned gen = old / nloc;
        if (old + 1u == (gen + 1u) * nloc) {
            __builtin_amdgcn_fence(__ATOMIC_RELEASE, "agent");
            asm volatile("s_waitcnt vmcnt(0)" ::: "memory");
            const unsigned og = xb_add(&bar[XB_TOP], 1u);
            const unsigned tg = og / nx;
            if (og + 1u == (tg + 1u) * nx) xb_add(&bar[XB_TOPGEN], 1u);
            else XB_SPIN(xb_ld(&bar[XB_TOPGEN]) == tg, bar);
            __builtin_amdgcn_fence(__ATOMIC_ACQUIRE, "agent");
            xb_add(&bar[XB_XGEN(b.x)], 1u);
            asm volatile("s_waitcnt vmcnt(0)" ::: "memory");
        } else {
            XB_SPIN(xb_ld(&bar[XB_XGEN(b.x)]) == gen, bar);
            __builtin_amdgcn_fence(__ATOMIC_ACQUIRE, "agent");
            asm volatile("s_waitcnt vmcnt(0)" ::: "memory");
        }
    }
    __syncthreads();
}

struct KArgs { const float* in[53]; float* out; unsigned char* ws; };
#define INP(i) ((const float*)(const __attribute__((address_space(1))) float*)PT[(i)])

__global__ void __launch_bounds__(512, 2) mega_fwd(KArgs args) {
  extern __shared__ __attribute__((aligned(16))) unsigned char lds_raw[];
  LAS unsigned char* lds = (LAS unsigned char*)lds_raw;
  LAS ull* PT = (LAS ull*)(lds + PT_OFF);
  const int wid_s = __builtin_amdgcn_readfirstlane((int)threadIdx.x >> 6);
  if (threadIdx.x == 0) {
#pragma unroll
    for (int i = 0; i < 53; ++i) PT[i] = (ull)args.in[i];
  }
  if (threadIdx.x < 2) ((LAS unsigned*)(lds + PT_OFF + 1024))[threadIdx.x] = 0u;
  unsigned* barw = (unsigned*)(args.ws + WS_SMALL + SM_BAR);
  if (blockIdx.x == 0) for (int i = threadIdx.x; i < XCD_BAR_WORDS; i += 512) __hip_atomic_store(barw + i, 0u, __ATOMIC_RELAXED, __HIP_MEMORY_SCOPE_AGENT);
  __syncthreads();
  cg::grid_group grid = cg::this_grid();
  grid.sync();
  (void)xcd_barrier_post(barw, (volatile LAS unsigned*)(lds + PT_OFF + 1024));
  for (int pq = 0; pq < 2 * NPH; ++pq) {
    const int ph = pq >> 1;
    const PhaseDesc d = PROG[ph];
    if ((pq & 1) && !((REPMASK >> d.kind) & 1)) continue;
    __attribute__((address_space(1))) unsigned char* wsg = (__attribute__((address_space(1))) unsigned char*)args.ws; __attribute__((address_space(1))) float* Xg = (__attribute__((address_space(1))) float*)args.out;
    asm volatile("" : "+s"(wsg), "+s"(Xg));
    unsigned char* ws = (unsigned char*)wsg; float* X = (float*)Xg;
    { unsigned lb = 0; asm volatile("" : "+s"(lb)); lds = (LAS unsigned char*)lds_raw + lb; PT = (LAS ull*)(lds + PT_OFF); }
    int bid = blockIdx.x, G = gridDim.x; asm volatile("" : "+s"(bid), "+s"(G));
    const int wave = wid_s;
#define TIDS const int tid = opaque_tid_w(wid_s), lane = tid & 63, gw = bid * 8 + wave, ngw = G * 8, gtid = bid * 512 + tid, ngt = G * 512; (void)lane; (void)gw; (void)ngw; (void)gtid; (void)ngt
    switch (d.kind) {
      case K_PREP: { TIDS;
        if (d.lda == 1) norm_rows(INP(0), X, INP(d.K), (bf16_t*)(ws + d.a), 1, gw, ngw, lane);
        else norm_rows(X, nullptr, INP(d.K), (bf16_t*)(ws + d.a), d.lda, gw, ngw, lane);
      } break;
      case K_GEMM:
      case K_GEMMR: {
        const int mode = (d.kind == K_GEMMR) ? 0 : (d.act == 2 ? 2 : 1);
        pg8::Gemm g{(const bf16_t*)(ws + d.a), (const bf16_t*)(ws + d.b), d.Mr, d.N, d.K, d.lda, mode == 2 ? 254 : 256}; pg8::StaticOrder S; S.init(d.Mr, d.N, G, bid);
        void* outp = (mode == 0) ? (void*)X : (mode == 2 ? (void*)(ws + A_H) : (void*)(ws + d.c));
        pg8::EpiAny E{mode, outp, d.ldc, d.act, d.x1, lds};
        pg8::gemm_phase<pg8::EpiAny>(lds, g, S, E, wid_s);
      } break;
      case K_CLOCAL: if (d.x0) chunk_local<true>(lds, ws, INP(44), nullptr, bid, G, wid_s); else chunk_local<false>(lds, ws, INP(3), INP(4), bid, G, wid_s); break;
      case K_CSCAN: { TIDS; if (d.x0) chunk_scan<true>(ws, gtid, ngt); else chunk_scan<false>(ws, gtid, ngt); } break;
      case K_COUT: if (d.x0) chunk_out<true>(lds, ws, INP(44), nullptr, INP(45), bid, G, wid_s); else chunk_out<false>(lds, ws, INP(3), INP(4), INP(5), bid, G, wid_s); break;
      case K_RP1: { TIDS; for (int it = bid * 8 + wave; it < 2048; it += G * 8) rk_chunk<1>(lds, ws, INP(15), INP(18), INP(23), INP(24), INP(25), it, wave, lane); } break;
      case K_RSCAN: rk_scan(lds, ws, bid, wid_s); break;
      case K_RREC: { TIDS; for (int it = bid * 8 + wave; it < 2048; it += G * 8) rk_chunk<3>(lds, ws, INP(15), INP(18), INP(23), INP(24), INP(25), it, wave, lane); } break;
      case K_RPOST: { TIDS; rwkv_post(ws, INP(26), INP(27), gw, ngw, lane); } break;
      case K_SB: sb_attn(lds, ws, bid, G, wid_s); break;
      case K_FINAL: { TIDS; norm_rows(X, X, INP(d.K), nullptr, 3, gw, ngw, lane); } break;
      default: break;
    }
    {
      const int j0 = (d.kind == K_PREP) ? d.x0 : d.sj0, j1 = (d.kind == K_PREP) ? d.x1 : d.sj1;
      if (j1 > j0) {
        __syncthreads();
        const int lane2 = opaque_tid_w(wid_s) & 63;
        const bool sideg = (d.kind == K_GEMM) && G > 150;
        const int sw = sideg ? (bid - 150) * 8 + wave : bid * 8 + wave, nsw = sideg ? (G - 150) * 8 : G * 8;
        if (sw >= 0 && nsw > 0) {
          LAS float* scr = (LAS float*)(lds + wave * 16384);
          int base = 0;
          for (int j = j0; j < j1; ++j) { const ConvJob J = JOBS[j]; const int items = (J.KP / 64) * (J.NP / 32);
            const float* W = INP(J.in_idx) + J.in_off; const float* sc = INP(13) + J.sc_off; bf16_t* out = (bf16_t*)(ws + J.out_off);
            int it = sw - base; if (it < 0) it += nsw;
            for (; it < items; it += nsw) conv_item(J, W, sc, out, scr, it, lane2);
            base = (base + items) % nsw; }
        }
      }
    }
    { XcdBarrier xbar; xbar.bar = (unsigned*)(ws + WS_SMALL + SM_BAR); xbar.x = xb_xcc_id(); xbar.st = (volatile LAS unsigned*)(lds + PT_OFF + 1024);
      for (int xs = 0; xs < XSYNC; ++xs) xcd_barrier(xbar, wid_s);
      xcd_barrier(xbar, wid_s); }
  }
}

extern "C" void kernel_launch(void* const* d_in, const int* in_sizes, int n_in, void* d_out, int out_size, void* d_ws, size_t ws_size, hipStream_t stream) {
  static int grid = 0;
  if (grid == 0) {
    if (n_in != 53 || out_size != M * D || ws_size < WS_NEED) { fprintf(stderr, "kernel_launch: unexpected shapes n_in %d out %d ws %zu\n", n_in, out_size, ws_size); grid = -1; return; }
    int dev = 0, cus = 0, per_cu = 0;
    hipGetDevice(&dev); hipDeviceGetAttribute(&cus, hipDeviceAttributeMultiprocessorCount, dev);
    hipFuncSetAttribute((const void*)mega_fwd, hipFuncAttributeMaxDynamicSharedMemorySize, LDS_BYTES);
    hipOccupancyMaxActiveBlocksPerMultiprocessor(&per_cu, (const void*)mega_fwd, 512, LDS_BYTES);
    (void)hipGetLastError();
    if (per_cu < 1) per_cu = 1;
    grid = cus;
  }
  if (grid < 0) return;
  KArgs a{};
  for (int i = 0; i < 53; ++i) a.in[i] = (const float*)d_in[i];
  a.out = (float*)d_out; a.ws = (unsigned char*)d_ws;
  void* params[] = {&a};
  hipError_t e = hipLaunchCooperativeKernel((const void*)mega_fwd, dim3(grid), dim3(512), params, LDS_BYTES, stream);
  if (e != hipSuccess) fprintf(stderr, "cooperative launch failed: %s (grid %d)\n", hipGetErrorString(e), grid);
}
```
